# Optimizing an MI355X kernel written in HIP

```python
import jax
import jax.numpy as jnp
from jax import lax
import numpy as np

D_MODEL = 2048
BATCH = 2
SEQ = 8192
DEPTH = 2

GRID_W = 64
CTX_LEN = 256
N_MOD = 6
D_FF = 4 * D_MODEL
NORM_EPS = 1e-6

A_WIDTH = D_MODEL // 2
A_HEAD_DIM = 64
A_HEADS = A_WIDTH // A_HEAD_DIM
A_LORA_W = 96
A_LORA_A = 96
A_LORA_G = 256
A_LN_EPS = 64e-5
A_COLS = 3 * A_WIDTH + A_LORA_G + 2 * A_LORA_W + 2 * A_LORA_A

B_HEADS = 4
B_WIDTH_V = D_MODEL // 2
B_DV = B_WIDTH_V // B_HEADS
B_DK = B_DV // 2
B_WIDTH_K = B_HEADS * B_DK
B_LORA = 16
B_GATE_TAU = 16.0
B_CHUNK = 64
B_COLS = 2 * B_WIDTH_K + 2 * B_WIDTH_V + 2 * B_LORA
AB_COLS = A_COLS + B_COLS

C_WIDTH = D_MODEL
C_BLOCKS = 8
C_BLOCK = C_WIDTH // C_BLOCKS
C_CONV = 4
C_CONST = 8.0

kernel_name = "hybrid_rwkv7_gla_rglru_dit_block"


def rms_norm(x, g):
    xf = x.astype(jnp.float32)
    y = xf * lax.rsqrt(jnp.mean(xf * xf, axis=-1, keepdims=True) + NORM_EPS)
    return (y * g.astype(jnp.float32)).astype(x.dtype)


def seg_flip(t, n_ctx):
    return jnp.concatenate([jnp.flip(t[:, :n_ctx], 1), jnp.flip(t[:, n_ctx:], 1)], axis=1)


def shift_mix(p, mu):
    prev = jnp.pad(p[:, :-1], ((0, 0), (1, 0), (0, 0)))
    nxt = jnp.pad(p[:, 1:], ((0, 0), (0, 1), (0, 0)))
    return p + mu[0] * (prev - p) + mu[1] * (nxt - p)


def rwkv7_scan(r, w, k, v, a, b):
    bsz, _, h, n = r.shape

    def step(state, inp):
        r_t, w_t, k_t, v_t, a_t, b_t = inp
        sa = jnp.einsum('bhvk,bhk->bhv', state, a_t)
        state = (state * w_t[:, :, None, :] + sa[..., None] * b_t[:, :, None, :]
                 + v_t[..., None] * k_t[:, :, None, :])
        return state, jnp.einsum('bhvk,bhk->bhv', state, r_t)

    s0 = jnp.zeros((bsz, h, n, n), jnp.float32)
    xs = tuple(jnp.moveaxis(z, 1, 0) for z in (r, w, k, v, a, b))
    _, y = lax.scan(step, s0, xs)
    return jnp.moveaxis(y, 0, 1)


def rwkv7_mixer(pc, pl, mu, w0, w2, a0, a2, g2, k_k, k_a, r_k, ln_w, ln_b):
    n_ctx = pc.shape[1]
    p = jnp.concatenate([shift_mix(pc, mu), shift_mix(pl, mu)], axis=1).astype(jnp.float32)
    bsz, t = p.shape[:2]
    hs = (bsz, t, A_HEADS, A_HEAD_DIM)
    idx = [A_WIDTH, 2 * A_WIDTH, 3 * A_WIDTH, 3 * A_WIDTH + A_LORA_G,
           3 * A_WIDTH + A_LORA_G + 2 * A_LORA_W]
    r, k, v, gd, wd, ad = jnp.split(p, idx, axis=-1)
    wd = wd.reshape(bsz, t, 2, A_LORA_W)
    ad = ad.reshape(bsz, t, 2, A_LORA_A)
    g = jax.nn.sigmoid(gd) @ g2
    kk = (k * k_k).reshape(hs)
    kk = kk / jnp.maximum(jnp.sqrt(jnp.sum(kk * kk, -1, keepdims=True)), 1e-12)
    rh = r.reshape(hs)
    vh = v.reshape(hs)

    def direction(d):
        w_log = -jax.nn.softplus(-(w0[d] + jnp.tanh(wd[:, :, d]) @ w2[d])) - 0.5
        decay = jnp.exp(-jnp.exp(w_log)).reshape(hs)
        a = jax.nn.sigmoid(a0[d] + ad[:, :, d] @ a2[d])
        kd = (k * (1.0 + (a - 1.0) * k_a)).reshape(hs)
        ins = (rh, decay, kd, vh, -kk, kk * a.reshape(hs))
        if d == 1:
            yd = seg_flip(rwkv7_scan(*(seg_flip(z, n_ctx) for z in ins)), n_ctx)
        else:
            yd = rwkv7_scan(*ins)
        bonus = jnp.sum(rh * kd * r_k, -1, keepdims=True) * vh
        return yd, bonus

    y_f, bonus_f = direction(0)
    y_b, bonus_b = direction(1)
    y = y_f + y_b
    mean = jnp.mean(y, -1, keepdims=True)
    var = jnp.mean(jnp.square(y - mean), -1, keepdims=True)
    y = ((y - mean) * lax.rsqrt(var + A_LN_EPS)).reshape(bsz, t, A_WIDTH) * ln_w + ln_b
    y = (y + (bonus_f + bonus_b).reshape(bsz, t, A_WIDTH)) * g
    return y[:, :n_ctx], y[:, n_ctx:]


def gla_chunked(q, k, v, log_a):
    bsz, t, h, dk = q.shape
    dv = v.shape[-1]
    n = t // B_CHUNK
    q, k, log_a = (z.reshape(bsz, n, B_CHUNK, h, dk) for z in (q, k, log_a))
    v = v.reshape(bsz, n, B_CHUNK, h, dv)
    cum = jnp.cumsum(log_a, axis=2)
    q_in = q * jnp.exp(cum)
    k_in = k * jnp.exp(-cum)
    lower = jnp.tril(jnp.ones((B_CHUNK, B_CHUNK), dtype=bool))
    scores = jnp.where(lower, jnp.einsum('bnihk,bnjhk->bnhij', q_in, k_in), 0.0)
    intra = jnp.einsum('bnhij,bnjhv->bnihv', scores, v)
    cum_last = cum[:, :, -1]
    k_end = k * jnp.exp(cum_last[:, :, None] - cum)
    chunk_kv = jnp.einsum('bnjhk,bnjhv->bnhkv', k_end, v)
    chunk_decay = jnp.exp(cum_last)

    def step(state, inp):
        kv, dec = inp
        return state * dec[..., None] + kv, state

    s0 = jnp.zeros((bsz, h, dk, dv), jnp.float32)
    _, s_in = lax.scan(step, s0, (jnp.moveaxis(chunk_kv, 1, 0), jnp.moveaxis(chunk_decay, 1, 0)))
    inter = jnp.einsum('bnihk,nbhkv->bnihv', q_in, s_in)
    return (intra + inter).reshape(bsz, t, h, dv)


def gla_mixer(pc, pl, gw2, gb, norm_g):
    n_ctx = pc.shape[1]
    p = jnp.concatenate([pc, pl], axis=1).astype(jnp.float32)
    bsz, t = p.shape[:2]
    idx = [B_WIDTH_K, 2 * B_WIDTH_K, 2 * B_WIDTH_K + B_WIDTH_V, 2 * B_WIDTH_K + 2 * B_WIDTH_V]
    q, k, v, g, gd = jnp.split(p, idx, axis=-1)
    q = q.reshape(bsz, t, B_HEADS, B_DK) * (B_DK ** -0.5)
    k = k.reshape(bsz, t, B_HEADS, B_DK)
    v = v.reshape(bsz, t, B_HEADS, B_DV)
    gd = gd.reshape(bsz, t, 2, B_LORA)

    def log_gate(d):
        z = gd[:, :, d] @ gw2[d] + gb[d]
        return (jax.nn.log_sigmoid(z) / B_GATE_TAU).reshape(bsz, t, B_HEADS, B_DK)

    o_f = gla_chunked(q, k, v, log_gate(0))
    o_b = seg_flip(gla_chunked(*(seg_flip(z, n_ctx) for z in (q, k, v, log_gate(1)))), n_ctx)
    o = o_f + o_b
    o = o * lax.rsqrt(jnp.mean(o * o, -1, keepdims=True) + NORM_EPS) * norm_g
    o = o.reshape(bsz, t, B_WIDTH_V) * jax.nn.silu(g)
    return o[:, :n_ctx], o[:, n_ctx:]


def dwconv_centred(x, w, b):
    t = x.shape[1]
    left = C_CONV // 2
    xp = jnp.pad(x, ((0, 0), (left, C_CONV - 1 - left), (0, 0)))
    y = b + xp[:, 0:t] * w[0]
    for j in range(1, C_CONV):
        y = y + xp[:, j:j + t] * w[j]
    return y


def linear_scan(a, u):
    def combine(left, right):
        a_l, u_l = left
        a_r, u_r = right
        return a_l * a_r, a_r * u_l + u_r
    return lax.associative_scan(combine, (a, u), axis=1)[1]


def to_col_major(t, rows):
    b, _, ch = t.shape
    return t.reshape(b, rows, GRID_W, ch).transpose(0, 2, 1, 3).reshape(b, rows * GRID_W, ch)


def from_col_major(t, rows):
    b, _, ch = t.shape
    return t.reshape(b, GRID_W, rows, ch).transpose(0, 2, 1, 3).reshape(b, rows * GRID_W, ch)


def rglru_mixer(hc, hl, w_in, conv_w, conv_b, wa, ba, wx, bx, lam, rows):
    n_ctx = hc.shape[1]
    gate_c, xc = jnp.split(hc @ w_in, 2, axis=-1)
    gate_l, xl = jnp.split(hl @ w_in, 2, axis=-1)
    xs = jnp.concatenate([dwconv_centred(xc, conv_w, conv_b),
                          dwconv_centred(to_col_major(xl, rows), conv_w, conv_b)],
                         axis=1).astype(jnp.float32)
    bsz, t, _ = xs.shape
    xb = xs.reshape(bsz, t, C_BLOCKS, C_BLOCK)

    def direction(d):
        r = jax.nn.sigmoid(jnp.einsum('btnc,ncd->btnd', xb, wa[d]).reshape(bsz, t, C_WIDTH) + ba[d])
        i = jax.nn.sigmoid(jnp.einsum('btnc,ncd->btnd', xb, wx[d]).reshape(bsz, t, C_WIDTH) + bx[d])
        log_a = -C_CONST * r * jax.nn.softplus(-lam[d])
        a = jnp.exp(log_a)
        u = jnp.sqrt(-jnp.expm1(2.0 * log_a)) * (i * xs)
        if d == 1:
            return seg_flip(linear_scan(seg_flip(a, n_ctx), seg_flip(u, n_ctx)), n_ctx)
        return linear_scan(a, u)

    h = direction(0) + direction(1)
    yc = h[:, :n_ctx] * jax.nn.gelu(gate_c.astype(jnp.float32))
    yl = from_col_major(h[:, n_ctx:], rows) * jax.nn.gelu(gate_l.astype(jnp.float32))
    return yc, yl


def sq_relu_mlp(h, w1, w2):
    return jnp.square(jax.nn.relu(h @ w1)) @ w2


def setup_inputs(seed: int = 0) -> dict:
    key = jax.random.key(seed)
    ks = iter(jax.random.split(key, 48))
    D = D_MODEL
    ne = (DEPTH + 1) // 2
    no = DEPTH // 2

    def nrm(shape, scale):
        return jax.random.normal(next(ks), shape, jnp.float32) * scale

    def uni(shape, lo, hi):
        return jax.random.uniform(next(ks), shape, jnp.float32, minval=lo, maxval=hi)

    inp = {}
    inp["x"] = nrm((BATCH, SEQ, D), 1.0)
    inp["c"] = nrm((BATCH, D), 1.0)
    inp["ctx"] = nrm((BATCH, CTX_LEN, D), 1.0)
    inp["c_ctx"] = nrm((D,), 1.0)
    inp["mod_w"] = nrm((DEPTH, D, N_MOD * D), 0.5 * D ** -0.5)
    inp["mod_b"] = nrm((DEPTH, N_MOD * D), 0.02)
    inp["norm1"] = 1.0 + nrm((DEPTH, D), 0.02)
    inp["norm2"] = 1.0 + nrm((DEPTH, D), 0.02)
    inp["mlp_w1"] = nrm((DEPTH, D, D_FF), D ** -0.5)
    inp["mlp_w2"] = nrm((DEPTH, D_FF, D), D_FF ** -0.5)
    inp["ab_w_in"] = nrm((ne, D, AB_COLS), D ** -0.5)
    inp["ab_w_out"] = nrm((ne, A_WIDTH + B_WIDTH_V, D), (A_WIDTH + B_WIDTH_V) ** -0.5)
    inp["rw_mu"] = uni((ne, 2, A_COLS), 0.0, 0.5)
    inp["rw_w0"] = uni((ne, 2, A_WIDTH), -7.0, -2.0)
    inp["rw_w2"] = nrm((ne, 2, A_LORA_W, A_WIDTH), 0.5 * A_LORA_W ** -0.5)
    inp["rw_a0"] = nrm((ne, 2, A_WIDTH), 0.1)
    inp["rw_a2"] = nrm((ne, 2, A_LORA_A, A_WIDTH), 0.5 * A_LORA_A ** -0.5)
    inp["rw_g2"] = nrm((ne, A_LORA_G, A_WIDTH), A_LORA_G ** -0.5)
    inp["rw_kk"] = 0.85 + nrm((ne, A_WIDTH), 0.05)
    inp["rw_ka"] = 1.0 + nrm((ne, A_WIDTH), 0.05)
    inp["rw_rk"] = nrm((ne, A_HEADS, A_HEAD_DIM), 0.1)
    inp["rw_ln_w"] = 1.0 + nrm((ne, A_WIDTH), 0.02)
    inp["rw_ln_b"] = nrm((ne, A_WIDTH), 0.02)
    inp["gla_gw2"] = nrm((ne, 2, B_LORA, B_WIDTH_K), 0.5 * B_LORA ** -0.5)
    inp["gla_gb"] = uni((ne, 2, B_WIDTH_K), 1.0, 4.0)
    inp["gla_norm"] = 1.0 + nrm((ne, B_DV), 0.02)
    inp["lru_w_in"] = nrm((no, D, 2 * C_WIDTH), D ** -0.5)
    inp["lru_w_out"] = nrm((no, C_WIDTH, D), C_WIDTH ** -0.5)
    inp["lru_conv_w"] = nrm((no, C_CONV, C_WIDTH), C_CONV ** -0.5)
    inp["lru_conv_b"] = nrm((no, C_WIDTH), 0.02)
    inp["lru_wa"] = nrm((no, 2, C_BLOCKS, C_BLOCK, C_BLOCK), C_BLOCK ** -0.5)
    inp["lru_ba"] = nrm((no, 2, C_WIDTH), 0.02)
    inp["lru_wx"] = nrm((no, 2, C_BLOCKS, C_BLOCK, C_BLOCK), C_BLOCK ** -0.5)
    inp["lru_bx"] = nrm((no, 2, C_WIDTH), 0.02)
    a8 = uni((no, 2, C_WIDTH), 0.9, 0.999)
    s = a8 ** (1.0 / C_CONST)
    inp["lru_lam"] = jnp.log(s) - jnp.log1p(-s)
    inp["final_norm"] = 1.0 + nrm((D,), 0.02)
    return inp


def reference(x, c, ctx, c_ctx, mod_w, mod_b, norm1, norm2, mlp_w1, mlp_w2,
              ab_w_in, ab_w_out, rw_mu, rw_w0, rw_w2, rw_a0, rw_a2, rw_g2, rw_kk, rw_ka, rw_rk,
              rw_ln_w, rw_ln_b, gla_gw2, gla_gb, gla_norm,
              lru_w_in, lru_w_out, lru_conv_w, lru_conv_b, lru_wa, lru_ba, lru_wx, lru_bx, lru_lam,
              final_norm):
    dt = x.dtype
    rows = x.shape[1] // GRID_W
    silu_c = jax.nn.silu(c)[:, None, :]
    silu_cc = jax.nn.silu(c_ctx)[None, None, :]
    xl, xc = x, ctx
    for i in range(DEPTH):
        last = i == DEPTH - 1
        j = i // 2
        m_l = jnp.split(silu_c @ mod_w[i] + mod_b[i], N_MOD, axis=-1)
        m_c = jnp.split(silu_cc @ mod_w[i] + mod_b[i], N_MOD, axis=-1)
        hl = rms_norm(xl, norm1[i]) * (1.0 + m_l[1]) + m_l[0]
        hc = rms_norm(xc, norm1[i]) * (1.0 + m_c[1]) + m_c[0]
        if i % 2 == 0:
            pc = hc @ ab_w_in[j]
            pl = hl @ ab_w_in[j]
            ac, al = rwkv7_mixer(pc[..., :A_COLS], pl[..., :A_COLS], rw_mu[j], rw_w0[j], rw_w2[j],
                                 rw_a0[j], rw_a2[j], rw_g2[j], rw_kk[j], rw_ka[j], rw_rk[j],
                                 rw_ln_w[j], rw_ln_b[j])
            bc, bl = gla_mixer(pc[..., A_COLS:], pl[..., A_COLS:], gla_gw2[j], gla_gb[j], gla_norm[j])
            out_l = jnp.concatenate([al, bl], axis=-1).astype(dt) @ ab_w_out[j]
            if not last:
                out_c = jnp.concatenate([ac, bc], axis=-1).astype(dt) @ ab_w_out[j]
        else:
            yc, yl = rglru_mixer(hc, hl, lru_w_in[j], lru_conv_w[j], lru_conv_b[j], lru_wa[j],
                                 lru_ba[j], lru_wx[j], lru_bx[j], lru_lam[j], rows)
            out_l = yl.astype(dt) @ lru_w_out[j]
            if not last:
                out_c = yc.astype(dt) @ lru_w_out[j]
        xl = xl + m_l[2] * out_l
        hl = rms_norm(xl, norm2[i]) * (1.0 + m_l[4]) + m_l[3]
        xl = xl + m_l[5] * sq_relu_mlp(hl, mlp_w1[i], mlp_w2[i])
        if not last:
            xc = xc + m_c[2] * out_c
            hc = rms_norm(xc, norm2[i]) * (1.0 + m_c[4]) + m_c[3]
            xc = xc + m_c[5] * sq_relu_mlp(hc, mlp_w1[i], mlp_w2[i])
    return rms_norm(xl, final_norm)
```

```cpp
#include <hip/hip_runtime.h>
#include <hip/hip_cooperative_groups.h>
#include <cstdio>
namespace cg = cooperative_groups;

namespace pg8 {
#define PG8_LAS __attribute__((address_space(3)))
typedef unsigned short bf16_t;
typedef short bf16x8 __attribute__((ext_vector_type(8)));
typedef float f32x4 __attribute__((ext_vector_type(4)));
typedef unsigned u32x4 __attribute__((ext_vector_type(4)));
constexpr int BM = 256, BK = 64, HALF = 128, HTB = HALF * BK * 2, STAGE_BYTES = 8 * HTB, NXCD = 8, WGM = 8;
__host__ __device__ __forceinline__ int lds_byte(int r, int c) { const int st = (r >> 4) * 2 + (c >> 5), rr = r & 15, cc = c & 31, ob = rr * 64 + cc * 2; return st * 1024 + (ob ^ (((ob >> 9) & 1) << 5)); }
__host__ __device__ __forceinline__ void stage_rc(int b, int& R, int& C) { const int st = b / 1024, sb = b % 1024, swz = sb ^ (((sb >> 9) & 1) << 5); R = (st >> 1) * 16 + swz / 64; C = (st & 1) * 32 + (swz % 64) / 2; }
__host__ __device__ __forceinline__ int perm32(int rho) { const int n = rho >> 4, i = rho & 15; return 8 * (i >> 2) + 4 * n + (i & 3); }
struct Unit { int pm, pn; };
struct Gemm { const bf16_t* A; const bf16_t* Bt; int M, N, K, lda, ldb; };
struct Sched {
    int nM, nN, nwg, G, c, skip, amode;
    __device__ void init(int nM_, int nN_, int G_, int c_, int skip_, int amode_) { nM = nM_; nN = nN_; nwg = nM * nN; G = G_; c = c_; skip = skip_; amode = amode_; }
    __device__ bool next(int i, Unit& u) const {
        const long L = (long)i * G + c; if (L >= nwg) return false;
        int wgid = (int)L; { const int q = nwg / NXCD, r = nwg % NXCD, xcd = wgid % NXCD, off = wgid / NXCD; wgid = (xcd < r ? xcd * (q + 1) : r * (q + 1) + (xcd - r) * q) + off; }
        const int nig = WGM * nN, gid = wgid / nig, fm = gid * WGM, gsz = (nM - fm) < WGM ? (nM - fm) : WGM;
        int pm = fm + ((wgid % nig) % gsz); u.pn = (wgid % nig) / gsz;
        if (skip) pm = pm + pm / 32 + 1;
        u.pm = pm; return true;
    }
    __device__ __forceinline__ size_t a_off(const Unit& u) const {
        if (amode == 1) return (size_t)(u.pn < 4 ? 0 : (u.pn < 12 ? 256 : 512)) * 2;
        if (amode == 2) return (size_t)((u.pn >> 2) * 256) * 2;
        return 0;
    }
    __device__ __forceinline__ void a_ready(const Unit&) const {}
    __device__ __forceinline__ void done(const Unit&) const {}
};
__device__ __forceinline__ unsigned cvt_pk_bf16(float lo, float hi) { unsigned r; asm volatile("v_cvt_pk_bf16_f32 %0, %1, %2" : "=v"(r) : "v"(lo), "v"(hi)); return r; }

struct EpiBf16S {
    static constexpr bool PERM = true, AFTER_DRAIN = false;
    bf16_t* O0; bf16_t* O1; bf16_t* O2; int ld0, ld1, ld2, t1, t2, act;
    __device__ __forceinline__ void operator()(const f32x4 (&acc)[2][2][4][2], const Unit& u, int wr, int wc, int fr, int fq) const {
        const int row0 = u.pm * BM + wr * 64 + fr;
        bf16_t* base; int ldc, colt;
        if (u.pn < t1) { base = O0; ldc = ld0; colt = u.pn * BM; } else if (u.pn < t2) { base = O1; ldc = ld1; colt = (u.pn - t1) * BM; } else { base = O2; ldc = ld2; colt = (u.pn - t2) * BM; }
        const int col0 = colt + wc * 32 + 8 * fq;
#pragma unroll
        for (int ai = 0; ai < 2; ++ai)
#pragma unroll
            for (int m = 0; m < 4; ++m) { bf16_t* rowp = base + (size_t)(row0 + ai * HALF + m * 16) * ldc + col0;
#pragma unroll
                for (int bj = 0; bj < 2; ++bj) { f32x4 v0 = acc[ai][bj][m][0], v1 = acc[ai][bj][m][1];
                    if (act == 1) {
#pragma unroll
                        for (int e = 0; e < 4; ++e) { float a = v0[e] > 0.f ? v0[e] : 0.f; v0[e] = a * a; float b = v1[e] > 0.f ? v1[e] : 0.f; v1[e] = b * b; } }
                    u32x4 w; w.x = cvt_pk_bf16(v0[0], v0[1]); w.y = cvt_pk_bf16(v0[2], v0[3]); w.z = cvt_pk_bf16(v1[0], v1[1]); w.w = cvt_pk_bf16(v1[2], v1[3]);
                    *(u32x4*)(rowp + bj * HALF) = w; } }
    }
};
struct EpiResid {
    static constexpr bool PERM = false, AFTER_DRAIN = false;
    float* X; const float* xin; const float* cin; const float* modv; int gidx;
    __device__ __forceinline__ void operator()(const f32x4 (&acc)[2][2][4][2], const Unit& u, int wr, int wc, int fr, int fq) const {
        const int b = u.pm / 33, tt = u.pm % 33, mi = (tt == 0) ? 2 : b;
        const int rl0 = wr * 64 + fr, col0 = u.pn * BM + wc * 32 + 4 * fq;
        const float* gp = modv + (size_t)(mi * 6 + gidx) * 2048 + col0;
        f32x4 gv[2][2];
#pragma unroll
        for (int bj = 0; bj < 2; ++bj)
#pragma unroll
            for (int n = 0; n < 2; ++n) gv[bj][n] = *(const f32x4*)(gp + bj * HALF + n * 16);
#pragma unroll
        for (int ai = 0; ai < 2; ++ai)
#pragma unroll
            for (int m = 0; m < 4; ++m) { const int rl = rl0 + ai * HALF + m * 16;
                float* xp = X + (size_t)(u.pm * BM + rl) * 2048 + col0;
                const float* bp = xp;
                if (xin) bp = (tt == 0) ? (cin + (size_t)(b * 256 + rl) * 2048 + col0) : (xin + (size_t)(b * 8192 + (tt - 1) * 256 + rl) * 2048 + col0);
#pragma unroll
                for (int bj = 0; bj < 2; ++bj)
#pragma unroll
                    for (int n = 0; n < 2; ++n) { const f32x4 bv = *(const f32x4*)(bp + bj * HALF + n * 16); *(f32x4*)(xp + bj * HALF + n * 16) = bv + gv[bj][n] * acc[ai][bj][m][n]; } }
    }
};
struct EpiLruGate {
    static constexpr bool PERM = true, AFTER_DRAIN = false;
    bf16_t* Z; const float* ba; const float* bx; const float* lam;
    __device__ __forceinline__ void operator()(const f32x4 (&acc)[2][2][4][2], const Unit& u, int wr, int wc, int fr, int fq) const {
        const int n = u.pn >> 2, gq = u.pn & 3, d = gq & 1; const bool isx = gq >= 2;
        const int row0 = u.pm * BM + wr * 64 + fr, ct0 = wc * 32 + 8 * fq;
        float bias[2][8], spl[2][8];
#pragma unroll
        for (int bj = 0; bj < 2; ++bj)
#pragma unroll
            for (int e = 0; e < 8; ++e) { const int c = d * 2048 + n * 256 + ct0 + bj * HALF + e; bias[bj][e] = isx ? bx[c] : ba[c];
                spl[bj][e] = isx ? 0.f : lam[c]; }
#pragma unroll
        for (int ai = 0; ai < 2; ++ai)
#pragma unroll
            for (int m = 0; m < 4; ++m) { const int rr = row0 + ai * HALF + m * 16;
                bf16_t* rowp = Z + ((size_t)((rr >> 5) * 64 + u.pn * 2) * 32 + (rr & 31)) * 128 + ct0;
#pragma unroll
                for (int bj = 0; bj < 2; ++bj) { float v[8];
#pragma unroll
                    for (int e = 0; e < 4; ++e) { v[e] = acc[ai][bj][m][0][e]; v[4 + e] = acc[ai][bj][m][1][e]; }
#pragma unroll
                    for (int e = 0; e < 8; ++e) { const float r = __builtin_amdgcn_rcpf(1.f + __expf(-(v[e] + bias[bj][e]))); v[e] = isx ? r : r * spl[bj][e]; }
                    u32x4 w; w.x = cvt_pk_bf16(v[0], v[1]); w.y = cvt_pk_bf16(v[2], v[3]); w.z = cvt_pk_bf16(v[4], v[5]); w.w = cvt_pk_bf16(v[6], v[7]);
                    *(u32x4*)(rowp + bj * 32 * 128) = w; } }
    }
};
template <class Epi, class Sched, bool ALIGN_EPI = false, bool SP2 = false>
__device__ __forceinline__ void gemm_phase(PG8_LAS unsigned char* lds, const Gemm g, const Sched& S, const Epi& E) {
    const int tid = threadIdx.x, wid = __builtin_amdgcn_readfirstlane(tid >> 6), lane = tid & 63, wr = wid >> 2, wc = wid & 3, fr = lane & 15, fq = lane >> 4;
    const int K = g.K, nt = K / BK;
    unsigned voffA[2], voffB[2];
#pragma unroll
    for (int i = 0; i < 2; ++i) { int R, C; stage_rc(tid * 16 + i * 8192, R, C); const int Rb = Epi::PERM ? ((R & ~31) + perm32(R & 31)) : R;
        voffA[i] = (unsigned)(R * g.lda + C) * 2u; voffB[i] = (unsigned)(Rb * g.ldb + C) * 2u; }
    const size_t kstep = (size_t)(BK * 2);
    const size_t hstepA = (size_t)HALF * g.lda * 2, hstepB = (size_t)HALF * g.ldb * 2;
    const size_t tstepA = 2 * hstepA, tstepB = 2 * hstepB;
    const unsigned ldsw = (unsigned)wid * 1024u;
    const int aoff = lds_byte(wr * 64 + fr, fq * 8), boff = lds_byte(wc * 32 + fr, fq * 8);
#define PG8_SA(b, h) (((b) * 2 + (h)) * HTB)
#define PG8_SB(b, h) ((4 + (b) * 2 + (h)) * HTB)
#define PG8_STAGE(bufoff, gbase, voff) do { _Pragma("unroll") for (int _i = 0; _i < 2; ++_i) \
        __builtin_amdgcn_global_load_lds((const unsigned*)((const char*)(gbase) + (voff)[_i]), (PG8_LAS unsigned*)(lds + (bufoff) + ldsw + _i * 8192), 16, 0, 0); } while (0)
#define PG8_LDA(dst, b, h) do { _Pragma("unroll") for (int m = 0; m < 4; ++m) _Pragma("unroll") for (int k = 0; k < 2; ++k) dst[m][k] = *(const PG8_LAS bf16x8*)(lds + PG8_SA(b, h) + aoff + m * 2048 + k * 1024); } while (0)
#define PG8_LDB(dst, b, h) do { _Pragma("unroll") for (int n = 0; n < 2; ++n) _Pragma("unroll") for (int k = 0; k < 2; ++k) dst[n][k] = *(const PG8_LAS bf16x8*)(lds + PG8_SB(b, h) + boff + n * 2048 + k * 1024); } while (0)
#define PG8_MMA(ai, bj, At, Bt) do { __builtin_amdgcn_s_setprio(1); _Pragma("unroll") for (int m = 0; m < 4; ++m) _Pragma("unroll") for (int n = 0; n < 2; ++n) _Pragma("unroll") for (int k = 0; k < 2; ++k) \
        acc[ai][bj][m][n] = __builtin_amdgcn_mfma_f32_16x16x32_bf16(Bt[n][k], At[m][k], acc[ai][bj][m][n], 0, 0, 0); __builtin_amdgcn_s_setprio(0); } while (0)
#define PG8_WAIT_V(n) asm volatile("s_waitcnt vmcnt(" #n ")" ::: "memory")
#define PG8_WAIT_L(n) asm volatile("s_waitcnt lgkmcnt(" #n ")" ::: "memory")
#define PG8_BAR __builtin_amdgcn_s_barrier()
#define PG8_SCHED __builtin_amdgcn_sched_barrier(0)
    Unit cur, nxt; int ui = 0;
    if (!S.next(0, cur)) return;
    f32x4 acc[2][2][4][2];
#pragma unroll
    for (int a = 0; a < 2; ++a)
#pragma unroll
        for (int b = 0; b < 2; ++b)
#pragma unroll
            for (int m = 0; m < 4; ++m)
#pragma unroll
                for (int n = 0; n < 2; ++n) acc[a][b][m][n] = (f32x4){0.f, 0.f, 0.f, 0.f};
    bf16x8 At[4][2], B0[2][2], B1[2][2];
    const char* cA = (const char*)g.A + (size_t)cur.pm * tstepA + S.a_off(cur); const char* cB = (const char*)g.Bt + (size_t)cur.pn * tstepB;
    S.a_ready(cur);
    if constexpr (SP2) {
        PG8_STAGE(PG8_SB(0, 0), cB, voffB); PG8_STAGE(PG8_SB(0, 1), cB + hstepB, voffB); PG8_STAGE(PG8_SA(0, 0), cA, voffA); PG8_STAGE(PG8_SA(0, 1), cA + hstepA, voffA);
        if (wr == 1) PG8_BAR;
        PG8_WAIT_V(2); PG8_BAR;
        PG8_STAGE(PG8_SB(1, 0), cB + kstep, voffB); PG8_STAGE(PG8_SA(1, 0), cA + kstep, voffA); PG8_STAGE(PG8_SB(1, 1), cB + hstepB + kstep, voffB);
        PG8_WAIT_V(6); PG8_BAR;
    } else {
        PG8_STAGE(PG8_SB(0, 0), cB, voffB); PG8_STAGE(PG8_SA(0, 0), cA, voffA); PG8_STAGE(PG8_SB(0, 1), cB + hstepB, voffB); PG8_STAGE(PG8_SA(0, 1), cA + hstepA, voffA);
        if (wr == 1) PG8_BAR;
        PG8_WAIT_V(4); PG8_BAR;
        PG8_STAGE(PG8_SB(1, 0), cB + kstep, voffB); PG8_STAGE(PG8_SA(1, 0), cA + kstep, voffA); PG8_STAGE(PG8_SB(1, 1), cB + hstepB + kstep, voffB);
        PG8_WAIT_V(6); PG8_BAR;
    }
    for (;;) {
        const bool has_next = S.next(ui + 1, nxt);
        const char* nA = has_next ? (const char*)g.A + (size_t)nxt.pm * tstepA + S.a_off(nxt) : cA; const char* nB = has_next ? (const char*)g.Bt + (size_t)nxt.pn * tstepB : cB;
        _Pragma("unroll 1") for (int t = 0; t < nt; t += 2) {
            const bool last = (t == nt - 2);
            const char* a1 = cA + (size_t)(t + 1) * kstep;
            const char* a2 = last ? nA : cA + (size_t)(t + 2) * kstep; const char* b2 = last ? nB : cB + (size_t)(t + 2) * kstep;
            const char* a3 = a2 + kstep; const char* b3 = b2 + kstep;
            if (last && has_next) S.a_ready(nxt);
            if constexpr (SP2) {
            PG8_LDB(B0, 0, 0); PG8_LDB(B1, 0, 1); PG8_SCHED; PG8_LDA(At, 0, 0); PG8_STAGE(PG8_SA(1, 1), a1 + hstepA, voffA);
            PG8_WAIT_V(8); PG8_WAIT_L(0); PG8_BAR; PG8_MMA(0, 0, At, B0); PG8_MMA(0, 1, At, B1); PG8_BAR; PG8_SCHED;
            PG8_LDA(At, 0, 1); PG8_STAGE(PG8_SB(0, 0), b2, voffB); PG8_STAGE(PG8_SB(0, 1), b2 + hstepB, voffB); PG8_STAGE(PG8_SA(0, 0), a2, voffA);
            PG8_WAIT_V(8); PG8_WAIT_L(0); PG8_BAR; PG8_MMA(1, 0, At, B0); PG8_MMA(1, 1, At, B1); PG8_BAR; PG8_SCHED;
            PG8_LDB(B0, 1, 0); PG8_LDB(B1, 1, 1); PG8_SCHED; PG8_LDA(At, 1, 0); PG8_STAGE(PG8_SA(0, 1), a2 + hstepA, voffA);
            PG8_WAIT_V(8); PG8_WAIT_L(0); PG8_BAR; PG8_MMA(0, 0, At, B0); PG8_MMA(0, 1, At, B1); PG8_BAR; PG8_SCHED;
            PG8_LDA(At, 1, 1); PG8_STAGE(PG8_SB(1, 0), b3, voffB); PG8_STAGE(PG8_SB(1, 1), b3 + hstepB, voffB); PG8_STAGE(PG8_SA(1, 0), a3, voffA);
            PG8_WAIT_V(8); PG8_WAIT_L(0); PG8_BAR; PG8_MMA(1, 0, At, B0); PG8_MMA(1, 1, At, B1); PG8_BAR; PG8_SCHED;
            } else {
            PG8_LDB(B0, 0, 0); PG8_SCHED; PG8_LDA(At, 0, 0); PG8_STAGE(PG8_SA(1, 1), a1 + hstepA, voffA);
            PG8_WAIT_L(8); PG8_BAR; PG8_WAIT_L(0); PG8_MMA(0, 0, At, B0); PG8_BAR; PG8_SCHED;
            PG8_LDB(B1, 0, 1); PG8_STAGE(PG8_SB(0, 0), b2, voffB);
            PG8_BAR; PG8_WAIT_L(0); PG8_MMA(0, 1, At, B1); PG8_BAR;
            PG8_LDA(At, 0, 1); PG8_STAGE(PG8_SA(0, 0), a2, voffA);
            PG8_BAR; PG8_WAIT_L(0); PG8_MMA(1, 0, At, B0); PG8_BAR; PG8_SCHED;
            PG8_STAGE(PG8_SB(0, 1), b2 + hstepB, voffB);
            PG8_WAIT_V(6); PG8_BAR; PG8_MMA(1, 1, At, B1); PG8_BAR;
            PG8_LDB(B0, 1, 0); PG8_SCHED; PG8_LDA(At, 1, 0); PG8_STAGE(PG8_SA(0, 1), a2 + hstepA, voffA);
            PG8_WAIT_L(8); PG8_BAR; PG8_WAIT_L(0); PG8_MMA(0, 0, At, B0); PG8_BAR; PG8_SCHED;
            PG8_LDB(B1, 1, 1); PG8_STAGE(PG8_SB(1, 0), b3, voffB);
            PG8_BAR; PG8_WAIT_L(0); PG8_MMA(0, 1, At, B1); PG8_BAR;
            PG8_LDA(At, 1, 1); PG8_STAGE(PG8_SA(1, 0), a3, voffA);
            PG8_BAR; PG8_WAIT_L(0); PG8_MMA(1, 0, At, B0); PG8_BAR; PG8_SCHED;
            PG8_STAGE(PG8_SB(1, 1), b3 + hstepB, voffB);
            PG8_WAIT_V(6); PG8_BAR; PG8_MMA(1, 1, At, B1); PG8_BAR;
            }
        }
        if constexpr (ALIGN_EPI) { if (wr == 0) PG8_BAR; }
        if constexpr (!Epi::AFTER_DRAIN) { E(acc, cur, wr, wc, fr, fq); S.done(cur); }
        if (!has_next) break;
#pragma unroll
        for (int a = 0; a < 2; ++a)
#pragma unroll
            for (int b = 0; b < 2; ++b)
#pragma unroll
                for (int m = 0; m < 4; ++m)
#pragma unroll
                    for (int n = 0; n < 2; ++n) acc[a][b][m][n] = (f32x4){0.f, 0.f, 0.f, 0.f};
        cur = nxt; cA = nA; cB = nB; ++ui;
        if constexpr (ALIGN_EPI) { if (wr == 1) PG8_BAR; }
    }
    PG8_WAIT_V(0);
    if constexpr (!ALIGN_EPI) { if (wr == 0) PG8_BAR; }
    PG8_BAR;
    if constexpr (Epi::AFTER_DRAIN) { E.fused(acc, cur, wr, wc, fr, fq, lds, wid, lane); S.done(cur); }
#undef PG8_SA
#undef PG8_SB
#undef PG8_STAGE
#undef PG8_LDA
#undef PG8_LDB
#undef PG8_MMA
#undef PG8_WAIT_V
#undef PG8_WAIT_L
#undef PG8_BAR
#undef PG8_SCHED
}
}

typedef unsigned short bf16;
#define LASQ __attribute__((address_space(3)))
typedef float f32x4 __attribute__((ext_vector_type(4)));
typedef unsigned u32x4 __attribute__((ext_vector_type(4)));
typedef unsigned u32x2 __attribute__((ext_vector_type(2)));
constexpr int D = 2048, NB = 2, SEQ = 8192, CTX = 256, T = SEQ + CTX, M = NB * T, FF = 8192;
constexpr int ACOLS = 3712, BCOLS = 3104, PA_LD = 3840, PB_LD = 3328, NAB = 7168;
constexpr size_t MiB = 1u << 20;
constexpr size_t WS_MODV = 1 * MiB, WS_GDP = 2 * MiB;
constexpr size_t WS_WAB = 8 * MiB, WS_WOUT = 36 * MiB, WS_WLORA = 44 * MiB;
constexpr size_t WS_X = 48 * MiB, WS_HR = 180 * MiB, WS_MAIN = 246 * MiB, WS_END = 768 * MiB;
constexpr size_t MN_PA = WS_MAIN + 0 * MiB, MN_PB = WS_MAIN + 124 * MiB, MN_KV = WS_MAIN + 232 * MiB;
constexpr size_t MN_R = WS_MAIN + 364 * MiB, MN_V = WS_MAIN + 397 * MiB, MN_K = WS_MAIN + 430 * MiB;
constexpr size_t MN_O = WS_MAIN + 0 * MiB, MN_YD0 = WS_MAIN + 66 * MiB, MN_YD1 = WS_MAIN + 463 * MiB, MN_RA = WS_MAIN + 124 * MiB, MN_NT = WS_MAIN + 190 * MiB, MN_WKT = WS_MAIN + 256 * MiB;
constexpr size_t WS_GAM = 4 * MiB, WS_SPL = 7 * MiB;
constexpr size_t MN_W1_0 = WS_MAIN + 124 * MiB, MN_W2_0 = WS_MAIN + 156 * MiB, MN_U0 = WS_MAIN + 188 * MiB;
constexpr size_t MN_WLIN = WS_MAIN + 0 * MiB, MN_WLOUT = WS_MAIN + 16 * MiB, MN_WG = WS_MAIN + 24 * MiB, MN_W1_1 = WS_MAIN + 28 * MiB, MN_W2_1 = WS_MAIN + 60 * MiB;
constexpr size_t MN_GATE = WS_MAIN + 92 * MiB, MN_Z = WS_MAIN + 158 * MiB, MN_U1 = WS_MAIN + 158 * MiB;
constexpr size_t OT_GG = 0 * MiB, OT_WA0 = 33 * MiB, OT_LA = 99 * MiB, OT_XBR = 0 * MiB, OT_CAR = 66 * MiB, OT_Y = 0 * MiB;
constexpr int LDS_BYTES = 147456;
constexpr int NPH = 27;
constexpr int RCH = 132, RNCH = 64;
constexpr int LCH = 32, LNCH = T / LCH;

struct Args { const float* in[36]; float* out; unsigned char* ws; int ph_lo, ph_hi; };

__device__ __forceinline__ float bf2f(bf16 u) { return __builtin_bit_cast(float, (unsigned)u << 16); }

typedef float f32x2v __attribute__((ext_vector_type(2)));
typedef __bf16 bf16x2v __attribute__((ext_vector_type(2)));
__device__ __forceinline__ unsigned pk2(float lo, float hi) { const f32x2v v = {lo, hi}; const bf16x2v b = __builtin_convertvector(v, bf16x2v); return __builtin_bit_cast(unsigned, b); }
__device__ __forceinline__ unsigned f2bf(float f) { return pk2(f, 0.f) & 0xffffu; }
__device__ __forceinline__ float lo16(unsigned w) { return __builtin_bit_cast(float, w << 16); }
__device__ __forceinline__ float hi16(unsigned w) { return __builtin_bit_cast(float, w & 0xffff0000u); }
__device__ __forceinline__ float sigm(float x) { return __builtin_amdgcn_rcpf(1.f + __expf(-x)); }
__device__ __forceinline__ float softplus_(float x) { return x > 20.f ? x : log1pf(__expf(x)); }
__device__ __forceinline__ float silu_(float x) { return x * sigm(x); }
__device__ __forceinline__ float gelu_tanh(float x) { const float u = 0.7978845608028654f * (x + 0.044715f * x * x * x); return x * sigm(2.f * u); }
__device__ __forceinline__ float tanh_(float x) { return 2.f * sigm(2.f * x) - 1.f; }
__device__ __forceinline__ float wave_sum(float v) {
#pragma unroll
    for (int o = 1; o < 64; o <<= 1) v += __shfl_xor(v, o);
    return v;
}
#define LDS_BARRIER() do { asm volatile("s_waitcnt lgkmcnt(0)" ::: "memory"); __builtin_amdgcn_s_barrier(); asm volatile("" ::: "memory"); } while (0)
#define WAVE_LDS_SYNC() do { asm volatile("s_waitcnt lgkmcnt(0)" ::: "memory"); __builtin_amdgcn_wave_barrier(); } while (0)

#define XB_TMO      128
#define XB_XCNT(j)  (256  + 64 * (j))
#define XB_XSUB(j)  (1280 + 64 * (j))
#define XB_XGEN(j)  (2304 + 64 * (j))
#define XB_TOP      3328
#define XB_TOPGEN   3392
#define XCD_BAR_WORDS 3456
#define XB_SPIN_CAP (1u << 18)

__device__ __forceinline__ unsigned xb_ld(unsigned* p)              { return __hip_atomic_load(p, __ATOMIC_RELAXED, __HIP_MEMORY_SCOPE_AGENT); }
__device__ __forceinline__ unsigned xb_add(unsigned* p, unsigned v) { return __hip_atomic_fetch_add(p, v, __ATOMIC_RELAXED, __HIP_MEMORY_SCOPE_AGENT); }
__device__ __forceinline__ unsigned xb_xcc_id() { return (unsigned)__builtin_amdgcn_s_getreg((3 << 11) | 20) & 0xFu; }
#define XB_SPIN(cond, bar) do { unsigned _sp = 0; while (cond) { __builtin_amdgcn_s_sleep(1); \
    if ((++_sp & 255u) == 0u) { if (xb_ld(&(bar)[XB_TMO])) break; if (_sp > XB_SPIN_CAP) { atomicAdd(&(bar)[XB_TMO], 1u); break; } } } } while (0)

struct XcdBarrier {
    unsigned* bar; unsigned x;
    volatile unsigned* st;
};

__device__ __forceinline__ XcdBarrier xcd_barrier_post(unsigned* bar, volatile unsigned* st) {
    XcdBarrier b; b.bar = bar; b.x = xb_xcc_id(); b.st = st;
    if (threadIdx.x == 0) (void)xb_add(&bar[XB_XCNT(b.x)], 1u);
    return b;
}
__device__ __forceinline__ void xcd_barrier_complete(unsigned* bar, unsigned x, unsigned& nloc, unsigned& nx) {
    const unsigned G = gridDim.x * gridDim.y * gridDim.z;
    unsigned sum, cnt, mine, sp = 0u;
    for (;;) {
        sum = 0u; cnt = 0u; mine = 0u;
#pragma unroll
        for (unsigned j = 0; j < 16; ++j) { const unsigned c = xb_ld(&bar[XB_XCNT(j)]); sum += c; cnt += (c > 0u) ? 1u : 0u; mine = (j == x) ? c : mine; }
        if (sum == G) break;
        __builtin_amdgcn_s_sleep(1);
        if ((++sp & 255u) == 0u) { if (xb_ld(&bar[XB_TMO])) break; if (sp > XB_SPIN_CAP) { atomicAdd(&bar[XB_TMO], 1u); break; } }
    }
    nloc = mine > 0u ? mine : 1u; nx = cnt > 0u ? cnt : 1u;
}

__device__ __forceinline__ void xcd_barrier(const XcdBarrier& b) {
    asm volatile("s_waitcnt vmcnt(0)" ::: "memory");
    __syncthreads();
    if (threadIdx.x == 0) {
        unsigned* bar = b.bar;
        __builtin_amdgcn_s_waitcnt(0);
        unsigned nloc = b.st[0], nx = b.st[1];
        if (nloc == 0u) { xcd_barrier_complete(bar, b.x, nloc, nx); b.st[0] = nloc; b.st[1] = nx; }
        const unsigned old = xb_add(&bar[XB_XSUB(b.x)], 1u);
        const unsigned gen = old / nloc;
        if (old + 1u == (gen + 1u) * nloc) {
            __builtin_amdgcn_fence(__ATOMIC_RELEASE, "agent");
            asm volatile("s_waitcnt vmcnt(0)" ::: "memory");
            const unsigned og = xb_add(&bar[XB_TOP], 1u);
            const unsigned tg = og / nx;
            if (og + 1u == (tg + 1u) * nx) xb_add(&bar[XB_TOPGEN], 1u);
            else XB_SPIN(xb_ld(&bar[XB_TOPGEN]) == tg, bar);
            __builtin_amdgcn_fence(__ATOMIC_ACQUIRE, "agent");
            xb_add(&bar[XB_XGEN(b.x)], 1u);
            asm volatile("s_waitcnt vmcnt(0)" ::: "memory");
        } else {
            XB_SPIN(xb_ld(&bar[XB_XGEN(b.x)]) == gen, bar);
            __builtin_amdgcn_fence(__ATOMIC_ACQUIRE, "agent");
            asm volatile("s_waitcnt vmcnt(0)" ::: "memory");
        }
    }
    __syncthreads();
}


struct Ctx { unsigned char* lds; int tid, lane, wave, G, bid, gw, NGW; };

__device__ __forceinline__ int scan_t(int d, int sp) { return d ? (sp < CTX ? (CTX - 1 - sp) : (T + CTX - 1 - sp)) : sp; }

__device__ __forceinline__ void xpose_item(const float* W, int ldw, bf16* WT, int ldt, int nblk, float* scr, int item, int lane) {
    const int kb = item / nblk, nb = item % nblk, k0 = 64 * kb, n0 = 32 * nb;
    f32x4 t[8];
#pragma unroll
    for (int i = 0; i < 8; ++i) t[i] = *(const f32x4*)(W + (size_t)(k0 + 8 * i + (lane >> 3)) * ldw + n0 + 4 * (lane & 7));
#pragma unroll
    for (int i = 0; i < 8; ++i) { float* s = scr + (8 * i + (lane >> 3)) * 33 + 4 * (lane & 7); s[0] = t[i][0]; s[1] = t[i][1]; s[2] = t[i][2]; s[3] = t[i][3]; }
    WAVE_LDS_SYNC();
    const int c = lane & 7;
#pragma unroll
    for (int j = 0; j < 4; ++j) { const int n = (lane >> 3) + 8 * j; const float* s = scr + (8 * c) * 33 + n;
        u32x4 o; o.x = pk2(s[0 * 33], s[1 * 33]); o.y = pk2(s[2 * 33], s[3 * 33]); o.z = pk2(s[4 * 33], s[5 * 33]); o.w = pk2(s[6 * 33], s[7 * 33]);
        *(u32x4*)(WT + (size_t)(n0 + n) * ldt + k0 + 8 * c) = o; }
    WAVE_LDS_SYNC();
}
__device__ __forceinline__ void xpose(const Ctx& F, const float* W, int ldw, int K, int N, bf16* WT, int ldt) {
    float* scr = (float*)(F.lds + F.wave * 16384);
    const int nblk = N / 32, nit = (K / 64) * nblk;
    for (int it = F.gw; it < nit; it += F.NGW) xpose_item(W, ldw, WT, ldt, nblk, scr, it, F.lane);
}

__device__ __forceinline__ void mod_gemv(const Ctx& F, const float* c, const float* c_ctx, const float* mod_w, const float* mod_b, float* modv) {
    float* sv = (float*)F.lds;
    float* red = (float*)(F.lds + 32768);
    for (int i = F.tid; i < 3 * D; i += 512) { const int r = i / D, k = i % D; const float x = (r < 2) ? c[r * D + k] : c_ctx[k]; sv[i] = silu_(x); }
    __syncthreads();
    const int l4 = F.tid & 15, kg = F.tid >> 4;
    for (int it = F.bid; it < 2 * 192; it += F.G) {
        const int layer = it / 192, n0 = (it % 192) * 64;
        const float* Wp = mod_w + (size_t)layer * D * 12288 + n0 + 4 * l4;
        f32x4 a0 = {0.f, 0.f, 0.f, 0.f}, a1 = a0, a2 = a0;
#pragma unroll 8
        for (int kk = 0; kk < 64; ++kk) { const int k = kg * 64 + kk; const f32x4 w = *(const f32x4*)(Wp + (size_t)k * 12288);
            a0 += w * sv[k]; a1 += w * sv[D + k]; a2 += w * sv[2 * D + k]; }
        *(f32x4*)(red + (kg * 3 + 0) * 64 + 4 * l4) = a0; *(f32x4*)(red + (kg * 3 + 1) * 64 + 4 * l4) = a1; *(f32x4*)(red + (kg * 3 + 2) * 64 + 4 * l4) = a2;
        __syncthreads();
        if (F.tid < 192) { const int r = F.tid / 64, n = F.tid % 64; float s = mod_b[layer * 12288 + n0 + n];
            for (int g = 0; g < 32; ++g) s += red[(g * 3 + r) * 64 + n];
            modv[(size_t)(layer * 3 + r) * 12288 + n0 + n] = s; }
        __syncthreads();
    }
}

__device__ __forceinline__ void norm_mod(const Ctx& F, const float* X, const float* xin, const float* cin, const float* g, const float* modv, int ishift, int iscale, bf16* H, int latent_only) {
    for (int m = F.gw; m < M; m += F.NGW) {
        const int b = m / T, t = m % T;
        if (latent_only && t < CTX) continue;
        const float* xr = xin ? (t < CTX ? cin + (size_t)(b * CTX + t) * D : xin + (size_t)(b * SEQ + t - CTX) * D) : X + (size_t)m * D;
        const int mi = (t < CTX) ? 2 : b;
        const float* sh = modv + (size_t)(mi * 6 + ishift) * D; const float* sc = modv + (size_t)(mi * 6 + iscale) * D;
        f32x4 v[8]; float s = 0.f;
#pragma unroll
        for (int j = 0; j < 8; ++j) { v[j] = *(const f32x4*)(xr + 4 * F.lane + 256 * j); s += (v[j].x * v[j].x + v[j].y * v[j].y) + (v[j].z * v[j].z + v[j].w * v[j].w); }
        const float rstd = rsqrtf(wave_sum(s) * (1.f / D) + 1e-6f);
#pragma unroll
        for (int j = 0; j < 8; ++j) { const int col = 4 * F.lane + 256 * j;
            const f32x4 gg = *(const f32x4*)(g + col), s1 = *(const f32x4*)(sc + col), s0 = *(const f32x4*)(sh + col);
            const f32x4 y = v[j] * rstd * gg * (s1 + 1.f) + s0;
            u32x2 o; o.x = pk2(y.x, y.y); o.y = pk2(y.z, y.w);
            *(u32x2*)(H + (size_t)m * D + col) = o; }
    }
}
__device__ __forceinline__ void final_norm(const Ctx& F, const float* X, const float* g, float* out) {
    for (int r = F.gw; r < NB * SEQ; r += F.NGW) {
        const int b = r / SEQ, tl = r % SEQ; const float* xr = X + (size_t)(b * T + CTX + tl) * D;
        f32x4 v[8]; float s = 0.f;
#pragma unroll
        for (int j = 0; j < 8; ++j) { v[j] = *(const f32x4*)(xr + 4 * F.lane + 256 * j); s += (v[j].x * v[j].x + v[j].y * v[j].y) + (v[j].z * v[j].z + v[j].w * v[j].w); }
        const float rstd = rsqrtf(wave_sum(s) * (1.f / D) + 1e-6f);
#pragma unroll
        for (int j = 0; j < 8; ++j) { const int col = 4 * F.lane + 256 * j; *(f32x4*)(out + (size_t)r * D + col) = v[j] * rstd * *(const f32x4*)(g + col); }
    }
}

__device__ __forceinline__ void rwkv_mix(const Ctx& F, const bf16* PA, const float* mu, bf16* Rr, bf16* Rk, bf16* Rv, bf16* LA) {
    for (int m = F.gw; m < M; m += F.NGW) {
        const int t = m % T;
        const bool hp = (t != 0) && (t != CTX), hn = (t != CTX - 1) && (t != T - 1);
        const bf16* p0 = PA + (size_t)m * PA_LD;
        u32x4 cur[8], pv[8], nv[8];
#pragma unroll
        for (int q = 0; q < 8; ++q) { const int g8 = F.lane + 64 * q; const int c0 = (g8 < ACOLS / 8 ? g8 : 0) * 8;
            cur[q] = *(const u32x4*)(p0 + c0); pv[q] = (u32x4){0u, 0u, 0u, 0u}; nv[q] = (u32x4){0u, 0u, 0u, 0u};
            if (hp) pv[q] = *(const u32x4*)(p0 - PA_LD + c0);
            if (hn) nv[q] = *(const u32x4*)(p0 + PA_LD + c0); }
#pragma unroll
        for (int q = 0; q < 8; ++q) { const int g8 = F.lane + 64 * q; if (g8 >= ACOLS / 8) continue;
            const int c0 = g8 * 8;
            float y[8];
#pragma unroll
            for (int e = 0; e < 4; ++e) {
                const float pl = lo16(cur[q][e]), ph = hi16(cur[q][e]);
                y[2 * e] = pl + mu[c0 + 2 * e] * (lo16(pv[q][e]) - pl) + mu[ACOLS + c0 + 2 * e] * (lo16(nv[q][e]) - pl);
                y[2 * e + 1] = ph + mu[c0 + 2 * e + 1] * (hi16(pv[q][e]) - ph) + mu[ACOLS + c0 + 2 * e + 1] * (hi16(nv[q][e]) - ph);
            }
            bf16* dst;
            if (c0 < 1024) dst = Rr + (size_t)m * 1024 + c0;
            else if (c0 < 2048) dst = Rk + (size_t)m * 1024 + (c0 - 1024);
            else if (c0 < 3072) dst = Rv + (size_t)m * 1024 + (c0 - 2048);
            else if (c0 < 3328) { dst = LA + (size_t)m * 768 + (c0 - 3072);
#pragma unroll
                for (int e = 0; e < 8; ++e) y[e] = sigm(y[e]); }
            else if (c0 < 3520) { const int qq = c0 - 3328, d = qq / 96; dst = LA + (size_t)m * 768 + 256 + d * 256 + (qq - d * 96);
#pragma unroll
                for (int e = 0; e < 8; ++e) y[e] = tanh_(y[e]); }
            else { const int qq = c0 - 3520, d = qq / 96; dst = LA + (size_t)m * 768 + 256 + d * 256 + 96 + (qq - d * 96); }
            u32x4 o; o.x = pk2(y[0], y[1]); o.y = pk2(y[2], y[3]); o.z = pk2(y[4], y[5]); o.w = pk2(y[6], y[7]);
            *(u32x4*)dst = o;
        }
        if (F.lane < 16) { const int d = F.lane >> 3, j = F.lane & 7; const u32x4 z = {0u, 0u, 0u, 0u}; *(u32x4*)(LA + (size_t)m * 768 + 256 + d * 256 + 192 + 8 * j) = z; }
    }
}

typedef short bf16x8v __attribute__((ext_vector_type(8)));
constexpr int GC = 64, GNC = T / GC;
constexpr int GL_CUM = 0, GL_QI = 32768, GL_KI = 50176, GL_VV = 67584, GL_PP = 104448, GL_RSQ = 113664, GL_GW = 115712, GL_GD = 123904;
constexpr int TLD = 72;
constexpr int QLD = 136, VLD = 264, PLD = 72;
struct GlaP { const bf16* PB; const float *gw2, *gb; bf16* KV; float* GDP; };
__device__ __forceinline__ int gla_chunk_of(int d, int pc) { return d ? (pc < 4 ? 3 - pc : 135 - pc) : pc; }
__device__ __forceinline__ void gla_gates(const Ctx& F, const GlaP& P, int b, int h, int d, int pos0) {
    LASQ float* cum = (LASQ float*)(F.lds + GL_CUM); LASQ float* gwl = (LASQ float*)(F.lds + GL_GW); LASQ float* gdl = (LASQ float*)(F.lds + GL_GD);
    const int p = F.tid >> 3, kg = F.tid & 7;
    { const int e = F.tid >> 5, q = F.tid & 31; *(LASQ f32x4*)(gwl + e * 128 + 4 * q) = *(const f32x4*)(P.gw2 + (size_t)(d * 16 + e) * 512 + h * 128 + 4 * q); }
    if (kg < 4) { const bf16* row = P.PB + (size_t)(b * T + pos0 + p) * PB_LD + 3072 + d * 16 + 4 * kg; const u32x2 g = *(const u32x2*)row;
        *(LASQ f32x4*)(gdl + p * 16 + 4 * kg) = (f32x4){lo16(g.x), hi16(g.x), lo16(g.y), hi16(g.y)}; }
    LDS_BARRIER();
    f32x4 z[4];
    const float* gbp = P.gb + d * 512 + h * 128 + kg * 16;
#pragma unroll
    for (int q = 0; q < 4; ++q) z[q] = *(const f32x4*)(gbp + 4 * q);
#pragma unroll 2
    for (int e = 0; e < 16; ++e) { const float g = gdl[p * 16 + e]; const LASQ float* gwp = gwl + e * 128 + kg * 16;
#pragma unroll
        for (int q = 0; q < 4; ++q) z[q] += *(const f32x4*)(gwp + 4 * q) * g; }
#pragma unroll
    for (int q = 0; q < 4; ++q) { f32x4 t;
#pragma unroll
        for (int e = 0; e < 4; ++e) { const float nz = -z[q][e]; t[e] = -((nz > 20.f) ? nz : __logf(1.f + __expf(nz))) * (1.f / 16.f); }
        *(LASQ f32x4*)(cum + p * 128 + kg * 16 + 4 * q) = t; }
    LDS_BARRIER();
    if (F.tid < 128) { float tv[GC];
#pragma unroll
        for (int pp = 0; pp < GC; ++pp) tv[pp] = cum[pp * 128 + F.tid];
        float s = 0.f;
        if (d == 0) {
#pragma unroll
            for (int pp = 0; pp < GC; ++pp) { s += tv[pp]; tv[pp] = s; } }
        else {
#pragma unroll
            for (int pp = GC - 1; pp >= 0; --pp) { s += tv[pp]; tv[pp] = s; } }
#pragma unroll
        for (int pp = 0; pp < GC; ++pp) cum[pp * 128 + F.tid] = tv[pp]; }
    LDS_BARRIER();
}
__device__ __forceinline__ bf16x8v lfrag8(const LASQ bf16* p) { return *(const LASQ bf16x8v*)p; }
__device__ __forceinline__ bf16x8v lgather8(const LASQ bf16* p, int stride) { bf16x8v r;
#pragma unroll
    for (int e = 0; e < 8; ++e) r[e] = (short)p[e * stride];
    return r; }
__device__ __forceinline__ void gla_load_v(const Ctx& F, const GlaP& P, int b, int h, int pos0) {
    const int p = F.tid >> 3, kg = F.tid & 7; LASQ bf16* VV = (LASQ bf16*)(F.lds + GL_VV);
    const bf16* row = P.PB + (size_t)(b * T + pos0 + p) * PB_LD + 1024 + h * 256 + kg * 32;
    u32x4 r4[4];
#pragma unroll
    for (int q = 0; q < 4; ++q) r4[q] = *(const u32x4*)(row + 8 * q);
#pragma unroll
    for (int q = 0; q < 4; ++q)
#pragma unroll
        for (int e = 0; e < 4; ++e) { LASQ bf16* d = VV + (kg * 32 + 8 * q + 2 * e) * TLD + p; d[0] = (bf16)(r4[q][e] & 0xffffu); d[TLD] = (bf16)(r4[q][e] >> 16); }
}
__device__ __forceinline__ void gla_kv(const Ctx& F, const GlaP& P) {
    LASQ float* cum = (LASQ float*)(F.lds + GL_CUM); LASQ bf16* KT = (LASQ bf16*)(F.lds + GL_QI); const LASQ bf16* VV = (const LASQ bf16*)(F.lds + GL_VV);
    const int p = F.tid >> 3, kg = F.tid & 7, row = F.lane & 15, quad = F.lane >> 4;
    for (int it = F.bid; it < 16 * GNC; it += F.G) {
        const int seq = it / GNC, c = it % GNC, b = seq >> 3, d = (seq >> 2) & 1, h = seq & 3;
        const int pc = gla_chunk_of(d, c), pos0 = pc * GC;
        gla_load_v(F, P, b, h, pos0);
        gla_gates(F, P, b, h, d, pos0);
        const int tp = d ? 0 : (GC - 1);
        { const bf16* rowp = P.PB + (size_t)(b * T + pos0 + p) * PB_LD + 512 + h * 128 + kg * 16;
          const u32x4 k0 = *(const u32x4*)rowp, k1 = *(const u32x4*)(rowp + 8);
          float kv[16];
#pragma unroll
          for (int e = 0; e < 4; ++e) { kv[2 * e] = lo16(k0[e]); kv[2 * e + 1] = hi16(k0[e]); kv[8 + 2 * e] = lo16(k1[e]); kv[8 + 2 * e + 1] = hi16(k1[e]); }
#pragma unroll
          for (int e = 0; e < 16; ++e) kv[e] *= __expf(cum[tp * 128 + kg * 16 + e] - cum[p * 128 + kg * 16 + e]);
          u32x4 o0, o1;
#pragma unroll
          for (int e = 0; e < 4; ++e) { o0[e] = pk2(kv[2 * e], kv[2 * e + 1]); o1[e] = pk2(kv[8 + 2 * e], kv[8 + 2 * e + 1]); }
#pragma unroll
          for (int e = 0; e < 4; ++e) { LASQ bf16* d0 = KT + (kg * 16 + 2 * e) * TLD + p; d0[0] = (bf16)(o0[e] & 0xffffu); d0[TLD] = (bf16)(o0[e] >> 16);
              LASQ bf16* d1 = KT + (kg * 16 + 8 + 2 * e) * TLD + p; d1[0] = (bf16)(o1[e] & 0xffffu); d1[TLD] = (bf16)(o1[e] >> 16); } }
        if (F.tid < 128) P.GDP[(size_t)it * 128 + F.tid] = __expf(cum[tp * 128 + F.tid]);
        LDS_BARRIER();
        const int v0 = 32 * F.wave;
        f32x4 acc[2][8];
#pragma unroll
        for (int mt = 0; mt < 2; ++mt)
#pragma unroll
            for (int nt = 0; nt < 8; ++nt) acc[mt][nt] = (f32x4){0.f, 0.f, 0.f, 0.f};
#pragma unroll
        for (int ks = 0; ks < 2; ++ks) {
            bf16x8v a[2];
#pragma unroll
            for (int mt = 0; mt < 2; ++mt) a[mt] = lfrag8(VV + (v0 + mt * 16 + row) * TLD + ks * 32 + quad * 8);
#pragma unroll
            for (int nt = 0; nt < 8; ++nt) { const bf16x8v bb = lfrag8(KT + (nt * 16 + row) * TLD + ks * 32 + quad * 8);
#pragma unroll
                for (int mt = 0; mt < 2; ++mt) acc[mt][nt] = __builtin_amdgcn_mfma_f32_16x16x32_bf16(a[mt], bb, acc[mt][nt], 0, 0, 0); }
        }
        bf16* kvp = P.KV + (size_t)it * 32768;
#pragma unroll
        for (int mt = 0; mt < 2; ++mt)
#pragma unroll
            for (int nt = 0; nt < 8; ++nt)
#pragma unroll
                for (int j = 0; j < 4; ++j) kvp[(size_t)(v0 + mt * 16 + quad * 4 + j) * 128 + nt * 16 + row] = (bf16)f2bf(acc[mt][nt][j]);
        LDS_BARRIER();
    }
}
__device__ __forceinline__ void gla_carry(const Ctx& F, const GlaP& P) {
    const int nth = F.G * 512;
    for (int i = F.bid * 512 + F.tid; i < 16 * 256 * 16; i += nth) {
        const int k8 = i & 15, v = (i >> 4) & 255, seq = i >> 12;
        float s[8];
#pragma unroll
        for (int e = 0; e < 8; ++e) s[e] = 0.f;
        for (int c0 = 0; c0 < GNC; c0 += 6) {
            u32x4 q[6]; f32x4 d0[6], d1[6];
#pragma unroll
            for (int j = 0; j < 6; ++j) { const size_t sc = (size_t)seq * GNC + c0 + j;
                q[j] = *(const u32x4*)(P.KV + (sc * 256 + v) * 128 + 8 * k8); d0[j] = *(const f32x4*)(P.GDP + sc * 128 + 8 * k8); d1[j] = *(const f32x4*)(P.GDP + sc * 128 + 8 * k8 + 4); }
#pragma unroll
            for (int j = 0; j < 6; ++j) { const size_t sc = (size_t)seq * GNC + c0 + j;
                u32x4 o;
#pragma unroll
                for (int e = 0; e < 4; ++e) o[e] = pk2(s[2 * e], s[2 * e + 1]);
                *(u32x4*)(P.KV + (sc * 256 + v) * 128 + 8 * k8) = o;
                const float dd[8] = {d0[j][0], d0[j][1], d0[j][2], d0[j][3], d1[j][0], d1[j][1], d1[j][2], d1[j][3]};
#pragma unroll
                for (int e = 0; e < 4; ++e) { s[2 * e] = s[2 * e] * dd[2 * e] + lo16(q[j][e]); s[2 * e + 1] = s[2 * e + 1] * dd[2 * e + 1] + hi16(q[j][e]); } }
        }
    }
}
__device__ __forceinline__ void gla_out(const Ctx& F, const GlaP& P, const float* gn, bf16* O) {
    LASQ float* cum = (LASQ float*)(F.lds + GL_CUM); LASQ bf16* QI = (LASQ bf16*)(F.lds + GL_QI); LASQ bf16* KI = (LASQ bf16*)(F.lds + GL_KI); const LASQ bf16* VV = (const LASQ bf16*)(F.lds + GL_VV);
    LASQ bf16* PP = (LASQ bf16*)(F.lds + GL_PP); LASQ float* RSQ = (LASQ float*)(F.lds + GL_RSQ);
    const int p = F.tid >> 3, kg = F.tid & 7, row = F.lane & 15, quad = F.lane >> 4, v0 = 32 * F.wave;
    for (int it = F.bid; it < NB * 4 * GNC; it += F.G) {
        const int pc = it % GNC, bh = it / GNC, b = bh >> 2, h = bh & 3, pos0 = pc * GC;
        gla_load_v(F, P, b, h, pos0);
        f32x4 acc[4][2];
#pragma unroll
        for (int mt = 0; mt < 4; ++mt) { acc[mt][0] = (f32x4){0.f, 0.f, 0.f, 0.f}; acc[mt][1] = (f32x4){0.f, 0.f, 0.f, 0.f}; }
#pragma unroll 1
        for (int d = 0; d < 2; ++d) {
            const int seq = (b * 2 + d) * 4 + h, c = gla_chunk_of(d, pc);
            const bf16* kvp = P.KV + ((size_t)seq * GNC + c) * 32768;
            gla_gates(F, P, b, h, d, pos0);
            bf16x8v kvf[4][2];
#pragma unroll
            for (int ks = 0; ks < 4; ++ks)
#pragma unroll
                for (int nt = 0; nt < 2; ++nt) kvf[ks][nt] = *(const bf16x8v*)(kvp + (size_t)(v0 + nt * 16 + row) * 128 + ks * 32 + quad * 8);
            { const bf16* rowp = P.PB + (size_t)(b * T + pos0 + p) * PB_LD + h * 128 + kg * 16;
              const u32x4 q0 = *(const u32x4*)rowp, q1 = *(const u32x4*)(rowp + 8), k0 = *(const u32x4*)(rowp + 512), k1 = *(const u32x4*)(rowp + 520);
              float qv[16], kv[16];
#pragma unroll
              for (int e = 0; e < 4; ++e) { qv[2 * e] = lo16(q0[e]); qv[2 * e + 1] = hi16(q0[e]); qv[8 + 2 * e] = lo16(q1[e]); qv[8 + 2 * e + 1] = hi16(q1[e]);
                  kv[2 * e] = lo16(k0[e]); kv[2 * e + 1] = hi16(k0[e]); kv[8 + 2 * e] = lo16(k1[e]); kv[8 + 2 * e + 1] = hi16(k1[e]); }
#pragma unroll
              for (int e = 0; e < 16; ++e) { const float cc = cum[p * 128 + kg * 16 + e]; qv[e] *= 0.08838834764831845f * __expf(cc); kv[e] *= __expf(-cc); }
              u32x4 o0, o1, o2, o3;
#pragma unroll
              for (int e = 0; e < 4; ++e) { o0[e] = pk2(qv[2 * e], qv[2 * e + 1]); o1[e] = pk2(qv[8 + 2 * e], qv[8 + 2 * e + 1]); o2[e] = pk2(kv[2 * e], kv[2 * e + 1]); o3[e] = pk2(kv[8 + 2 * e], kv[8 + 2 * e + 1]); }
              *(LASQ u32x4*)(QI + p * QLD + kg * 16) = o0; *(LASQ u32x4*)(QI + p * QLD + kg * 16 + 8) = o1; *(LASQ u32x4*)(KI + p * QLD + kg * 16) = o2; *(LASQ u32x4*)(KI + p * QLD + kg * 16 + 8) = o3; }
            LDS_BARRIER();
#pragma unroll
            for (int tt = 0; tt < 2; ++tt) { const int t = 2 * F.wave + tt, itl = t >> 2, jt = t & 3;
                f32x4 sc = {0.f, 0.f, 0.f, 0.f};
                const bool live = d ? (jt >= itl) : (jt <= itl);
                if (live) {
#pragma unroll
                    for (int ks = 0; ks < 4; ++ks) { const bf16x8v a = lfrag8(QI + (itl * 16 + row) * QLD + ks * 32 + quad * 8), bb = lfrag8(KI + (jt * 16 + row) * QLD + ks * 32 + quad * 8);
                        sc = __builtin_amdgcn_mfma_f32_16x16x32_bf16(a, bb, sc, 0, 0, 0); } }
#pragma unroll
                for (int j = 0; j < 4; ++j) { const int ii = itl * 16 + quad * 4 + j, jj = jt * 16 + row; const bool keep = d ? (jj >= ii) : (jj <= ii);
                    PP[ii * PLD + jj] = (bf16)f2bf(keep ? sc[j] : 0.f); } }
            LDS_BARRIER();
#pragma unroll
            for (int ks = 0; ks < 2; ++ks) {
                bf16x8v bb[2];
#pragma unroll
                for (int nt = 0; nt < 2; ++nt) bb[nt] = lfrag8(VV + (v0 + nt * 16 + row) * TLD + ks * 32 + quad * 8);
#pragma unroll
                for (int mt = 0; mt < 4; ++mt) { const bf16x8v a = lfrag8(PP + (mt * 16 + row) * PLD + ks * 32 + quad * 8);
                    acc[mt][0] = __builtin_amdgcn_mfma_f32_16x16x32_bf16(a, bb[0], acc[mt][0], 0, 0, 0); acc[mt][1] = __builtin_amdgcn_mfma_f32_16x16x32_bf16(a, bb[1], acc[mt][1], 0, 0, 0); }
            }
#pragma unroll
            for (int ks = 0; ks < 4; ++ks) {
#pragma unroll
                for (int mt = 0; mt < 4; ++mt) { const bf16x8v a = lfrag8(QI + (mt * 16 + row) * QLD + ks * 32 + quad * 8);
                    acc[mt][0] = __builtin_amdgcn_mfma_f32_16x16x32_bf16(a, kvf[ks][0], acc[mt][0], 0, 0, 0); acc[mt][1] = __builtin_amdgcn_mfma_f32_16x16x32_bf16(a, kvf[ks][1], acc[mt][1], 0, 0, 0); }
            }
            LDS_BARRIER();
        }
#pragma unroll
        for (int mt = 0; mt < 4; ++mt)
#pragma unroll
            for (int j = 0; j < 4; ++j) { float ss = acc[mt][0][j] * acc[mt][0][j] + acc[mt][1][j] * acc[mt][1][j];
                ss += __shfl_xor(ss, 1); ss += __shfl_xor(ss, 2); ss += __shfl_xor(ss, 4); ss += __shfl_xor(ss, 8);
                if (row == 0) RSQ[F.wave * 64 + mt * 16 + quad * 4 + j] = ss; }
        LDS_BARRIER();
        const bf16* gbase = P.PB + (size_t)(b * T + pos0 + quad * 4) * PB_LD + 2048 + h * 256 + v0 + row; bf16* obase = O + (size_t)(b * T + pos0 + quad * 4) * 2048 + 1024 + h * 256 + v0 + row;
        const float gnv[2] = {gn[v0 + row], gn[v0 + 16 + row]};
#pragma unroll
        for (int mt = 0; mt < 4; ++mt)
#pragma unroll
            for (int j = 0; j < 4; ++j) { const int pr = mt * 16 + quad * 4 + j; float ss = 0.f;
#pragma unroll
                for (int w = 0; w < 8; ++w) ss += RSQ[w * 64 + pr];
                const float rs = rsqrtf(ss * (1.f / 256.f) + 1e-6f);
#pragma unroll
                for (int nt = 0; nt < 2; ++nt) { const float g = bf2f(gbase[(mt * 16 + j) * PB_LD + nt * 16]);
                    obase[(mt * 16 + j) * 2048 + nt * 16] = (bf16)f2bf(acc[mt][nt][j] * rs * gnv[nt] * silu_(g)); } }
        LDS_BARRIER();
    }
}

constexpr int RWC = 64, RWN = T / RWC;
constexpr int RW_CUM = 0, RW_AT = 16384, RW_RT = 25600, RW_BT = 34816, RW_KT = 44032, RW_BH = 53248, RW_KH = 62464, RW_VT = 71680, RW_M1 = 80896, RW_M2 = 97280, RW_M3 = 113664, RW_M4 = 122880, RW_TM2 = 132096;
constexpr int RLD = 72;
struct RwP2 { const bf16 *Rr, *Rk, *Rv, *WA0, *WA1; const float *w0, *a0, *kkw, *kaw; bf16 *RA, *NT, *WKT; float* GAM; bf16 *YD0, *YD1; };
__device__ __forceinline__ void unpack8(const u32x4 w, float (&o)[8]) {
#pragma unroll
    for (int e = 0; e < 4; ++e) { o[2 * e] = lo16(w[e]); o[2 * e + 1] = hi16(w[e]); } }
__device__ __forceinline__ u32x4 pack8(const float (&v)[8]) { u32x4 o;
#pragma unroll
    for (int e = 0; e < 4; ++e) o[e] = pk2(v[2 * e], v[2 * e + 1]);
    return o; }
template <int Q> __device__ __forceinline__ void rw1_scores(LASQ unsigned char* L, int half, int row, int quad) {
    const LASQ bf16* Am = (const LASQ bf16*)(L + ((Q < 2) ? RW_AT : RW_RT)) + row * RLD + quad * 8;
    const LASQ bf16* Bm = (const LASQ bf16*)(L + ((Q & 1) ? RW_KT : RW_BT)) + row * RLD + quad * 8;
    LASQ float* Mf = (LASQ float*)(L + (Q == 0 ? RW_M1 : RW_M2)) + (quad * 4) * 64 + row;
    LASQ bf16* Mb = (LASQ bf16*)(L + (Q == 2 ? RW_M3 : RW_M4)) + (quad * 4) * RLD + row;
#pragma unroll 2
    for (int tt = 0; tt < 8; ++tt) { const int t = half * 8 + tt, mt = t >> 2, nt = t & 3;
        f32x4 acc = {0.f, 0.f, 0.f, 0.f};
        if (nt <= mt) { const LASQ bf16* ap = Am + mt * 16 * RLD; const LASQ bf16* bp = Bm + nt * 16 * RLD;
            acc = __builtin_amdgcn_mfma_f32_16x16x32_bf16(lfrag8(ap), lfrag8(bp), acc, 0, 0, 0); acc = __builtin_amdgcn_mfma_f32_16x16x32_bf16(lfrag8(ap + 32), lfrag8(bp + 32), acc, 0, 0, 0); }
        const int di = mt * 16 + quad * 4 - (nt * 16 + row);
        if (Q < 2) { LASQ float* d = Mf + mt * 16 * 64 + nt * 16;
#pragma unroll
            for (int jj = 0; jj < 4; ++jj) d[jj * 64] = (di + jj > 0) ? acc[jj] : 0.f; }
        else { LASQ bf16* d = Mb + mt * 16 * RLD + nt * 16;
#pragma unroll
            for (int jj = 0; jj < 4; ++jj) d[jj * RLD] = (bf16)(pk2((di + jj >= 0) ? acc[jj] : 0.f, 0.f) & 0xffffu); }
    }
}
template <int Q> __device__ __forceinline__ void rw1_products(LASQ unsigned char* L, int half, int row, int quad, bf16* gout) {
    const LASQ bf16* M3 = (const LASQ bf16*)(L + RW_M3) + row * RLD + quad * 8;
    const LASQ bf16* TX = (const LASQ bf16*)(L + ((Q == 0 || Q == 2) ? RW_CUM : RW_TM2)) + row * RLD + quad * 8;
    const LASQ bf16* Bh = (const LASQ bf16*)(L + RW_BH) + row * RLD + quad * 8;
    const LASQ bf16* Ad = (const LASQ bf16*)(L + (Q == 0 ? RW_RT : (Q == 1 ? RW_M4 : RW_KH))) + (quad * 4) * RLD + row;
    LASQ bf16* CY = (LASQ bf16*)(L + RW_M1) + (quad * 4) * RLD + row;
#pragma unroll 2
    for (int tt = 0; tt < 8; ++tt) { const int t = half * 8 + tt, mt = t >> 2, nt = t & 3;
        f32x4 acc = {0.f, 0.f, 0.f, 0.f};
#pragma unroll
        for (int ks = 0; ks < 2; ++ks) { bf16x8v a, bb;
            if (Q < 2) { a = lfrag8(M3 + mt * 16 * RLD + ks * 32); bb = lfrag8(TX + nt * 16 * RLD + ks * 32); }
            else { a = lfrag8(TX + mt * 16 * RLD + ks * 32); bb = lfrag8(Bh + nt * 16 * RLD + ks * 32); }
            acc = __builtin_amdgcn_mfma_f32_16x16x32_bf16(a, bb, acc, 0, 0, 0); }
        float o[4];
        if (Q != 2) { const LASQ bf16* ad = Ad + mt * 16 * RLD + nt * 16;
#pragma unroll
            for (int jj = 0; jj < 4; ++jj) o[jj] = acc[jj] + bf2f(ad[jj * RLD]); }
        else {
#pragma unroll
            for (int jj = 0; jj < 4; ++jj) o[jj] = acc[jj]; }
        if (Q == 0) { bf16* g = gout + (mt * 16 + quad * 4) * 64 + nt * 16 + row;
#pragma unroll
            for (int jj = 0; jj < 4; ++jj) g[jj * 64] = (bf16)(pk2(o[jj], 0.f) & 0xffffu); }
        else if (Q == 1) { LASQ bf16* d = CY + mt * 16 * RLD + nt * 16;
#pragma unroll
            for (int jj = 0; jj < 4; ++jj) d[jj * RLD] = (bf16)(pk2(o[jj], 0.f) & 0xffffu); }
        else { u32x2 w; w.x = pk2(o[0], o[1]); w.y = pk2(o[2], o[3]); *(u32x2*)(gout + (nt * 16 + row) * 64 + mt * 16 + quad * 4) = w; }
    }
}
__device__ __forceinline__ void rwkv_chunk_prep(const Ctx& F, const RwP2& P) {
    LASQ float* CUM = (LASQ float*)(F.lds + RW_CUM); LASQ bf16* At = (LASQ bf16*)(F.lds + RW_AT); LASQ bf16* Rt = (LASQ bf16*)(F.lds + RW_RT); LASQ bf16* Bt = (LASQ bf16*)(F.lds + RW_BT); LASQ bf16* Kt = (LASQ bf16*)(F.lds + RW_KT);
    LASQ bf16* Bh = (LASQ bf16*)(F.lds + RW_BH); LASQ bf16* Kh = (LASQ bf16*)(F.lds + RW_KH); LASQ bf16* Vt = (LASQ bf16*)(F.lds + RW_VT); LASQ float* M1 = (LASQ float*)(F.lds + RW_M1); LASQ float* M2 = (LASQ float*)(F.lds + RW_M2);
    LASQ bf16* M3 = (LASQ bf16*)(F.lds + RW_M3); LASQ bf16* M4 = (LASQ bf16*)(F.lds + RW_M4); LASQ bf16* TA = (LASQ bf16*)(F.lds + RW_CUM); LASQ bf16* TM2 = (LASQ bf16*)(F.lds + RW_TM2); LASQ bf16* CY = (LASQ bf16*)(F.lds + RW_M1); LASQ float* XA = (LASQ float*)(F.lds + RW_BT);
    const int ri = F.tid >> 3, kg = F.tid & 7, k0 = kg * 8, row = F.lane & 15, quad = F.lane >> 4;
    u32x4 raw[5];
    if (F.bid < 64 * RWN) { const int seq = F.bid / RWN, ch = F.bid % RWN, b = seq >> 5, d = (seq >> 4) & 1, h = seq & 15, c0 = h * 64 + k0; const bf16* WA = d ? P.WA1 : P.WA0;
        const size_t m = (size_t)b * T + scan_t(d, ch * RWC + ri);
        raw[0] = *(const u32x4*)(P.Rr + m * 1024 + c0); raw[1] = *(const u32x4*)(P.Rk + m * 1024 + c0); raw[2] = *(const u32x4*)(P.Rv + m * 1024 + c0);
        raw[3] = *(const u32x4*)(WA + m * 2048 + c0); raw[4] = *(const u32x4*)(WA + m * 2048 + 1024 + c0); }
    for (int item = F.bid; item < 64 * RWN; item += F.G) {
        const int seq = item / RWN, ch = item % RWN, b = seq >> 5, d = (seq >> 4) & 1, h = seq & 15, c0 = h * 64 + k0;
        bf16* YD = d ? P.YD1 : P.YD0;
        float rr[8], kd[8], bv[8], av[8], vv[8], lw[8];
        { float kr[8], wl[8], al[8];
          unpack8(raw[0], rr); unpack8(raw[1], kr); unpack8(raw[2], vv); unpack8(raw[3], wl); unpack8(raw[4], al);
          { const int itn = (item + F.G < 64 * RWN) ? item + F.G : item;
            const int seqn = itn / RWN, chn = itn % RWN, bn = seqn >> 5, dn = (seqn >> 4) & 1, hn = seqn & 15, cn = hn * 64 + k0; const bf16* WAn = dn ? P.WA1 : P.WA0;
            const size_t mn = (size_t)bn * T + scan_t(dn, chn * RWC + ri);
            raw[0] = *(const u32x4*)(P.Rr + mn * 1024 + cn); raw[1] = *(const u32x4*)(P.Rk + mn * 1024 + cn); raw[2] = *(const u32x4*)(P.Rv + mn * 1024 + cn);
            raw[3] = *(const u32x4*)(WAn + mn * 2048 + cn); raw[4] = *(const u32x4*)(WAn + mn * 2048 + 1024 + cn); }
          float ckk[8], ca0[8], cka[8], cw0[8];
#pragma unroll
          for (int q = 0; q < 2; ++q) { const f32x4 t0 = *(const f32x4*)(P.kkw + c0 + 4 * q), t1 = *(const f32x4*)(P.a0 + d * 1024 + c0 + 4 * q), t2 = *(const f32x4*)(P.kaw + c0 + 4 * q), t3 = *(const f32x4*)(P.w0 + d * 1024 + c0 + 4 * q);
#pragma unroll
              for (int e = 0; e < 4; ++e) { ckk[4 * q + e] = t0[e]; ca0[4 * q + e] = t1[e]; cka[4 * q + e] = t2[e]; cw0[4 * q + e] = t3[e]; } }
          float ss = 0.f, kn[8];
#pragma unroll
          for (int e = 0; e < 8; ++e) { kn[e] = kr[e] * ckk[e]; ss += kn[e] * kn[e]; }
          ss += __shfl_xor(ss, 1); ss += __shfl_xor(ss, 2); ss += __shfl_xor(ss, 4);
          const float inv = __builtin_amdgcn_rsqf(fmaxf(ss, 1e-24f));
#pragma unroll
          for (int e = 0; e < 8; ++e) { const float kk = kn[e] * inv; const float ag = sigm(ca0[e] + al[e]);
              kd[e] = kr[e] * (1.f + (ag - 1.f) * cka[e]); bv[e] = kk * ag; av[e] = -kk;
              lw[e] = -0.6065306597126334f * sigm(cw0[e] + wl[e]); }
          *(LASQ f32x4*)(CUM + ri * 64 + k0) = (f32x4){lw[0], lw[1], lw[2], lw[3]}; *(LASQ f32x4*)(CUM + ri * 64 + k0 + 4) = (f32x4){lw[4], lw[5], lw[6], lw[7]}; }
        LDS_BARRIER();
        if (F.tid < 64) { float tv[RWC];
#pragma unroll
            for (int i = 0; i < RWC; ++i) tv[i] = CUM[i * 64 + F.tid];
            float s = 0.f;
#pragma unroll
            for (int i = 0; i < RWC; ++i) { s += tv[i]; tv[i] = s; }
#pragma unroll
            for (int i = 0; i < RWC; ++i) CUM[i * 64 + F.tid] = tv[i]; }
        LDS_BARRIER();
        { float o1[8], o2[8], o3[8], o4[8], o5[8], o6[8];
#pragma unroll
          for (int e = 0; e < 8; ++e) { const float cm = CUM[ri * 64 + k0 + e], c63 = CUM[63 * 64 + k0 + e];
              const float ecx = __expf(cm - lw[e]), ec = __expf(cm), en = __expf(-cm), eh = __expf(c63 - cm);
              o1[e] = av[e] * ecx; o2[e] = rr[e] * ec; o3[e] = bv[e] * en; o4[e] = kd[e] * en; o5[e] = bv[e] * eh; o6[e] = kd[e] * eh;
              if (ri == 63) P.GAM[(size_t)item * 64 + k0 + e] = ec; }
          *(LASQ u32x4*)(At + ri * RLD + k0) = pack8(o1); *(LASQ u32x4*)(Rt + ri * RLD + k0) = pack8(o2); *(LASQ u32x4*)(Bt + ri * RLD + k0) = pack8(o3); *(LASQ u32x4*)(Kt + ri * RLD + k0) = pack8(o4);
          *(LASQ u32x4*)(Kh + ri * RLD + k0) = pack8(o6);
#pragma unroll
          for (int e = 0; e < 8; ++e) { Bh[(k0 + e) * RLD + ri] = (bf16)f2bf(o5[e]); Vt[(k0 + e) * RLD + ri] = (bf16)f2bf(vv[e]); } }
        LDS_BARRIER();
        { LASQ unsigned char* L = (LASQ unsigned char*)F.lds; const int q = F.wave >> 1, half = F.wave & 1;
          if (q == 0) rw1_scores<0>(L, half, row, quad); else if (q == 1) rw1_scores<1>(L, half, row, quad); else if (q == 2) rw1_scores<2>(L, half, row, quad); else rw1_scores<3>(L, half, row, quad); }
        LDS_BARRIER();
        { const int e0 = F.tid * 8, xi = e0 >> 6, xc = e0 & 63; float t8[8]; unpack8(*(const LASQ u32x4*)(At + xi * RLD + xc), t8);
          *(LASQ f32x4*)(XA + xi * 64 + xc) = (f32x4){t8[0], t8[1], t8[2], t8[3]}; *(LASQ f32x4*)(XA + xi * 64 + xc + 4) = (f32x4){t8[4], t8[5], t8[6], t8[7]}; }
        LDS_BARRIER();
#pragma unroll 1
        for (int r = 0; r < 4; ++r) {
            if (r > 0) { LASQ float* Xh = (F.wave < 4) ? XA : M2; const LASQ bf16* Xb = (F.wave < 4) ? TA : TM2; const int cb = (F.wave & 3) * 16;
                f32x4 acc = {0.f, 0.f, 0.f, 0.f};
                for (int ks = 0; ks < ((r + 1) >> 1); ++ks) { bf16x8v a; const LASQ float* mr = M1 + (16 * r + row) * 64 + ks * 32 + quad * 8;
                    const f32x4 m0 = *(const LASQ f32x4*)mr, m1v = *(const LASQ f32x4*)(mr + 4);
#pragma unroll
                    for (int e = 0; e < 8; ++e) { const int j = ks * 32 + quad * 8 + e; const float mv = (e < 4) ? m0[e & 3] : m1v[e & 3]; a[e] = (short)((j < 16 * r) ? f2bf(mv) : 0u); }
                    const int jb = ks * 32 + quad * 8; bf16x8v bb = lfrag8(Xb + (cb + row) * RLD + jb);
                    if (jb >= 16 * r) bb = (bf16x8v){0, 0, 0, 0, 0, 0, 0, 0};
                    acc = __builtin_amdgcn_mfma_f32_16x16x32_bf16(a, bb, acc, 0, 0, 0); }
#pragma unroll
                for (int jj = 0; jj < 4; ++jj) Xh[(16 * r + quad * 4 + jj) * 64 + cb + row] += acc[jj]; }
            LDS_BARRIER();
            if (F.tid < 128) { const int col = F.tid & 63; LASQ float* Xh = (F.tid < 64) ? XA : M2; LASQ bf16* dst = (F.tid < 64) ? TA : TM2;
                float x[16];
#pragma unroll
                for (int ii = 0; ii < 16; ++ii) x[ii] = Xh[(16 * r + ii) * 64 + col];
#pragma unroll
                for (int jj = 0; jj < 15; ++jj) {
#pragma unroll
                    for (int ii = jj + 1; ii < 16; ++ii) x[ii] += M1[(16 * r + ii) * 64 + 16 * r + jj] * x[jj]; }
                u32x4 w0, w1;
#pragma unroll
                for (int e = 0; e < 4; ++e) { w0[e] = pk2(x[2 * e], x[2 * e + 1]); w1[e] = pk2(x[8 + 2 * e], x[8 + 2 * e + 1]); }
                *(LASQ u32x4*)(dst + col * RLD + 16 * r) = w0; *(LASQ u32x4*)(dst + col * RLD + 16 * r + 8) = w1; }
            LDS_BARRIER();
        }
        { LASQ unsigned char* L = (LASQ unsigned char*)F.lds; const int q = F.wave >> 1, half = F.wave & 1;
          if (q == 0) rw1_products<0>(L, half, row, quad, P.RA + (size_t)item * 4096); else if (q == 1) rw1_products<1>(L, half, row, quad, nullptr);
          else if (q == 2) rw1_products<2>(L, half, row, quad, P.NT + (size_t)item * 4096); else rw1_products<3>(L, half, row, quad, P.WKT + (size_t)item * 4096); }
        LDS_BARRIER();
#pragma unroll
        for (int tt = 0; tt < 2; ++tt) { const int t = 2 * F.wave + tt, mt = t >> 2, nt = t & 3;
            f32x4 acc = {0.f, 0.f, 0.f, 0.f};
#pragma unroll
            for (int ks = 0; ks < 2; ++ks) acc = __builtin_amdgcn_mfma_f32_16x16x32_bf16(lfrag8(CY + (mt * 16 + row) * RLD + ks * 32 + quad * 8), lfrag8(Vt + (nt * 16 + row) * RLD + ks * 32 + quad * 8), acc, 0, 0, 0);
#pragma unroll
            for (int jj = 0; jj < 4; ++jj) { const size_t m = (size_t)b * T + scan_t(d, ch * RWC + mt * 16 + quad * 4 + jj); YD[m * 1024 + h * 64 + nt * 16 + row] = (bf16)f2bf(acc[jj]); } }
        LDS_BARRIER();
    }
}
constexpr int R2_RA = 0, R2_NT = 9216, R2_WK = 18432, R2_V = 27648, R2_Y = 30720, R2_G = 33792, R2_BUF = 34048, R2_SL = 2 * R2_BUF, VL2 = 24;
struct RwSet { u32x4 a, n, w, x; };
__device__ __forceinline__ void rw2_fetch(const Ctx& F, const RwP2& P, RwSet& o, int seq, int c, int b, int d, int h, int vq) {
    if (c >= RWN) c = RWN - 1;
    const size_t item = (size_t)seq * RWN + c; const bf16* YD = d ? P.YD1 : P.YD0;
    o.a = *(const u32x4*)(P.RA + item * 4096 + F.tid * 8); o.n = *(const u32x4*)(P.NT + item * 4096 + F.tid * 8); o.w = *(const u32x4*)(P.WKT + item * 4096 + F.tid * 8);
    o.x = (u32x4){0u, 0u, 0u, 0u};
    if (F.tid < 256) { const int j = (F.tid & 127) >> 1, hf = F.tid & 1; const size_t m = (size_t)b * T + scan_t(d, c * RWC + j);
        o.x = *(const u32x4*)((F.tid < 128 ? P.Rv : YD) + m * 1024 + h * 64 + vq * 16 + hf * 8); }
    else if (F.tid < 272) o.x = *(const u32x4*)(P.GAM + item * 64 + (F.tid - 256) * 4);
}
__device__ __forceinline__ void rw2_put(const Ctx& F, const RwSet& o, LASQ unsigned char* buf) {
    const int e0 = F.tid * 8, r = e0 >> 6, cc = e0 & 63;
    *(LASQ u32x4*)(buf + R2_RA + (r * RLD + cc) * 2) = o.a; *(LASQ u32x4*)(buf + R2_NT + (r * RLD + cc) * 2) = o.n; *(LASQ u32x4*)(buf + R2_WK + (r * RLD + cc) * 2) = o.w;
    if (F.tid < 256) { const int j = (F.tid & 127) >> 1, hf = F.tid & 1; *(LASQ u32x4*)(buf + (F.tid < 128 ? R2_V : R2_Y) + (j * VL2 + hf * 8) * 2) = o.x; }
    else if (F.tid < 272) *(LASQ u32x4*)(buf + R2_G + (F.tid - 256) * 16) = o.x;
}
__device__ __forceinline__ void rw2_state(const Ctx& F, const LASQ unsigned char* buf, f32x4 (&S)[4], int c) {
    const int row = F.lane & 15, quad = F.lane >> 4;
    const LASQ bf16* Sc = (const LASQ bf16*)(F.lds + R2_SL + (c & 1) * 2304); LASQ bf16* Sn = (LASQ bf16*)(F.lds + R2_SL + ((c + 1) & 1) * 2304);
    const LASQ bf16* NTl = (const LASQ bf16*)(buf + R2_NT); const LASQ bf16* WKl = (const LASQ bf16*)(buf + R2_WK); const LASQ bf16* Vl = (const LASQ bf16*)(buf + R2_V); const LASQ float* Gl = (const LASQ float*)(buf + R2_G);
    bf16x8v sf[2]; sf[0] = lfrag8(Sc + row * RLD + quad * 8); sf[1] = lfrag8(Sc + row * RLD + 32 + quad * 8);
    bf16x8v vf[2]; vf[0] = lgather8(Vl + (quad * 8) * VL2 + row, VL2); vf[1] = lgather8(Vl + (32 + quad * 8) * VL2 + row, VL2);
#pragma unroll
    for (int t = 0; t < 4; ++t) { f32x4 acc = S[t] * Gl[t * 16 + row];
        acc = __builtin_amdgcn_mfma_f32_16x16x32_bf16(sf[0], lfrag8(NTl + (t * 16 + row) * RLD + quad * 8), acc, 0, 0, 0); acc = __builtin_amdgcn_mfma_f32_16x16x32_bf16(sf[1], lfrag8(NTl + (t * 16 + row) * RLD + 32 + quad * 8), acc, 0, 0, 0);
        acc = __builtin_amdgcn_mfma_f32_16x16x32_bf16(vf[0], lfrag8(WKl + (t * 16 + row) * RLD + quad * 8), acc, 0, 0, 0); acc = __builtin_amdgcn_mfma_f32_16x16x32_bf16(vf[1], lfrag8(WKl + (t * 16 + row) * RLD + 32 + quad * 8), acc, 0, 0, 0);
        S[t] = acc; }
#pragma unroll
    for (int t = 0; t < 4; ++t) { u32x2 w; w.x = pk2(S[t][0], S[t][1]); w.y = pk2(S[t][2], S[t][3]);
        Sn[(quad * 4 + 0) * RLD + t * 16 + row] = (bf16)(w.x & 0xffffu); Sn[(quad * 4 + 1) * RLD + t * 16 + row] = (bf16)(w.x >> 16);
        Sn[(quad * 4 + 2) * RLD + t * 16 + row] = (bf16)(w.y & 0xffffu); Sn[(quad * 4 + 3) * RLD + t * 16 + row] = (bf16)(w.y >> 16); }
}
__device__ __forceinline__ void rw2_y(const Ctx& F, const RwP2& P, const LASQ unsigned char* buf, int c, int b, int d, int h, int vq) {
    const int row = F.lane & 15, quad = F.lane >> 4;
    const LASQ bf16* Sc = (const LASQ bf16*)(F.lds + R2_SL + (c & 1) * 2304); bf16* YD = d ? P.YD1 : P.YD0;
    const LASQ bf16* RAl = (const LASQ bf16*)(buf + R2_RA); const LASQ bf16* Yl = (const LASQ bf16*)(buf + R2_Y);
    bf16x8v sf[2]; sf[0] = lfrag8(Sc + row * RLD + quad * 8); sf[1] = lfrag8(Sc + row * RLD + 32 + quad * 8);
#pragma unroll
    for (int t = 0; t < 4; ++t) { f32x4 y = {0.f, 0.f, 0.f, 0.f};
        y = __builtin_amdgcn_mfma_f32_16x16x32_bf16(lfrag8(RAl + (t * 16 + row) * RLD + quad * 8), sf[0], y, 0, 0, 0); y = __builtin_amdgcn_mfma_f32_16x16x32_bf16(lfrag8(RAl + (t * 16 + row) * RLD + 32 + quad * 8), sf[1], y, 0, 0, 0);
#pragma unroll
        for (int jj = 0; jj < 4; ++jj) { const int i = t * 16 + quad * 4 + jj; const size_t m = (size_t)b * T + scan_t(d, c * RWC + i); YD[m * 1024 + h * 64 + vq * 16 + row] = (bf16)f2bf(y[jj] + bf2f(Yl[i * VL2 + row])); } }
}
__device__ __forceinline__ void rwkv_chunk_scan(const Ctx& F, const RwP2& P) {
    for (int it = F.bid; it < 256; it += F.G) {
        const int seq = it >> 2, vq = it & 3, b = seq >> 5, d = (seq >> 4) & 1, h = seq & 15;
        f32x4 S[4];
#pragma unroll
        for (int t = 0; t < 4; ++t) S[t] = (f32x4){0.f, 0.f, 0.f, 0.f};
        RwSet s0, s1, s2;
        rw2_fetch(F, P, s0, seq, 0, b, d, h, vq); rw2_fetch(F, P, s1, seq, 1, b, d, h, vq); rw2_fetch(F, P, s2, seq, 2, b, d, h, vq);
        LDS_BARRIER();
        rw2_put(F, s0, (LASQ unsigned char*)F.lds);
        for (int i = F.tid; i < 16 * RLD; i += 512) ((LASQ bf16*)(F.lds + R2_SL))[i] = 0;
        LDS_BARRIER();
        for (int c3 = 0; c3 < RWN; c3 += 6) {
#define RW2_BODY(cc, SN, SC) do { rw2_put(F, SN, (LASQ unsigned char*)F.lds + (((cc) + 1) & 1) * R2_BUF); rw2_fetch(F, P, SC, seq, (cc) + 3, b, d, h, vq); \
            if (F.wave == 0) rw2_state(F, (const LASQ unsigned char*)F.lds + ((cc) & 1) * R2_BUF, S, (cc)); else if (F.wave == 1) rw2_y(F, P, (const LASQ unsigned char*)F.lds + ((cc) & 1) * R2_BUF, (cc), b, d, h, vq); LDS_BARRIER(); } while (0)
            RW2_BODY(c3 + 0, s1, s0); RW2_BODY(c3 + 1, s2, s1); RW2_BODY(c3 + 2, s0, s2);
            RW2_BODY(c3 + 3, s1, s0); RW2_BODY(c3 + 4, s2, s1); RW2_BODY(c3 + 5, s0, s2);
#undef RW2_BODY
        }
    }
}
__device__ __forceinline__ void rwkv_post(const Ctx& F, const RwP2& P, const bf16* Gg, const float* rk, const float* lnw, const float* lnb, bf16* O) {
    for (int m = F.gw; m < M; m += F.NGW) {
#pragma unroll 1
        for (int hp = 0; hp < 2; ++hp) {
            const int c0 = hp * 512 + 8 * F.lane; const size_t i1 = (size_t)m * 1024 + c0;
            const u32x4 wy0 = *(const u32x4*)(P.YD0 + i1), wy1 = *(const u32x4*)(P.YD1 + i1), wr = *(const u32x4*)(P.Rr + i1), wk = *(const u32x4*)(P.Rk + i1), wv = *(const u32x4*)(P.Rv + i1);
            const u32x4 wa0 = *(const u32x4*)(P.WA0 + (size_t)m * 2048 + 1024 + c0), wa1 = *(const u32x4*)(P.WA1 + (size_t)m * 2048 + 1024 + c0), wg = *(const u32x4*)(Gg + i1);
            float cl[8], cb[8], ca0[8], ca1[8], cka[8], crk[8];
#pragma unroll
            for (int q = 0; q < 2; ++q) { const f32x4 t0 = *(const f32x4*)(lnw + c0 + 4 * q), t1 = *(const f32x4*)(lnb + c0 + 4 * q), t2 = *(const f32x4*)(P.a0 + c0 + 4 * q), t3 = *(const f32x4*)(P.a0 + 1024 + c0 + 4 * q),
                    t4 = *(const f32x4*)(P.kaw + c0 + 4 * q), t5 = *(const f32x4*)(rk + c0 + 4 * q);
#pragma unroll
                for (int e = 0; e < 4; ++e) { cl[4 * q + e] = t0[e]; cb[4 * q + e] = t1[e]; ca0[4 * q + e] = t2[e]; ca1[4 * q + e] = t3[e]; cka[4 * q + e] = t4[e]; crk[4 * q + e] = t5[e]; } }
            float y0[8], y1[8], r[8], k[8], v[8], a0v[8], a1v[8], g[8];
            unpack8(wy0, y0); unpack8(wy1, y1); unpack8(wr, r); unpack8(wk, k); unpack8(wv, v); unpack8(wa0, a0v); unpack8(wa1, a1v); unpack8(wg, g);
            float y[8], s1 = 0.f, dot = 0.f;
#pragma unroll
            for (int e = 0; e < 8; ++e) { y[e] = y0[e] + y1[e]; s1 += y[e];
                const float ag0 = sigm(ca0[e] + a0v[e]), ag1 = sigm(ca1[e] + a1v[e]);
                dot += r[e] * k[e] * (2.f + (ag0 + ag1 - 2.f) * cka[e]) * crk[e]; }
            s1 += __shfl_xor(s1, 1); s1 += __shfl_xor(s1, 2); s1 += __shfl_xor(s1, 4);
            dot += __shfl_xor(dot, 1); dot += __shfl_xor(dot, 2); dot += __shfl_xor(dot, 4);
            const float mean = s1 * (1.f / 64.f); float s2 = 0.f;
#pragma unroll
            for (int e = 0; e < 8; ++e) { y[e] -= mean; s2 += y[e] * y[e]; }
            s2 += __shfl_xor(s2, 1); s2 += __shfl_xor(s2, 2); s2 += __shfl_xor(s2, 4);
            const float rs = rsqrtf(s2 * (1.f / 64.f) + 64e-5f);
            float o[8];
#pragma unroll
            for (int e = 0; e < 8; ++e) o[e] = (y[e] * rs * cl[e] + cb[e] + dot * v[e]) * g[e];
            *(u32x4*)(O + (size_t)m * 2048 + c0) = pack8(o);
        }
    }
}

struct LruP { const bf16 *XBR, *GATE, *XS, *Z; const float *convw, *convb, *ba, *bx, *lam; float* CAR; bf16* Y; };
__device__ __forceinline__ int lru_row(int b, int s) { if (s < CTX) return b * T + s; const int p = s - CTX; return b * T + CTX + (p & 127) * 64 + (p >> 7); }
__device__ __forceinline__ void lru_conv(const Ctx& F, const LruP& P, bf16* XS) {
    for (int m = F.gw; m < M; m += F.NGW) {
        const int b = m / T, s = m % T; const int lo = (s < CTX) ? 0 : CTX, hi = (s < CTX) ? CTX : T;
#pragma unroll
        for (int q = 0; q < 4; ++q) {
            const int c0 = 8 * (F.lane + 64 * q);
            float y[8];
            { const f32x4 b0 = *(const f32x4*)(P.convb + c0), b1 = *(const f32x4*)(P.convb + c0 + 4); y[0] = b0[0]; y[1] = b0[1]; y[2] = b0[2]; y[3] = b0[3]; y[4] = b1[0]; y[5] = b1[1]; y[6] = b1[2]; y[7] = b1[3]; }
#pragma unroll
            for (int j = 0; j < 4; ++j) { const int sj = s + j - 2;
                if (sj >= lo && sj < hi) { const u32x4 x = *(const u32x4*)(P.XBR + (size_t)lru_row(b, sj) * 2048 + c0);
                    const f32x4 w0 = *(const f32x4*)(P.convw + j * 2048 + c0), w1 = *(const f32x4*)(P.convw + j * 2048 + c0 + 4);
                    y[0] += lo16(x[0]) * w0[0]; y[1] += hi16(x[0]) * w0[1]; y[2] += lo16(x[1]) * w0[2]; y[3] += hi16(x[1]) * w0[3];
                    y[4] += lo16(x[2]) * w1[0]; y[5] += hi16(x[2]) * w1[1]; y[6] += lo16(x[3]) * w1[2]; y[7] += hi16(x[3]) * w1[3]; } }
            u32x4 o; o.x = pk2(y[0], y[1]); o.y = pk2(y[2], y[3]); o.z = pk2(y[4], y[5]); o.w = pk2(y[6], y[7]);
            *(u32x4*)(XS + (size_t)m * 2048 + c0) = o;
        }
    }
}
struct LruRaw { unsigned lw, iw, xw; };
__device__ __forceinline__ LruRaw lru_ld(const bf16* zb, const bf16* xb, int i, int d) {
    LruRaw r; r.lw = *(const unsigned*)(zb + i * 128 + d * 8192); r.iw = *(const unsigned*)(zb + i * 128 + (2 + d) * 8192); r.xw = *(const unsigned*)(xb + i * 2048);
    return r;
}
__device__ __forceinline__ const bf16* lru_zbase(const LruP& P, int b, int cf, int c) { const int n = c >> 8, j = c & 255; return P.Z + (((size_t)(b * LNCH + cf) * 64 + n * 8 + (j >> 7)) * 32) * 128 + (j & 127); }
__device__ __forceinline__ void lru_cmp(const LruRaw& r, float (&a)[2], float (&u)[2]) {
    const float la[2] = {lo16(r.lw), hi16(r.lw)}, ig[2] = {lo16(r.iw), hi16(r.iw)}, xs[2] = {lo16(r.xw), hi16(r.xw)};
#pragma unroll
    for (int e = 0; e < 2; ++e) { a[e] = __expf(la[e]); const float x2 = 2.f * la[e];
        const float om = -x2 * (1.f + x2 * (0.5f + x2 * (0.16666667f + x2 * (0.041666668f + x2 * (0.0083333338f + x2 * 0.0013888889f)))));
        const float om2 = (x2 < -0.5f) ? (1.f - a[e] * a[e]) : om;
        u[e] = __builtin_amdgcn_sqrtf(fmaxf(om2, 0.f)) * ig[e] * xs[e]; }
}
__device__ __forceinline__ void lru_passA(const Ctx& F, const LruP& P) {
    for (int it = F.bid; it < NB * LNCH * 2; it += F.G) {
        const int hq = it & 1, bc = it >> 1, b = bc / LNCH, cf = bc % LNCH, c = hq * 1024 + 2 * F.tid;
        const bf16* zb = lru_zbase(P, b, cf, c); const bf16* xb = P.XS + ((size_t)b * T + cf * LCH) * 2048 + c;
#pragma unroll
        for (int d = 0; d < 2; ++d) {
            float A[2] = {1.f, 1.f}, U[2] = {0.f, 0.f};
#pragma unroll 1
            for (int i0 = 0; i0 < LCH; i0 += 16) {
                LruRaw rw[16];
#pragma unroll
                for (int i = 0; i < 16; ++i) rw[i] = lru_ld(zb, xb, d ? (LCH - 1 - i0 - i) : (i0 + i), d);
#pragma unroll
                for (int i = 0; i < 16; ++i) { float a[2], u[2]; lru_cmp(rw[i], a, u); U[0] = a[0] * U[0] + u[0]; A[0] *= a[0]; U[1] = a[1] * U[1] + u[1]; A[1] *= a[1]; }
            }
            *(f32x4*)(P.CAR + ((size_t)((b * 2 + d) * LNCH + cf) * 2048 + c) * 2) = (f32x4){A[0], U[0], A[1], U[1]};
        }
    }
}
__device__ __forceinline__ void lru_passB(const Ctx& F, const LruP& P) {
    const int nth = F.G * 512;
    for (int i = F.bid * 512 + F.tid; i < NB * 2 * 2048; i += nth) {
        const int c = i & 2047, d = (i >> 11) & 1, b = i >> 12;
        float h = 0.f;
        for (int k0 = 0; k0 < LNCH; k0 += 24) {
            float A[24], U[24]; float* cp[24];
#pragma unroll
            for (int j = 0; j < 24; ++j) { const int k = k0 + j, cf = d ? (k < 8 ? 7 - k : LNCH + 7 - k) : k;
                cp[j] = P.CAR + ((size_t)((b * 2 + d) * LNCH + cf) * 2048 + c) * 2; const float2 t = *(const float2*)cp[j]; A[j] = t.x; U[j] = t.y; }
#pragma unroll
            for (int j = 0; j < 24; ++j) { cp[j][1] = h; h = A[j] * h + U[j]; }
        }
    }
}
__device__ __forceinline__ void lru_passC(const Ctx& F, const LruP& P) {
    for (int it = F.bid; it < NB * LNCH * 2; it += F.G) {
        const int hq = it & 1, bc = it >> 1, b = bc / LNCH, cf = bc % LNCH, c = hq * 1024 + 2 * F.tid;
        const bf16* zb = lru_zbase(P, b, cf, c); const bf16* xb = P.XS + ((size_t)b * T + cf * LCH) * 2048 + c;
        LASQ f32x2v* hfl = (LASQ f32x2v*)F.lds + F.tid;
        { const f32x4 cr = *(const f32x4*)(P.CAR + ((size_t)((b * 2 + 0) * LNCH + cf) * 2048 + c) * 2);
          float h0 = cr[1], h1 = cr[3];
#pragma unroll
          for (int i0 = 0; i0 < LCH; i0 += 8) {
              LruRaw rw[8];
#pragma unroll
              for (int i = 0; i < 8; ++i) rw[i] = lru_ld(zb, xb, i0 + i, 0);
#pragma unroll
              for (int i = 0; i < 8; ++i) { float a[2], u[2]; lru_cmp(rw[i], a, u); h0 = a[0] * h0 + u[0]; h1 = a[1] * h1 + u[1]; hfl[(i0 + i) * 512] = (f32x2v){h0, h1}; }
              asm volatile("" ::: "memory"); } }
        { const f32x4 cr = *(const f32x4*)(P.CAR + ((size_t)((b * 2 + 1) * LNCH + cf) * 2048 + c) * 2);
          float h0 = cr[1], h1 = cr[3];
          const int s0 = cf * LCH;
#pragma unroll
          for (int i0 = 0; i0 < LCH; i0 += 8) {
              LruRaw rw[8]; unsigned gw[8];
#pragma unroll
              for (int i = 0; i < 8; ++i) { const int li = LCH - 1 - i0 - i; rw[i] = lru_ld(zb, xb, li, 1); gw[i] = *(const unsigned*)(P.GATE + (size_t)lru_row(b, s0 + li) * 2048 + c); }
#pragma unroll
              for (int i = 0; i < 8; ++i) { const int li = LCH - 1 - i0 - i; float a[2], u[2]; lru_cmp(rw[i], a, u); h0 = a[0] * h0 + u[0]; h1 = a[1] * h1 + u[1];
                  const f32x2v hv = hfl[li * 512];
                  *(unsigned*)(P.Y + (size_t)lru_row(b, s0 + li) * 2048 + c) = pk2((hv.x + h0) * gelu_tanh(lo16(gw[i])), (hv.y + h1) * gelu_tanh(hi16(gw[i]))); }
              asm volatile("" ::: "memory"); } }
    }
}

__device__ __forceinline__ void fill_wlora(const Ctx& F, const float* g2, const float* w2, const float* a2, bf16* WL) {
    const int nth = F.G * 512;
    for (int i = F.bid * 512 + F.tid; i < 5120 * 256; i += nth) {
        const int k = i & 255, n = i >> 8; float v = 0.f;
        if (n < 1024) v = g2[(size_t)k * 1024 + n];
        else { const int q = n - 1024, d = q >> 11, r2 = q & 2047;
            if (r2 < 1024) { if (k < 96) v = w2[((size_t)d * 96 + k) * 1024 + r2]; }
            else { if (k >= 96 && k < 192) v = a2[((size_t)d * 96 + (k - 96)) * 1024 + (r2 - 1024)]; } }
        WL[i] = (bf16)f2bf(v);
    }
}
__device__ __forceinline__ void zero_rows(const Ctx& F, bf16* p, size_t n16) {
    const size_t nth = (size_t)F.G * 512; const u32x4 z = {0u, 0u, 0u, 0u};
    for (size_t i = (size_t)F.bid * 512 + F.tid; i < n16; i += nth) ((u32x4*)p)[i] = z;
}

__global__ void __launch_bounds__(512, 2) mega_fwd(Args args) {
    extern __shared__ __attribute__((aligned(16))) unsigned char lds[];
    cg::grid_group grid = cg::this_grid();
    Ctx F; F.lds = lds; F.tid = threadIdx.x; F.lane = F.tid & 63; F.wave = __builtin_amdgcn_readfirstlane(F.tid >> 6);
    F.G = gridDim.x; F.bid = blockIdx.x; F.gw = F.bid * 8 + F.wave; F.NGW = F.G * 8;
    unsigned char* ws = args.ws; unsigned char* ob = (unsigned char*)args.out;
    const float* x = args.in[0]; const float* cvec = args.in[1]; const float* ctx = args.in[2]; const float* c_ctx = args.in[3];
    const float* mod_w = args.in[4]; const float* mod_b = args.in[5]; const float* norm1 = args.in[6]; const float* norm2 = args.in[7];
    const float* mlp_w1 = args.in[8]; const float* mlp_w2 = args.in[9]; const float* ab_w_in = args.in[10]; const float* ab_w_out = args.in[11];
    float* modv = (float*)(ws + WS_MODV); float* X = (float*)(ws + WS_X); bf16* H = (bf16*)(ws + WS_HR);
    bf16* Wab = (bf16*)(ws + WS_WAB); bf16* Wout = (bf16*)(ws + WS_WOUT); bf16* Wlora = (bf16*)(ws + WS_WLORA);
    bf16* PA = (bf16*)(ws + MN_PA); bf16* PB = (bf16*)(ws + MN_PB); bf16* O = (bf16*)(ws + MN_O);
    bf16* Gg = (bf16*)(ob + OT_GG); bf16* WA0 = (bf16*)(ob + OT_WA0); bf16* WA1 = (bf16*)(ws + WS_HR); bf16* LA = (bf16*)(ob + OT_LA);
    RwP2 RP; RP.Rr = (bf16*)(ws + MN_R); RP.Rk = (bf16*)(ws + MN_K); RP.Rv = (bf16*)(ws + MN_V); RP.WA0 = WA0; RP.WA1 = WA1;
    RP.w0 = args.in[13]; RP.a0 = args.in[15]; RP.kkw = args.in[18]; RP.kaw = args.in[19]; RP.RA = (bf16*)(ws + MN_RA); RP.NT = (bf16*)(ws + MN_NT); RP.WKT = (bf16*)(ws + MN_WKT);
    RP.GAM = (float*)(ws + WS_GAM); RP.YD0 = (bf16*)(ws + MN_YD0); RP.YD1 = (bf16*)(ws + MN_YD1);
    GlaP GP; GP.PB = PB; GP.gw2 = args.in[23]; GP.gb = args.in[24]; GP.KV = (bf16*)(ws + MN_KV); GP.GDP = (float*)(ws + WS_GDP);
    LruP LP; LP.XBR = (bf16*)(ob + OT_XBR); LP.GATE = (bf16*)(ws + MN_GATE); LP.XS = (bf16*)(ws + WS_HR); LP.Z = (bf16*)(ws + MN_Z);
    LP.convw = args.in[28]; LP.convb = args.in[29]; LP.ba = args.in[31]; LP.bx = args.in[33]; LP.lam = args.in[34]; LP.CAR = (float*)(ob + OT_CAR); LP.Y = (bf16*)(ob + OT_Y);
    PG8_LAS unsigned char* glds = (PG8_LAS unsigned char*)lds;
    const int lo = args.ph_lo, hi = args.ph_hi;
    volatile unsigned* xst = (volatile unsigned*)(lds + 147456 - 64);
    if (F.tid == 0) { xst[0] = 0u; xst[1] = 0u; }
    __syncthreads();
    XcdBarrier xbar = xcd_barrier_post((unsigned*)ws, xst);
#define IN(k) (lo <= (k) && (k) < hi)
#define SEAM(k) do { if (IN(k) && IN((k) + 1)) { if ((k) == 0) grid.sync(); else xcd_barrier(xbar); } } while (0)
#define GEMM(EPI, Aptr, lda_, Btptr, ldb_, nM_, nN_, K_, skip_, amode_, ...) do { pg8::Gemm g{(const bf16*)(Aptr), (const bf16*)(Btptr), 0, 0, (K_), (lda_), (ldb_)}; pg8::Sched S; S.init((nM_), (nN_), F.G, F.bid, (skip_), (amode_)); \
        pg8::EPI E{__VA_ARGS__}; pg8::gemm_phase<pg8::EPI, pg8::Sched, true, true>(glds, g, S, E); } while (0)

    if (IN(0)) {
        mod_gemv(F, cvec, c_ctx, mod_w, mod_b, modv);
        xpose(F, ab_w_in, 6816, D, ACOLS, Wab, D);
        xpose(F, ab_w_in + ACOLS, 6816, D, BCOLS, Wab + (size_t)PA_LD * D, D);
        xpose(F, ab_w_out, D, D, D, Wout, D);
        zero_rows(F, Wab + (size_t)ACOLS * D, (size_t)(PA_LD - ACOLS) * D / 8);
        zero_rows(F, Wab + (size_t)(PA_LD + BCOLS) * D, (size_t)(NAB - PA_LD - BCOLS) * D / 8);
        fill_wlora(F, args.in[17], args.in[14], args.in[16], Wlora);
        for (int i = F.bid * 512 + F.tid; i < 2 * D; i += F.G * 512) { const float l = args.in[34][i]; ((float*)(ws + WS_SPL))[i] = -8.f * ((-l) > 20.f ? (-l) : log1pf(__expf(-l))); }
    }
    SEAM(0);
    if (IN(1)) norm_mod(F, X, x, ctx, norm1, modv, 0, 1, H, 0);
    SEAM(1);
    if (IN(2)) GEMM(EpiBf16S, H, D, Wab, D, 66, 28, D, 0, 0, PA, PB, PB, PA_LD, PB_LD, PB_LD, 15, 1000, 0);
    SEAM(2);
    if (IN(3)) { gla_kv(F, GP); rwkv_mix(F, PA, args.in[12], (bf16*)RP.Rr, (bf16*)RP.Rk, (bf16*)RP.Rv, LA); }
    SEAM(3);
    if (IN(4)) { gla_carry(F, GP); GEMM(EpiBf16S, LA, 768, Wlora, 256, 66, 20, 256, 0, 1, Gg, WA0, WA1, 1024, 2048, 2048, 4, 12, 0); }
    SEAM(4);
    if (IN(5)) gla_out(F, GP, args.in[25], O);
    SEAM(5);
    if (IN(7)) rwkv_chunk_prep(F, RP);
    SEAM(7);
    if (IN(8)) rwkv_chunk_scan(F, RP);
    SEAM(8);
    if (IN(10)) rwkv_post(F, RP, Gg, args.in[20], args.in[21], args.in[22], O);
    SEAM(10);
    Ctx FI = F; FI.gw = (F.bid - 16) * 8 + F.wave; FI.NGW = (F.G - 16) * 8;
    if (IN(11)) { GEMM(EpiResid, O, D, Wout, D, 66, 8, D, 0, 0, X, x, ctx, modv, 2);
        if (F.bid >= 16) { xpose(FI, mlp_w1, FF, D, FF, (bf16*)(ws + MN_W1_0), D); xpose(FI, mlp_w2, D, FF, D, (bf16*)(ws + MN_W2_0), FF); } }
    SEAM(11);
    if (IN(12)) norm_mod(F, X, nullptr, nullptr, norm2, modv, 3, 4, H, 0);
    SEAM(12);
    if (IN(13)) GEMM(EpiBf16S, H, D, ws + MN_W1_0, D, 66, 32, D, 0, 0, (bf16*)(ws + MN_U0), nullptr, nullptr, FF, 0, 0, 1000, 1000, 1);
    SEAM(13);
    if (IN(14)) { GEMM(EpiResid, ws + MN_U0, FF, ws + MN_W2_0, FF, 66, 8, FF, 0, 0, X, nullptr, nullptr, modv, 5);
        if (F.bid >= 16) { xpose(FI, args.in[26], 2 * D, D, 2 * D, (bf16*)(ws + MN_WLIN), D); xpose(FI, args.in[27], D, D, D, (bf16*)(ws + MN_WLOUT), D);
            for (int q = 0; q < 32; ++q) { const int gq = q >> 3, n = q & 7, d = gq & 1; const float* src = (gq < 2 ? args.in[30] : args.in[32]) + (size_t)(d * 8 + n) * 65536;
                xpose(FI, src, 256, 256, 256, (bf16*)(ws + MN_WG) + (size_t)(n * 1024 + gq * 256) * 256, 256); }
            xpose(FI, mlp_w1 + (size_t)D * FF, FF, D, FF, (bf16*)(ws + MN_W1_1), D); xpose(FI, mlp_w2 + (size_t)D * FF, D, FF, D, (bf16*)(ws + MN_W2_1), FF); } }
    SEAM(14);
    const float* modv1 = modv + 3 * 12288;
    if (IN(15)) norm_mod(F, X, nullptr, nullptr, norm1 + D, modv1, 0, 1, H, 0);
    SEAM(15);
    if (IN(16)) GEMM(EpiBf16S, H, D, ws + MN_WLIN, D, 66, 16, D, 0, 0, (bf16*)LP.GATE, (bf16*)LP.XBR, (bf16*)LP.XBR, D, D, D, 8, 1000, 0);
    SEAM(16);
    if (IN(17)) lru_conv(F, LP, (bf16*)LP.XS);
    SEAM(17);
    if (IN(18)) GEMM(EpiLruGate, LP.XS, D, ws + MN_WG, 256, 66, 32, 256, 0, 2, (bf16*)LP.Z, LP.ba, LP.bx, (const float*)(ws + WS_SPL));
    SEAM(18);
    if (IN(19)) lru_passA(F, LP);
    SEAM(19);
    if (IN(20)) lru_passB(F, LP);
    SEAM(20);
    if (IN(21)) lru_passC(F, LP);
    SEAM(21);
    if (IN(22)) GEMM(EpiResid, LP.Y, D, ws + MN_WLOUT, D, 64, 8, D, 1, 0, X, nullptr, nullptr, modv1, 2);
    SEAM(22);
    if (IN(23)) norm_mod(F, X, nullptr, nullptr, norm2 + D, modv1, 3, 4, H, 1);
    SEAM(23);
    if (IN(24)) GEMM(EpiBf16S, H, D, ws + MN_W1_1, D, 64, 32, D, 1, 0, (bf16*)(ws + MN_U1), nullptr, nullptr, FF, 0, 0, 1000, 1000, 1);
    SEAM(24);
    if (IN(25)) GEMM(EpiResid, ws + MN_U1, FF, ws + MN_W2_1, FF, 64, 8, FF, 1, 0, X, nullptr, nullptr, modv1, 5);
    SEAM(25);
    if (IN(26)) final_norm(F, X, args.in[35], args.out);
}

#ifndef N_LAUNCH_PER_PHASE
#define N_LAUNCH_PER_PHASE 0
#endif
extern "C" void kernel_launch(void* const* d_in, const int* in_sizes, int n_in, void* d_out, int out_size, void* d_ws, size_t ws_size, hipStream_t stream) {
    static int grid = 0;
    if (grid == 0) {
        if (n_in != 36 || ws_size < WS_END) { fprintf(stderr, "kernel_launch: unexpected n_in %d / ws_size %zu\n", n_in, ws_size); grid = -1; return; }
        int dev = 0, cus = 0, per_cu = 0;
        hipGetDevice(&dev); hipDeviceGetAttribute(&cus, hipDeviceAttributeMultiprocessorCount, dev);
        hipFuncSetAttribute((const void*)mega_fwd, hipFuncAttributeMaxDynamicSharedMemorySize, LDS_BYTES);
        hipOccupancyMaxActiveBlocksPerMultiprocessor(&per_cu, (const void*)mega_fwd, 512, LDS_BYTES);
        if (per_cu < 1) per_cu = 1;
        (void)hipGetLastError();
        grid = cus * per_cu;
    }
    if (grid < 0) return;
    if (hipMemsetAsync(d_ws, 0, 16384, stream) != hipSuccess) { fprintf(stderr, "memset failed\n"); return; }
    Args a{};
    for (int i = 0; i < 36; ++i) a.in[i] = (const float*)d_in[i];
    a.out = (float*)d_out; a.ws = (unsigned char*)d_ws;
#if N_LAUNCH_PER_PHASE
    for (int p = 0; p < NPH; ++p) { a.ph_lo = p; a.ph_hi = p + 1; hipLaunchKernelGGL(mega_fwd, dim3(grid), dim3(512), LDS_BYTES, stream, a); }
#else
    a.ph_lo = 0; a.ph_hi = NPH;
    void* kargs[] = {&a};
    hipError_t e = hipLaunchCooperativeKernel((const void*)mega_fwd, dim3(grid), dim3(512), kargs, LDS_BYTES, stream);
    if (e != hipSuccess) fprintf(stderr, "cooperative launch failed: %s (grid %d)\n", hipGetErrorString(e), grid);
#endif
}
```

```cpp
#include <hip/hip_runtime.h>
#include <hip/hip_cooperative_groups.h>
#include <cstdio>
namespace cg = cooperative_groups;

namespace pg8 {
#define PG8_LAS __attribute__((address_space(3)))
typedef unsigned short bf16_t;
typedef short bf16x8 __attribute__((ext_vector_type(8)));
typedef float f32x4 __attribute__((ext_vector_type(4)));
typedef unsigned u32x4 __attribute__((ext_vector_type(4)));
constexpr int BM = 256, BK = 64, HALF = 128, HTB = HALF * BK * 2, STAGE_BYTES = 8 * HTB, NXCD = 8, WGM = 8;
__host__ __device__ __forceinline__ int lds_byte(int r, int c) { const int st = (r >> 4) * 2 + (c >> 5), rr = r & 15, cc = c & 31, ob = rr * 64 + cc * 2; return st * 1024 + (ob ^ (((ob >> 9) & 1) << 5)); }
__host__ __device__ __forceinline__ void stage_rc(int b, int& R, int& C) { const int st = b / 1024, sb = b % 1024, swz = sb ^ (((sb >> 9) & 1) << 5); R = (st >> 1) * 16 + swz / 64; C = (st & 1) * 32 + (swz % 64) / 2; }
__host__ __device__ __forceinline__ int perm32(int rho) { const int n = rho >> 4, i = rho & 15; return 8 * (i >> 2) + 4 * n + (i & 3); }
struct Unit { int pm, pn; };
struct Gemm { const bf16_t* A; const bf16_t* Bt; int M, N, K, lda, ldb; };
struct Sched {
    int nM, nN, nwg, G, c, skip, amode;
    __device__ void init(int nM_, int nN_, int G_, int c_, int skip_, int amode_) { nM = nM_; nN = nN_; nwg = nM * nN; G = G_; c = c_; skip = skip_; amode = amode_; }
    __device__ bool next(int i, Unit& u) const {
        const long L = (long)i * G + c; if (L >= nwg) return false;
        int wgid = (int)L; { const int q = nwg / NXCD, r = nwg % NXCD, xcd = wgid % NXCD, off = wgid / NXCD; wgid = (xcd < r ? xcd * (q + 1) : r * (q + 1) + (xcd - r) * q) + off; }
        const int nig = WGM * nN, gid = wgid / nig, fm = gid * WGM, gsz = (nM - fm) < WGM ? (nM - fm) : WGM;
        int pm = fm + ((wgid % nig) % gsz); u.pn = (wgid % nig) / gsz;
        if (skip) pm = pm + pm / 32 + 1;
        u.pm = pm; return true;
    }
    __device__ __forceinline__ size_t a_off(const Unit& u) const {
        if (amode == 1) return (size_t)(u.pn < 4 ? 0 : (u.pn < 12 ? 256 : 512)) * 2;
        if (amode == 2) return (size_t)((u.pn >> 2) * 256) * 2;
        return 0;
    }
    __device__ __forceinline__ void a_ready(const Unit&) const {}
    __device__ __forceinline__ void done(const Unit&) const {}
};
__device__ __forceinline__ unsigned cvt_pk_bf16(float lo, float hi) { unsigned r; asm volatile("v_cvt_pk_bf16_f32 %0, %1, %2" : "=v"(r) : "v"(lo), "v"(hi)); return r; }

struct EpiBf16S {
    static constexpr bool PERM = true, AFTER_DRAIN = false;
    bf16_t* O0; bf16_t* O1; bf16_t* O2; int ld0, ld1, ld2, t1, t2, act;
    __device__ __forceinline__ void operator()(const f32x4 (&acc)[2][2][4][2], const Unit& u, int wr, int wc, int fr, int fq) const {
        const int row0 = u.pm * BM + wr * 64 + fr;
        bf16_t* base; int ldc, colt;
        if (u.pn < t1) { base = O0; ldc = ld0; colt = u.pn * BM; } else if (u.pn < t2) { base = O1; ldc = ld1; colt = (u.pn - t1) * BM; } else { base = O2; ldc = ld2; colt = (u.pn - t2) * BM; }
        const int col0 = colt + wc * 32 + 8 * fq;
#pragma unroll
        for (int ai = 0; ai < 2; ++ai)
#pragma unroll
            for (int m = 0; m < 4; ++m) { bf16_t* rowp = base + (size_t)(row0 + ai * HALF + m * 16) * ldc + col0;
#pragma unroll
                for (int bj = 0; bj < 2; ++bj) { f32x4 v0 = acc[ai][bj][m][0], v1 = acc[ai][bj][m][1];
                    if (act == 1) {
#pragma unroll
                        for (int e = 0; e < 4; ++e) { float a = v0[e] > 0.f ? v0[e] : 0.f; v0[e] = a * a; float b = v1[e] > 0.f ? v1[e] : 0.f; v1[e] = b * b; } }
                    u32x4 w; w.x = cvt_pk_bf16(v0[0], v0[1]); w.y = cvt_pk_bf16(v0[2], v0[3]); w.z = cvt_pk_bf16(v1[0], v1[1]); w.w = cvt_pk_bf16(v1[2], v1[3]);
                    *(u32x4*)(rowp + bj * HALF) = w; } }
    }
};
struct EpiResid {
    static constexpr bool PERM = false, AFTER_DRAIN = false;
    float* X; const float* xin; const float* cin; const float* modv; int gidx;
    __device__ __forceinline__ void operator()(const f32x4 (&acc)[2][2][4][2], const Unit& u, int wr, int wc, int fr, int fq) const {
        const int b = u.pm / 33, tt = u.pm % 33, mi = (tt == 0) ? 2 : b;
        const int rl0 = wr * 64 + fr, col0 = u.pn * BM + wc * 32 + 4 * fq;
        const float* gp = modv + (size_t)(mi * 6 + gidx) * 2048 + col0;
        f32x4 gv[2][2];
#pragma unroll
        for (int bj = 0; bj < 2; ++bj)
#pragma unroll
            for (int n = 0; n < 2; ++n) gv[bj][n] = *(const f32x4*)(gp + bj * HALF + n * 16);
#pragma unroll
        for (int ai = 0; ai < 2; ++ai)
#pragma unroll
            for (int m = 0; m < 4; ++m) { const int rl = rl0 + ai * HALF + m * 16;
                float* xp = X + (size_t)(u.pm * BM + rl) * 2048 + col0;
                const float* bp = xp;
                if (xin) bp = (tt == 0) ? (cin + (size_t)(b * 256 + rl) * 2048 + col0) : (xin + (size_t)(b * 8192 + (tt - 1) * 256 + rl) * 2048 + col0);
#pragma unroll
                for (int bj = 0; bj < 2; ++bj)
#pragma unroll
                    for (int n = 0; n < 2; ++n) { const f32x4 bv = *(const f32x4*)(bp + bj * HALF + n * 16); *(f32x4*)(xp + bj * HALF + n * 16) = bv + gv[bj][n] * acc[ai][bj][m][n]; } }
    }
};
struct EpiLruGate {
    static constexpr bool PERM = true, AFTER_DRAIN = false;
    bf16_t* Z; const float* ba; const float* bx; const float* lam;
    __device__ __forceinline__ void operator()(const f32x4 (&acc)[2][2][4][2], const Unit& u, int wr, int wc, int fr, int fq) const {
        const int n = u.pn >> 2, gq = u.pn & 3, d = gq & 1; const bool isx = gq >= 2;
        const int row0 = u.pm * BM + wr * 64 + fr, ct0 = wc * 32 + 8 * fq;
        float bias[2][8], spl[2][8];
#pragma unroll
        for (int bj = 0; bj < 2; ++bj)
#pragma unroll
            for (int e = 0; e < 8; ++e) { const int c = d * 2048 + n * 256 + ct0 + bj * HALF + e; bias[bj][e] = isx ? bx[c] : ba[c];
                spl[bj][e] = isx ? 0.f : lam[c]; }
#pragma unroll
        for (int ai = 0; ai < 2; ++ai)
#pragma unroll
            for (int m = 0; m < 4; ++m) { const int rr = row0 + ai * HALF + m * 16;
                bf16_t* rowp = Z + ((size_t)((rr >> 5) * 64 + u.pn * 2) * 32 + (rr & 31)) * 128 + ct0;
#pragma unroll
                for (int bj = 0; bj < 2; ++bj) { float v[8];
#pragma unroll
                    for (int e = 0; e < 4; ++e) { v[e] = acc[ai][bj][m][0][e]; v[4 + e] = acc[ai][bj][m][1][e]; }
#pragma unroll
                    for (int e = 0; e < 8; ++e) { const float r = __builtin_amdgcn_rcpf(1.f + __expf(-(v[e] + bias[bj][e]))); v[e] = isx ? r : r * spl[bj][e]; }
                    u32x4 w; w.x = cvt_pk_bf16(v[0], v[1]); w.y = cvt_pk_bf16(v[2], v[3]); w.z = cvt_pk_bf16(v[4], v[5]); w.w = cvt_pk_bf16(v[6], v[7]);
                    *(u32x4*)(rowp + bj * 32 * 128) = w; } }
    }
};
template <class Epi, class Sched, bool ALIGN_EPI = false, bool SP2 = false>
__device__ __forceinline__ void gemm_phase(PG8_LAS unsigned char* lds, const Gemm g, const Sched& S, const Epi& E) {
    const int tid = threadIdx.x, wid = __builtin_amdgcn_readfirstlane(tid >> 6), lane = tid & 63, wr = wid >> 2, wc = wid & 3, fr = lane & 15, fq = lane >> 4;
    const int K = g.K, nt = K / BK;
    unsigned voffA[2], voffB[2];
#pragma unroll
    for (int i = 0; i < 2; ++i) { int R, C; stage_rc(tid * 16 + i * 8192, R, C); const int Rb = Epi::PERM ? ((R & ~31) + perm32(R & 31)) : R;
        voffA[i] = (unsigned)(R * g.lda + C) * 2u; voffB[i] = (unsigned)(Rb * g.ldb + C) * 2u; }
    const size_t kstep = (size_t)(BK * 2);
    const size_t hstepA = (size_t)HALF * g.lda * 2, hstepB = (size_t)HALF * g.ldb * 2;
    const size_t tstepA = 2 * hstepA, tstepB = 2 * hstepB;
    const unsigned ldsw = (unsigned)wid * 1024u;
    const int aoff = lds_byte(wr * 64 + fr, fq * 8), boff = lds_byte(wc * 32 + fr, fq * 8);
#define PG8_SA(b, h) (((b) * 2 + (h)) * HTB)
#define PG8_SB(b, h) ((4 + (b) * 2 + (h)) * HTB)
#define PG8_STAGE(bufoff, gbase, voff) do { _Pragma("unroll") for (int _i = 0; _i < 2; ++_i) \
        __builtin_amdgcn_global_load_lds((const unsigned*)((const char*)(gbase) + (voff)[_i]), (PG8_LAS unsigned*)(lds + (bufoff) + ldsw + _i * 8192), 16, 0, 0); } while (0)
#define PG8_LDA(dst, b, h) do { _Pragma("unroll") for (int m = 0; m < 4; ++m) _Pragma("unroll") for (int k = 0; k < 2; ++k) dst[m][k] = *(const PG8_LAS bf16x8*)(lds + PG8_SA(b, h) + aoff + m * 2048 + k * 1024); } while (0)
#define PG8_LDB(dst, b, h) do { _Pragma("unroll") for (int n = 0; n < 2; ++n) _Pragma("unroll") for (int k = 0; k < 2; ++k) dst[n][k] = *(const PG8_LAS bf16x8*)(lds + PG8_SB(b, h) + boff + n * 2048 + k * 1024); } while (0)
#define PG8_MMA(ai, bj, At, Bt) do { __builtin_amdgcn_s_setprio(1); _Pragma("unroll") for (int m = 0; m < 4; ++m) _Pragma("unroll") for (int n = 0; n < 2; ++n) _Pragma("unroll") for (int k = 0; k < 2; ++k) \
        acc[ai][bj][m][n] = __builtin_amdgcn_mfma_f32_16x16x32_bf16(Bt[n][k], At[m][k], acc[ai][bj][m][n], 0, 0, 0); __builtin_amdgcn_s_setprio(0); } while (0)
#define PG8_WAIT_V(n) asm volatile("s_waitcnt vmcnt(" #n ")" ::: "memory")
#define PG8_WAIT_L(n) asm volatile("s_waitcnt lgkmcnt(" #n ")" ::: "memory")
#define PG8_BAR __builtin_amdgcn_s_barrier()
#define PG8_SCHED __builtin_amdgcn_sched_barrier(0)
    Unit cur, nxt; int ui = 0;
    if (!S.next(0, cur)) return;
    f32x4 acc[2][2][4][2];
#pragma unroll
    for (int a = 0; a < 2; ++a)
#pragma unroll
        for (int b = 0; b < 2; ++b)
#pragma unroll
            for (int m = 0; m < 4; ++m)
#pragma unroll
                for (int n = 0; n < 2; ++n) acc[a][b][m][n] = (f32x4){0.f, 0.f, 0.f, 0.f};
    bf16x8 At[4][2], B0[2][2], B1[2][2];
    const char* cA = (const char*)g.A + (size_t)cur.pm * tstepA + S.a_off(cur); const char* cB = (const char*)g.Bt + (size_t)cur.pn * tstepB;
    S.a_ready(cur);
    if constexpr (SP2) {
        PG8_STAGE(PG8_SB(0, 0), cB, voffB); PG8_STAGE(PG8_SB(0, 1), cB + hstepB, voffB); PG8_STAGE(PG8_SA(0, 0), cA, voffA); PG8_STAGE(PG8_SA(0, 1), cA + hstepA, voffA);
        if (wr == 1) PG8_BAR;
        PG8_WAIT_V(2); PG8_BAR;
        PG8_STAGE(PG8_SB(1, 0), cB + kstep, voffB); PG8_STAGE(PG8_SA(1, 0), cA + kstep, voffA); PG8_STAGE(PG8_SB(1, 1), cB + hstepB + kstep, voffB);
        PG8_WAIT_V(6); PG8_BAR;
    } else {
        PG8_STAGE(PG8_SB(0, 0), cB, voffB); PG8_STAGE(PG8_SA(0, 0), cA, voffA); PG8_STAGE(PG8_SB(0, 1), cB + hstepB, voffB); PG8_STAGE(PG8_SA(0, 1), cA + hstepA, voffA);
        if (wr == 1) PG8_BAR;
        PG8_WAIT_V(4); PG8_BAR;
        PG8_STAGE(PG8_SB(1, 0), cB + kstep, voffB); PG8_STAGE(PG8_SA(1, 0), cA + kstep, voffA); PG8_STAGE(PG8_SB(1, 1), cB + hstepB + kstep, voffB);
        PG8_WAIT_V(6); PG8_BAR;
    }
    for (;;) {
        const bool has_next = S.next(ui + 1, nxt);
        const char* nA = has_next ? (const char*)g.A + (size_t)nxt.pm * tstepA + S.a_off(nxt) : cA; const char* nB = has_next ? (const char*)g.Bt + (size_t)nxt.pn * tstepB : cB;
        _Pragma("unroll 1") for (int t = 0; t < nt; t += 2) {
            const bool last = (t == nt - 2);
            const char* a1 = cA + (size_t)(t + 1) * kstep;
            const char* a2 = last ? nA : cA + (size_t)(t + 2) * kstep; const char* b2 = last ? nB : cB + (size_t)(t + 2) * kstep;
            const char* a3 = a2 + kstep; const char* b3 = b2 + kstep;
            if (last && has_next) S.a_ready(nxt);
            if constexpr (SP2) {
            PG8_LDB(B0, 0, 0); PG8_LDB(B1, 0, 1); PG8_SCHED; PG8_LDA(At, 0, 0); PG8_STAGE(PG8_SA(1, 1), a1 + hstepA, voffA);
            PG8_WAIT_V(8); PG8_WAIT_L(0); PG8_BAR; PG8_MMA(0, 0, At, B0); PG8_MMA(0, 1, At, B1); PG8_BAR; PG8_SCHED;
            PG8_LDA(At, 0, 1); PG8_STAGE(PG8_SB(0, 0), b2, voffB); PG8_STAGE(PG8_SB(0, 1), b2 + hstepB, voffB); PG8_STAGE(PG8_SA(0, 0), a2, voffA);
            PG8_WAIT_V(8); PG8_WAIT_L(0); PG8_BAR; PG8_MMA(1, 0, At, B0); PG8_MMA(1, 1, At, B1); PG8_BAR; PG8_SCHED;
            PG8_LDB(B0, 1, 0); PG8_LDB(B1, 1, 1); PG8_SCHED; PG8_LDA(At, 1, 0); PG8_STAGE(PG8_SA(0, 1), a2 + hstepA, voffA);
            PG8_WAIT_V(8); PG8_WAIT_L(0); PG8_BAR; PG8_MMA(0, 0, At, B0); PG8_MMA(0, 1, At, B1); PG8_BAR; PG8_SCHED;
            PG8_LDA(At, 1, 1); PG8_STAGE(PG8_SB(1, 0), b3, voffB); PG8_STAGE(PG8_SB(1, 1), b3 + hstepB, voffB); PG8_STAGE(PG8_SA(1, 0), a3, voffA);
            PG8_WAIT_V(8); PG8_WAIT_L(0); PG8_BAR; PG8_MMA(1, 0, At, B0); PG8_MMA(1, 1, At, B1); PG8_BAR; PG8_SCHED;
            } else {
            PG8_LDB(B0, 0, 0); PG8_SCHED; PG8_LDA(At, 0, 0); PG8_STAGE(PG8_SA(1, 1), a1 + hstepA, voffA);
            PG8_WAIT_L(8); PG8_BAR; PG8_WAIT_L(0); PG8_MMA(0, 0, At, B0); PG8_BAR; PG8_SCHED;
            PG8_LDB(B1, 0, 1); PG8_STAGE(PG8_SB(0, 0), b2, voffB);
            PG8_BAR; PG8_WAIT_L(0); PG8_MMA(0, 1, At, B1); PG8_BAR;
            PG8_LDA(At, 0, 1); PG8_STAGE(PG8_SA(0, 0), a2, voffA);
            PG8_BAR; PG8_WAIT_L(0); PG8_MMA(1, 0, At, B0); PG8_BAR; PG8_SCHED;
            PG8_STAGE(PG8_SB(0, 1), b2 + hstepB, voffB);
            PG8_WAIT_V(6); PG8_BAR; PG8_MMA(1, 1, At, B1); PG8_BAR;
            PG8_LDB(B0, 1, 0); PG8_SCHED; PG8_LDA(At, 1, 0); PG8_STAGE(PG8_SA(0, 1), a2 + hstepA, voffA);
            PG8_WAIT_L(8); PG8_BAR; PG8_WAIT_L(0); PG8_MMA(0, 0, At, B0); PG8_BAR; PG8_SCHED;
            PG8_LDB(B1, 1, 1); PG8_STAGE(PG8_SB(1, 0), b3, voffB);
            PG8_BAR; PG8_WAIT_L(0); PG8_MMA(0, 1, At, B1); PG8_BAR;
            PG8_LDA(At, 1, 1); PG8_STAGE(PG8_SA(1, 0), a3, voffA);
            PG8_BAR; PG8_WAIT_L(0); PG8_MMA(1, 0, At, B0); PG8_BAR; PG8_SCHED;
            PG8_STAGE(PG8_SB(1, 1), b3 + hstepB, voffB);
            PG8_WAIT_V(6); PG8_BAR; PG8_MMA(1, 1, At, B1); PG8_BAR;
            }
        }
        if constexpr (ALIGN_EPI) { if (wr == 0) PG8_BAR; }
        if constexpr (!Epi::AFTER_DRAIN) { E(acc, cur, wr, wc, fr, fq); S.done(cur); }
        if (!has_next) break;
#pragma unroll
        for (int a = 0; a < 2; ++a)
#pragma unroll
            for (int b = 0; b < 2; ++b)
#pragma unroll
                for (int m = 0; m < 4; ++m)
#pragma unroll
                    for (int n = 0; n < 2; ++n) acc[a][b][m][n] = (f32x4){0.f, 0.f, 0.f, 0.f};
        cur = nxt; cA = nA; cB = nB; ++ui;
        if constexpr (ALIGN_EPI) { if (wr == 1) PG8_BAR; }
    }
    PG8_WAIT_V(0);
    if constexpr (!ALIGN_EPI) { if (wr == 0) PG8_BAR; }
    PG8_BAR;
    if constexpr (Epi::AFTER_DRAIN) { E.fused(acc, cur, wr, wc, fr, fq, lds, wid, lane); S.done(cur); }
#undef PG8_SA
#undef PG8_SB
#undef PG8_STAGE
#undef PG8_LDA
#undef PG8_LDB
#undef PG8_MMA
#undef PG8_WAIT_V
#undef PG8_WAIT_L
#undef PG8_BAR
#undef PG8_SCHED
}
}

typedef unsigned short bf16;
#define LASQ __attribute__((address_space(3)))
typedef float f32x4 __attribute__((ext_vector_type(4)));
typedef unsigned u32x4 __attribute__((ext_vector_type(4)));
typedef unsigned u32x2 __attribute__((ext_vector_type(2)));
constexpr int D = 2048, NB = 2, SEQ = 8192, CTX = 256, T = SEQ + CTX, M = NB * T, FF = 8192;
constexpr int ACOLS = 3712, BCOLS = 3104, PA_LD = 3840, PB_LD = 3328, NAB = 7168;
constexpr size_t MiB = 1u << 20;
constexpr size_t WS_MODV = 1 * MiB, WS_GDP = 2 * MiB;
constexpr size_t WS_WAB = 8 * MiB, WS_WOUT = 36 * MiB, WS_WLORA = 44 * MiB;
constexpr size_t WS_X = 48 * MiB, WS_HR = 180 * MiB, WS_MAIN = 246 * MiB, WS_END = 768 * MiB;
constexpr size_t MN_PA = WS_MAIN + 0 * MiB, MN_PB = WS_MAIN + 124 * MiB, MN_KV = WS_MAIN + 232 * MiB;
constexpr size_t MN_R = WS_MAIN + 364 * MiB, MN_V = WS_MAIN + 397 * MiB, MN_K = WS_MAIN + 430 * MiB;
constexpr size_t MN_O = WS_MAIN + 0 * MiB, MN_YD0 = WS_MAIN + 66 * MiB, MN_YD1 = WS_MAIN + 463 * MiB, MN_RA = WS_MAIN + 124 * MiB, MN_NT = WS_MAIN + 190 * MiB, MN_WKT = WS_MAIN + 256 * MiB;
constexpr size_t WS_GAM = 4 * MiB, WS_SPL = 7 * MiB;
constexpr size_t MN_W1_0 = WS_MAIN + 124 * MiB, MN_W2_0 = WS_MAIN + 156 * MiB, MN_U0 = WS_MAIN + 188 * MiB;
constexpr size_t MN_WLIN = WS_MAIN + 0 * MiB, MN_WLOUT = WS_MAIN + 16 * MiB, MN_WG = WS_MAIN + 24 * MiB, MN_W1_1 = WS_MAIN + 28 * MiB, MN_W2_1 = WS_MAIN + 60 * MiB;
constexpr size_t MN_GATE = WS_MAIN + 92 * MiB, MN_Z = WS_MAIN + 158 * MiB, MN_U1 = WS_MAIN + 158 * MiB;
constexpr size_t OT_GG = 0 * MiB, OT_WA0 = 33 * MiB, OT_LA = 99 * MiB, OT_XBR = 0 * MiB, OT_CAR = 66 * MiB, OT_Y = 0 * MiB;
constexpr int LDS_BYTES = 147456;
constexpr int NPH = 27;
constexpr int RCH = 132, RNCH = 64;
constexpr int LCH = 32, LNCH = T / LCH;

struct Args { const float* in[36]; float* out; unsigned char* ws; int ph_lo, ph_hi; };

__device__ __forceinline__ float bf2f(bf16 u) { return __builtin_bit_cast(float, (unsigned)u << 16); }

typedef float f32x2v __attribute__((ext_vector_type(2)));
typedef __bf16 bf16x2v __attribute__((ext_vector_type(2)));
__device__ __forceinline__ unsigned pk2(float lo, float hi) { const f32x2v v = {lo, hi}; const bf16x2v b = __builtin_convertvector(v, bf16x2v); return __builtin_bit_cast(unsigned, b); }
__device__ __forceinline__ unsigned f2bf(float f) { return pk2(f, 0.f) & 0xffffu; }
__device__ __forceinline__ float lo16(unsigned w) { return __builtin_bit_cast(float, w << 16); }
__device__ __forceinline__ float hi16(unsigned w) { return __builtin_bit_cast(float, w & 0xffff0000u); }
__device__ __forceinline__ float sigm(float x) { return __builtin_amdgcn_rcpf(1.f + __expf(-x)); }
__device__ __forceinline__ float softplus_(float x) { return x > 20.f ? x : log1pf(__expf(x)); }
__device__ __forceinline__ float silu_(float x) { return x * sigm(x); }
__device__ __forceinline__ float gelu_tanh(float x) { const float u = 0.7978845608028654f * (x + 0.044715f * x * x * x); return x * sigm(2.f * u); }
__device__ __forceinline__ float tanh_(float x) { return 2.f * sigm(2.f * x) - 1.f; }
__device__ __forceinline__ float wave_sum(float v) {
#pragma unroll
    for (int o = 1; o < 64; o <<= 1) v += __shfl_xor(v, o);
    return v;
}
#define LDS_BARRIER() do { asm volatile("s_waitcnt lgkmcnt(0)" ::: "memory"); __builtin_amdgcn_s_barrier(); asm volatile("" ::: "memory"); } while (0)
#define WAVE_LDS_SYNC() do { asm volatile("s_waitcnt lgkmcnt(0)" ::: "memory"); __builtin_amdgcn_wave_barrier(); } while (0)

#define XB_TMO      128
#define XB_XCNT(j)  (256  + 64 * (j))
#define XB_XSUB(j)  (1280 + 64 * (j))
#define XB_XGEN(j)  (2304 + 64 * (j))
#define XB_TOP      3328
#define XB_TOPGEN   3392
#define XCD_BAR_WORDS 3456
#define XB_SPIN_CAP (1u << 18)

__device__ __forceinline__ unsigned xb_ld(unsigned* p)              { return __hip_atomic_load(p, __ATOMIC_RELAXED, __HIP_MEMORY_SCOPE_AGENT); }
__device__ __forceinline__ unsigned xb_add(unsigned* p, unsigned v) { return __hip_atomic_fetch_add(p, v, __ATOMIC_RELAXED, __HIP_MEMORY_SCOPE_AGENT); }
__device__ __forceinline__ unsigned xb_xcc_id() { return (unsigned)__builtin_amdgcn_s_getreg((3 << 11) | 20) & 0xFu; }
#define XB_SPIN(cond, bar) do { unsigned _sp = 0; while (cond) { __builtin_amdgcn_s_sleep(1); \
    if ((++_sp & 255u) == 0u) { if (xb_ld(&(bar)[XB_TMO])) break; if (_sp > XB_SPIN_CAP) { atomicAdd(&(bar)[XB_TMO], 1u); break; } } } } while (0)

struct XcdBarrier {
    unsigned* bar; unsigned x;
    volatile unsigned* st;
};

__device__ __forceinline__ XcdBarrier xcd_barrier_post(unsigned* bar, volatile unsigned* st) {
    XcdBarrier b; b.bar = bar; b.x = xb_xcc_id(); b.st = st;
    if (threadIdx.x == 0) (void)xb_add(&bar[XB_XCNT(b.x)], 1u);
    return b;
}
__device__ __forceinline__ void xcd_barrier_complete(unsigned* bar, unsigned x, unsigned& nloc, unsigned& nx) {
    const unsigned G = gridDim.x * gridDim.y * gridDim.z;
    unsigned sum, cnt, mine, sp = 0u;
    for (;;) {
        sum = 0u; cnt = 0u; mine = 0u;
#pragma unroll
        for (unsigned j = 0; j < 16; ++j) { const unsigned c = xb_ld(&bar[XB_XCNT(j)]); sum += c; cnt += (c > 0u) ? 1u : 0u; mine = (j == x) ? c : mine; }
        if (sum == G) break;
        __builtin_amdgcn_s_sleep(1);
        if ((++sp & 255u) == 0u) { if (xb_ld(&bar[XB_TMO])) break; if (sp > XB_SPIN_CAP) { atomicAdd(&bar[XB_TMO], 1u); break; } }
    }
    nloc = mine > 0u ? mine : 1u; nx = cnt > 0u ? cnt : 1u;
}

__device__ __forceinline__ void xcd_barrier(const XcdBarrier& b) {
    asm volatile("s_waitcnt vmcnt(0)" ::: "memory");
    __syncthreads();
    if (threadIdx.x == 0) {
        unsigned* bar = b.bar;
        __builtin_amdgcn_s_waitcnt(0);
        unsigned nloc = b.st[0], nx = b.st[1];
        if (nloc == 0u) { xcd_barrier_complete(bar, b.x, nloc, nx); b.st[0] = nloc; b.st[1] = nx; }
        const unsigned old = xb_add(&bar[XB_XSUB(b.x)], 1u);
        const unsigned gen = old / nloc;
        if (old + 1u == (gen + 1u) * nloc) {
            __builtin_amdgcn_fence(__ATOMIC_RELEASE, "agent");
            asm volatile("s_waitcnt vmcnt(0)" ::: "memory");
            const unsigned og = xb_add(&bar[XB_TOP], 1u);
            const unsigned tg = og / nx;
            if (og + 1u == (tg + 1u) * nx) xb_add(&bar[XB_TOPGEN], 1u);
            else XB_SPIN(xb_ld(&bar[XB_TOPGEN]) == tg, bar);
            __builtin_amdgcn_fence(__ATOMIC_ACQUIRE, "agent");
            xb_add(&bar[XB_XGEN(b.x)], 1u);
            asm volatile("s_waitcnt vmcnt(0)" ::: "memory");
        } else {
            XB_SPIN(xb_ld(&bar[XB_XGEN(b.x)]) == gen, bar);
            __builtin_amdgcn_fence(__ATOMIC_ACQUIRE, "agent");
            asm volatile("s_waitcnt vmcnt(0)" ::: "memory");
        }
    }
    __syncthreads();
}


struct Ctx { unsigned char* lds; int tid, lane, wave, G, bid, gw, NGW; };

__device__ __forceinline__ int scan_t(int d, int sp) { return d ? (sp < CTX ? (CTX - 1 - sp) : (T + CTX - 1 - sp)) : sp; }

__device__ __forceinline__ void xpose_item(const float* W, int ldw, bf16* WT, int ldt, int nblk, float* scr, int item, int lane) {
    const int kb = item / nblk, nb = item % nblk, k0 = 64 * kb, n0 = 32 * nb;
    f32x4 t[8];
#pragma unroll
    for (int i = 0; i < 8; ++i) t[i] = *(const f32x4*)(W + (size_t)(k0 + 8 * i + (lane >> 3)) * ldw + n0 + 4 * (lane & 7));
#pragma unroll
    for (int i = 0; i < 8; ++i) { float* s = scr + (8 * i + (lane >> 3)) * 33 + 4 * (lane & 7); s[0] = t[i][0]; s[1] = t[i][1]; s[2] = t[i][2]; s[3] = t[i][3]; }
    WAVE_LDS_SYNC();
    const int c = lane & 7;
#pragma unroll
    for (int j = 0; j < 4; ++j) { const int n = (lane >> 3) + 8 * j; const float* s = scr + (8 * c) * 33 + n;
        u32x4 o; o.x = pk2(s[0 * 33], s[1 * 33]); o.y = pk2(s[2 * 33], s[3 * 33]); o.z = pk2(s[4 * 33], s[5 * 33]); o.w = pk2(s[6 * 33], s[7 * 33]);
        *(u32x4*)(WT + (size_t)(n0 + n) * ldt + k0 + 8 * c) = o; }
    WAVE_LDS_SYNC();
}
__device__ __forceinline__ void xpose(const Ctx& F, const float* W, int ldw, int K, int N, bf16* WT, int ldt) {
    float* scr = (float*)(F.lds + F.wave * 16384);
    const int nblk = N / 32, nit = (K / 64) * nblk;
    for (int it = F.gw; it < nit; it += F.NGW) xpose_item(W, ldw, WT, ldt, nblk, scr, it, F.lane);
}

__device__ __forceinline__ void mod_gemv(const Ctx& F, const float* c, const float* c_ctx, const float* mod_w, const float* mod_b, float* modv) {
    float* sv = (float*)F.lds;
    float* red = (float*)(F.lds + 32768);
    for (int i = F.tid; i < 3 * D; i += 512) { const int r = i / D, k = i % D; const float x = (r < 2) ? c[r * D + k] : c_ctx[k]; sv[i] = silu_(x); }
    __syncthreads();
    const int l4 = F.tid & 15, kg = F.tid >> 4;
    for (int it = F.bid; it < 2 * 192; it += F.G) {
        const int layer = it / 192, n0 = (it % 192) * 64;
        const float* Wp = mod_w + (size_t)layer * D * 12288 + n0 + 4 * l4;
        f32x4 a0 = {0.f, 0.f, 0.f, 0.f}, a1 = a0, a2 = a0;
#pragma unroll 8
        for (int kk = 0; kk < 64; ++kk) { const int k = kg * 64 + kk; const f32x4 w = *(const f32x4*)(Wp + (size_t)k * 12288);
            a0 += w * sv[k]; a1 += w * sv[D + k]; a2 += w * sv[2 * D + k]; }
        *(f32x4*)(red + (kg * 3 + 0) * 64 + 4 * l4) = a0; *(f32x4*)(red + (kg * 3 + 1) * 64 + 4 * l4) = a1; *(f32x4*)(red + (kg * 3 + 2) * 64 + 4 * l4) = a2;
        __syncthreads();
        if (F.tid < 192) { const int r = F.tid / 64, n = F.tid % 64; float s = mod_b[layer * 12288 + n0 + n];
            for (int g = 0; g < 32; ++g) s += red[(g * 3 + r) * 64 + n];
            modv[(size_t)(layer * 3 + r) * 12288 + n0 + n] = s; }
        __syncthreads();
    }
}

__device__ __forceinline__ void norm_mod(const Ctx& F, const float* X, const float* xin, const float* cin, const float* g, const float* modv, int ishift, int iscale, bf16* H, int latent_only) {
    for (int m = F.gw; m < M; m += F.NGW) {
        const int b = m / T, t = m % T;
        if (latent_only && t < CTX) continue;
        const float* xr = xin ? (t < CTX ? cin + (size_t)(b * CTX + t) * D : xin + (size_t)(b * SEQ + t - CTX) * D) : X + (size_t)m * D;
        const int mi = (t < CTX) ? 2 : b;
        const float* sh = modv + (size_t)(mi * 6 + ishift) * D; const float* sc = modv + (size_t)(mi * 6 + iscale) * D;
        f32x4 v[8]; float s = 0.f;
#pragma unroll
        for (int j = 0; j < 8; ++j) { v[j] = *(const f32x4*)(xr + 4 * F.lane + 256 * j); s += (v[j].x * v[j].x + v[j].y * v[j].y) + (v[j].z * v[j].z + v[j].w * v[j].w); }
        const float rstd = rsqrtf(wave_sum(s) * (1.f / D) + 1e-6f);
#pragma unroll
        for (int j = 0; j < 8; ++j) { const int col = 4 * F.lane + 256 * j;
            const f32x4 gg = *(const f32x4*)(g + col), s1 = *(const f32x4*)(sc + col), s0 = *(const f32x4*)(sh + col);
            const f32x4 y = v[j] * rstd * gg * (s1 + 1.f) + s0;
            u32x2 o; o.x = pk2(y.x, y.y); o.y = pk2(y.z, y.w);
            *(u32x2*)(H + (size_t)m * D + col) = o; }
    }
}
__device__ __forceinline__ void final_norm(const Ctx& F, const float* X, const float* g, float* out) {
    for (int r = F.gw; r < NB * SEQ; r += F.NGW) {
        const int b = r / SEQ, tl = r % SEQ; const float* xr = X + (size_t)(b * T + CTX + tl) * D;
        f32x4 v[8]; float s = 0.f;
#pragma unroll
        for (int j = 0; j < 8; ++j) { v[j] = *(const f32x4*)(xr + 4 * F.lane + 256 * j); s += (v[j].x * v[j].x + v[j].y * v[j].y) + (v[j].z * v[j].z + v[j].w * v[j].w); }
        const float rstd = rsqrtf(wave_sum(s) * (1.f / D) + 1e-6f);
#pragma unroll
        for (int j = 0; j < 8; ++j) { const int col = 4 * F.lane + 256 * j; *(f32x4*)(out + (size_t)r * D + col) = v[j] * rstd * *(const f32x4*)(g + col); }
    }
}

__device__ __forceinline__ void rwkv_mix(const Ctx& F, const bf16* PA, const float* mu, bf16* Rr, bf16* Rk, bf16* Rv, bf16* LA) {
    for (int m = F.gw; m < M; m += F.NGW) {
        const int t = m % T;
        const bool hp = (t != 0) && (t != CTX), hn = (t != CTX - 1) && (t != T - 1);
        const bf16* p0 = PA + (size_t)m * PA_LD;
        u32x4 cur[8], pv[8], nv[8];
#pragma unroll
        for (int q = 0; q < 8; ++q) { const int g8 = F.lane + 64 * q; const int c0 = (g8 < ACOLS / 8 ? g8 : 0) * 8;
            cur[q] = *(const u32x4*)(p0 + c0); pv[q] = (u32x4){0u, 0u, 0u, 0u}; nv[q] = (u32x4){0u, 0u, 0u, 0u};
            if (hp) pv[q] = *(const u32x4*)(p0 - PA_LD + c0);
            if (hn) nv[q] = *(const u32x4*)(p0 + PA_LD + c0); }
#pragma unroll
        for (int q = 0; q < 8; ++q) { const int g8 = F.lane + 64 * q; if (g8 >= ACOLS / 8) continue;
            const int c0 = g8 * 8;
            float y[8];
#pragma unroll
            for (int e = 0; e < 4; ++e) {
                const float pl = lo16(cur[q][e]), ph = hi16(cur[q][e]);
                y[2 * e] = pl + mu[c0 + 2 * e] * (lo16(pv[q][e]) - pl) + mu[ACOLS + c0 + 2 * e] * (lo16(nv[q][e]) - pl);
                y[2 * e + 1] = ph + mu[c0 + 2 * e + 1] * (hi16(pv[q][e]) - ph) + mu[ACOLS + c0 + 2 * e + 1] * (hi16(nv[q][e]) - ph);
            }
            bf16* dst;
            if (c0 < 1024) dst = Rr + (size_t)m * 1024 + c0;
            else if (c0 < 2048) dst = Rk + (size_t)m * 1024 + (c0 - 1024);
            else if (c0 < 3072) dst = Rv + (size_t)m * 1024 + (c0 - 2048);
            else if (c0 < 3328) { dst = LA + (size_t)m * 768 + (c0 - 3072);
#pragma unroll
                for (int e = 0; e < 8; ++e) y[e] = sigm(y[e]); }
            else if (c0 < 3520) { const int qq = c0 - 3328, d = qq / 96; dst = LA + (size_t)m * 768 + 256 + d * 256 + (qq - d * 96);
#pragma unroll
                for (int e = 0; e < 8; ++e) y[e] = tanh_(y[e]); }
            else { const int qq = c0 - 3520, d = qq / 96; dst = LA + (size_t)m * 768 + 256 + d * 256 + 96 + (qq - d * 96); }
            u32x4 o; o.x = pk2(y[0], y[1]); o.y = pk2(y[2], y[3]); o.z = pk2(y[4], y[5]); o.w = pk2(y[6], y[7]);
            *(u32x4*)dst = o;
        }
        if (F.lane < 16) { const int d = F.lane >> 3, j = F.lane & 7; const u32x4 z = {0u, 0u, 0u, 0u}; *(u32x4*)(LA + (size_t)m * 768 + 256 + d * 256 + 192 + 8 * j) = z; }
    }
}

typedef short bf16x8v __attribute__((ext_vector_type(8)));
constexpr int GC = 64, GNC = T / GC;
constexpr int GL_CUM = 0, GL_QI = 33792, GL_KI = 51200, GL_VV = 68608, GL_PP = 102400, GL_RSQ = 111616, GL_GW = 113664, GL_GD = 121856;
constexpr int GCLD = 132;
constexpr int QLD = 136, VLD = 264, PLD = 72;
struct GlaP { const bf16* PB; const float *gw2, *gb; bf16* KV; float* GDP; };
__device__ __forceinline__ int gla_chunk_of(int d, int pc) { return d ? (pc < 4 ? 3 - pc : 135 - pc) : pc; }
__device__ __forceinline__ void gla_gates(const Ctx& F, const GlaP& P, int b, int h, int d, int pos0) {
    LASQ float* cum = (LASQ float*)(F.lds + GL_CUM); LASQ float* gwl = (LASQ float*)(F.lds + GL_GW); LASQ float* gdl = (LASQ float*)(F.lds + GL_GD);
    const int p = F.tid >> 3, kg = F.tid & 7;
    { const int e = F.tid >> 5, q = F.tid & 31; *(LASQ f32x4*)(gwl + e * 128 + 4 * q) = *(const f32x4*)(P.gw2 + (size_t)(d * 16 + e) * 512 + h * 128 + 4 * q); }
    if (kg < 4) { const bf16* row = P.PB + (size_t)(b * T + pos0 + p) * PB_LD + 3072 + d * 16 + 4 * kg; const u32x2 g = *(const u32x2*)row;
        *(LASQ f32x4*)(gdl + p * 16 + 4 * kg) = (f32x4){lo16(g.x), hi16(g.x), lo16(g.y), hi16(g.y)}; }
    LDS_BARRIER();
    f32x4 z[4];
    const float* gbp = P.gb + d * 512 + h * 128 + kg * 16;
#pragma unroll
    for (int q = 0; q < 4; ++q) z[q] = *(const f32x4*)(gbp + 4 * q);
#pragma unroll 2
    for (int e = 0; e < 16; ++e) { const float g = gdl[p * 16 + e]; const LASQ float* gwp = gwl + e * 128 + kg * 16;
#pragma unroll
        for (int q = 0; q < 4; ++q) z[q] += *(const f32x4*)(gwp + 4 * q) * g; }
#pragma unroll
    for (int q = 0; q < 4; ++q) { f32x4 t;
#pragma unroll
        for (int e = 0; e < 4; ++e) { const float nz = -z[q][e]; t[e] = -((nz > 20.f) ? nz : __logf(1.f + __expf(nz))) * (1.f / 16.f); }
        *(LASQ f32x4*)(cum + p * GCLD + kg * 16 + 4 * q) = t; }
    LDS_BARRIER();
    if (F.tid < 128) { float tv[GC];
#pragma unroll
        for (int pp = 0; pp < GC; ++pp) tv[pp] = cum[pp * GCLD + F.tid];
        float s = 0.f;
        if (d == 0) {
#pragma unroll
            for (int pp = 0; pp < GC; ++pp) { s += tv[pp]; tv[pp] = s; } }
        else {
#pragma unroll
            for (int pp = GC - 1; pp >= 0; --pp) { s += tv[pp]; tv[pp] = s; } }
#pragma unroll
        for (int pp = 0; pp < GC; ++pp) cum[pp * GCLD + F.tid] = tv[pp]; }
    LDS_BARRIER();
}
__device__ __forceinline__ bf16x8v lfrag8(const LASQ bf16* p) { return *(const LASQ bf16x8v*)p; }
__device__ __forceinline__ bf16x8v lgather8(const LASQ bf16* p, int stride) { bf16x8v r;
#pragma unroll
    for (int e = 0; e < 8; ++e) r[e] = (short)p[e * stride];
    return r; }
__device__ __forceinline__ void gla_load_v(const Ctx& F, const GlaP& P, int b, int h, int pos0) {
    const int p = F.tid >> 3, kg = F.tid & 7; LASQ bf16* VV = (LASQ bf16*)(F.lds + GL_VV);
    const bf16* row = P.PB + (size_t)(b * T + pos0 + p) * PB_LD + 1024 + h * 256 + kg * 32;
#pragma unroll
    for (int q = 0; q < 4; ++q) *(LASQ u32x4*)(VV + p * VLD + kg * 32 + 8 * q) = *(const u32x4*)(row + 8 * q);
}
__device__ __forceinline__ void gla_kv(const Ctx& F, const GlaP& P) {
    LASQ float* cum = (LASQ float*)(F.lds + GL_CUM); LASQ bf16* KI = (LASQ bf16*)(F.lds + GL_KI); const LASQ bf16* VV = (const LASQ bf16*)(F.lds + GL_VV);
    const int p = F.tid >> 3, kg = F.tid & 7, row = F.lane & 15, quad = F.lane >> 4;
    for (int it = F.bid; it < 16 * GNC; it += F.G) {
        const int seq = it / GNC, c = it % GNC, b = seq >> 3, d = (seq >> 2) & 1, h = seq & 3;
        const int pc = gla_chunk_of(d, c), pos0 = pc * GC;
        gla_load_v(F, P, b, h, pos0);
        gla_gates(F, P, b, h, d, pos0);
        const int tp = d ? 0 : (GC - 1);
        { const bf16* rowp = P.PB + (size_t)(b * T + pos0 + p) * PB_LD + 512 + h * 128 + kg * 16;
          const u32x4 k0 = *(const u32x4*)rowp, k1 = *(const u32x4*)(rowp + 8);
          float kv[16];
#pragma unroll
          for (int e = 0; e < 4; ++e) { kv[2 * e] = lo16(k0[e]); kv[2 * e + 1] = hi16(k0[e]); kv[8 + 2 * e] = lo16(k1[e]); kv[8 + 2 * e + 1] = hi16(k1[e]); }
#pragma unroll
          for (int e = 0; e < 16; ++e) kv[e] *= __expf(cum[tp * GCLD + kg * 16 + e] - cum[p * GCLD + kg * 16 + e]);
          u32x4 o0, o1;
#pragma unroll
          for (int e = 0; e < 4; ++e) { o0[e] = pk2(kv[2 * e], kv[2 * e + 1]); o1[e] = pk2(kv[8 + 2 * e], kv[8 + 2 * e + 1]); }
          *(LASQ u32x4*)(KI + p * QLD + kg * 16) = o0; *(LASQ u32x4*)(KI + p * QLD + kg * 16 + 8) = o1; }
        if (F.tid < 128) P.GDP[(size_t)it * 128 + F.tid] = __expf(cum[tp * GCLD + F.tid]);
        LDS_BARRIER();
        const int v0 = 32 * F.wave;
        f32x4 acc[2][8];
#pragma unroll
        for (int mt = 0; mt < 2; ++mt)
#pragma unroll
            for (int nt = 0; nt < 8; ++nt) acc[mt][nt] = (f32x4){0.f, 0.f, 0.f, 0.f};
#pragma unroll
        for (int ks = 0; ks < 2; ++ks) {
            bf16x8v a[2];
#pragma unroll
            for (int mt = 0; mt < 2; ++mt) a[mt] = lgather8(VV + (ks * 32 + quad * 8) * VLD + v0 + mt * 16 + row, VLD);
#pragma unroll
            for (int nt = 0; nt < 8; ++nt) { const bf16x8v bb = lgather8(KI + (ks * 32 + quad * 8) * QLD + nt * 16 + row, QLD);
#pragma unroll
                for (int mt = 0; mt < 2; ++mt) acc[mt][nt] = __builtin_amdgcn_mfma_f32_16x16x32_bf16(a[mt], bb, acc[mt][nt], 0, 0, 0); }
        }
        bf16* kvp = P.KV + (size_t)it * 32768;
#pragma unroll
        for (int mt = 0; mt < 2; ++mt)
#pragma unroll
            for (int nt = 0; nt < 8; ++nt)
#pragma unroll
                for (int j = 0; j < 4; ++j) kvp[(size_t)(v0 + mt * 16 + quad * 4 + j) * 128 + nt * 16 + row] = (bf16)f2bf(acc[mt][nt][j]);
        LDS_BARRIER();
    }
}
__device__ __forceinline__ void gla_carry(const Ctx& F, const GlaP& P) {
    const int nth = F.G * 512;
    for (int i = F.bid * 512 + F.tid; i < 16 * 256 * 16; i += nth) {
        const int k8 = i & 15, v = (i >> 4) & 255, seq = i >> 12;
        float s[8];
#pragma unroll
        for (int e = 0; e < 8; ++e) s[e] = 0.f;
        for (int c0 = 0; c0 < GNC; c0 += 6) {
            u32x4 q[6]; f32x4 d0[6], d1[6];
#pragma unroll
            for (int j = 0; j < 6; ++j) { const size_t sc = (size_t)seq * GNC + c0 + j;
                q[j] = *(const u32x4*)(P.KV + (sc * 256 + v) * 128 + 8 * k8); d0[j] = *(const f32x4*)(P.GDP + sc * 128 + 8 * k8); d1[j] = *(const f32x4*)(P.GDP + sc * 128 + 8 * k8 + 4); }
#pragma unroll
            for (int j = 0; j < 6; ++j) { const size_t sc = (size_t)seq * GNC + c0 + j;
                u32x4 o;
#pragma unroll
                for (int e = 0; e < 4; ++e) o[e] = pk2(s[2 * e], s[2 * e + 1]);
                *(u32x4*)(P.KV + (sc * 256 + v) * 128 + 8 * k8) = o;
                const float dd[8] = {d0[j][0], d0[j][1], d0[j][2], d0[j][3], d1[j][0], d1[j][1], d1[j][2], d1[j][3]};
#pragma unroll
                for (int e = 0; e < 4; ++e) { s[2 * e] = s[2 * e] * dd[2 * e] + lo16(q[j][e]); s[2 * e + 1] = s[2 * e + 1] * dd[2 * e + 1] + hi16(q[j][e]); } }
        }
    }
}
__device__ __forceinline__ void gla_out(const Ctx& F, const GlaP& P, const float* gn, bf16* O) {
    LASQ float* cum = (LASQ float*)(F.lds + GL_CUM); LASQ bf16* QI = (LASQ bf16*)(F.lds + GL_QI); LASQ bf16* KI = (LASQ bf16*)(F.lds + GL_KI); const LASQ bf16* VV = (const LASQ bf16*)(F.lds + GL_VV);
    LASQ bf16* PP = (LASQ bf16*)(F.lds + GL_PP); LASQ float* RSQ = (LASQ float*)(F.lds + GL_RSQ);
    const int p = F.tid >> 3, kg = F.tid & 7, row = F.lane & 15, quad = F.lane >> 4, v0 = 32 * F.wave;
    for (int it = F.bid; it < NB * 4 * GNC; it += F.G) {
        const int pc = it % GNC, bh = it / GNC, b = bh >> 2, h = bh & 3, pos0 = pc * GC;
        gla_load_v(F, P, b, h, pos0);
        f32x4 acc[4][2];
#pragma unroll
        for (int mt = 0; mt < 4; ++mt) { acc[mt][0] = (f32x4){0.f, 0.f, 0.f, 0.f}; acc[mt][1] = (f32x4){0.f, 0.f, 0.f, 0.f}; }
#pragma unroll 1
        for (int d = 0; d < 2; ++d) {
            const int seq = (b * 2 + d) * 4 + h, c = gla_chunk_of(d, pc);
            const bf16* kvp = P.KV + ((size_t)seq * GNC + c) * 32768;
            gla_gates(F, P, b, h, d, pos0);
            bf16x8v kvf[4][2];
#pragma unroll
            for (int ks = 0; ks < 4; ++ks)
#pragma unroll
                for (int nt = 0; nt < 2; ++nt) kvf[ks][nt] = *(const bf16x8v*)(kvp + (size_t)(v0 + nt * 16 + row) * 128 + ks * 32 + quad * 8);
            { const bf16* rowp = P.PB + (size_t)(b * T + pos0 + p) * PB_LD + h * 128 + kg * 16;
              const u32x4 q0 = *(const u32x4*)rowp, q1 = *(const u32x4*)(rowp + 8), k0 = *(const u32x4*)(rowp + 512), k1 = *(const u32x4*)(rowp + 520);
              float qv[16], kv[16];
#pragma unroll
              for (int e = 0; e < 4; ++e) { qv[2 * e] = lo16(q0[e]); qv[2 * e + 1] = hi16(q0[e]); qv[8 + 2 * e] = lo16(q1[e]); qv[8 + 2 * e + 1] = hi16(q1[e]);
                  kv[2 * e] = lo16(k0[e]); kv[2 * e + 1] = hi16(k0[e]); kv[8 + 2 * e] = lo16(k1[e]); kv[8 + 2 * e + 1] = hi16(k1[e]); }
#pragma unroll
              for (int e = 0; e < 16; ++e) { const float cc = cum[p * GCLD + kg * 16 + e]; qv[e] *= 0.08838834764831845f * __expf(cc); kv[e] *= __expf(-cc); }
              u32x4 o0, o1, o2, o3;
#pragma unroll
              for (int e = 0; e < 4; ++e) { o0[e] = pk2(qv[2 * e], qv[2 * e + 1]); o1[e] = pk2(qv[8 + 2 * e], qv[8 + 2 * e + 1]); o2[e] = pk2(kv[2 * e], kv[2 * e + 1]); o3[e] = pk2(kv[8 + 2 * e], kv[8 + 2 * e + 1]); }
              *(LASQ u32x4*)(QI + p * QLD + kg * 16) = o0; *(LASQ u32x4*)(QI + p * QLD + kg * 16 + 8) = o1; *(LASQ u32x4*)(KI + p * QLD + kg * 16) = o2; *(LASQ u32x4*)(KI + p * QLD + kg * 16 + 8) = o3; }
            LDS_BARRIER();
#pragma unroll
            for (int tt = 0; tt < 2; ++tt) { const int t = 2 * F.wave + tt, itl = t >> 2, jt = t & 3;
                f32x4 sc = {0.f, 0.f, 0.f, 0.f};
                const bool live = d ? (jt >= itl) : (jt <= itl);
                if (live) {
#pragma unroll
                    for (int ks = 0; ks < 4; ++ks) { const bf16x8v a = lfrag8(QI + (itl * 16 + row) * QLD + ks * 32 + quad * 8), bb = lfrag8(KI + (jt * 16 + row) * QLD + ks * 32 + quad * 8);
                        sc = __builtin_amdgcn_mfma_f32_16x16x32_bf16(a, bb, sc, 0, 0, 0); } }
#pragma unroll
                for (int j = 0; j < 4; ++j) { const int ii = itl * 16 + quad * 4 + j, jj = jt * 16 + row; const bool keep = d ? (jj >= ii) : (jj <= ii);
                    PP[ii * PLD + jj] = (bf16)f2bf(keep ? sc[j] : 0.f); } }
            LDS_BARRIER();
#pragma unroll
            for (int ks = 0; ks < 2; ++ks) {
                bf16x8v bb[2];
#pragma unroll
                for (int nt = 0; nt < 2; ++nt) bb[nt] = lgather8(VV + (ks * 32 + quad * 8) * VLD + v0 + nt * 16 + row, VLD);
#pragma unroll
                for (int mt = 0; mt < 4; ++mt) { const bf16x8v a = lfrag8(PP + (mt * 16 + row) * PLD + ks * 32 + quad * 8);
                    acc[mt][0] = __builtin_amdgcn_mfma_f32_16x16x32_bf16(a, bb[0], acc[mt][0], 0, 0, 0); acc[mt][1] = __builtin_amdgcn_mfma_f32_16x16x32_bf16(a, bb[1], acc[mt][1], 0, 0, 0); }
            }
#pragma unroll
            for (int ks = 0; ks < 4; ++ks) {
#pragma unroll
                for (int mt = 0; mt < 4; ++mt) { const bf16x8v a = lfrag8(QI + (mt * 16 + row) * QLD + ks * 32 + quad * 8);
                    acc[mt][0] = __builtin_amdgcn_mfma_f32_16x16x32_bf16(a, kvf[ks][0], acc[mt][0], 0, 0, 0); acc[mt][1] = __builtin_amdgcn_mfma_f32_16x16x32_bf16(a, kvf[ks][1], acc[mt][1], 0, 0, 0); }
            }
            LDS_BARRIER();
        }
#pragma unroll
        for (int mt = 0; mt < 4; ++mt)
#pragma unroll
            for (int j = 0; j < 4; ++j) { float ss = acc[mt][0][j] * acc[mt][0][j] + acc[mt][1][j] * acc[mt][1][j];
                ss += __shfl_xor(ss, 1); ss += __shfl_xor(ss, 2); ss += __shfl_xor(ss, 4); ss += __shfl_xor(ss, 8);
                if (row == 0) RSQ[F.wave * 64 + mt * 16 + quad * 4 + j] = ss; }
        LDS_BARRIER();
        const bf16* gbase = P.PB + (size_t)(b * T + pos0 + quad * 4) * PB_LD + 2048 + h * 256 + v0 + row; bf16* obase = O + (size_t)(b * T + pos0 + quad * 4) * 2048 + 1024 + h * 256 + v0 + row;
        const float gnv[2] = {gn[v0 + row], gn[v0 + 16 + row]};
#pragma unroll
        for (int mt = 0; mt < 4; ++mt)
#pragma unroll
            for (int j = 0; j < 4; ++j) { const int pr = mt * 16 + quad * 4 + j; float ss = 0.f;
#pragma unroll
                for (int w = 0; w < 8; ++w) ss += RSQ[w * 64 + pr];
                const float rs = rsqrtf(ss * (1.f / 256.f) + 1e-6f);
#pragma unroll
                for (int nt = 0; nt < 2; ++nt) { const float g = bf2f(gbase[(mt * 16 + j) * PB_LD + nt * 16]);
                    obase[(mt * 16 + j) * 2048 + nt * 16] = (bf16)f2bf(acc[mt][nt][j] * rs * gnv[nt] * silu_(g)); } }
        LDS_BARRIER();
    }
}

constexpr int RWC = 64, RWN = T / RWC;
constexpr int RW_CUM = 0, RW_AT = 17408, RW_RT = 26624, RW_BT = 35840, RW_KT = 45056, RW_BH = 54272, RW_KH = 63488, RW_VT = 72704, RW_M1 = 81920, RW_M2 = 98304, RW_M3 = 114688, RW_M4 = 123904, RW_TM2 = 133120;
constexpr int CLD = 68;
constexpr int RLD = 72;
struct RwP2 { const bf16 *Rr, *Rk, *Rv, *WA0, *WA1; const float *w0, *a0, *kkw, *kaw; bf16 *RA, *NT, *WKT; float* GAM; bf16 *YD0, *YD1; };
__device__ __forceinline__ void unpack8(const u32x4 w, float (&o)[8]) {
#pragma unroll
    for (int e = 0; e < 4; ++e) { o[2 * e] = lo16(w[e]); o[2 * e + 1] = hi16(w[e]); } }
__device__ __forceinline__ u32x4 pack8(const float (&v)[8]) { u32x4 o;
#pragma unroll
    for (int e = 0; e < 4; ++e) o[e] = pk2(v[2 * e], v[2 * e + 1]);
    return o; }
template <int Q> __device__ __forceinline__ void rw1_scores(LASQ unsigned char* L, int half, int row, int quad) {
    const LASQ bf16* Am = (const LASQ bf16*)(L + ((Q < 2) ? RW_AT : RW_RT)) + row * RLD + quad * 8;
    const LASQ bf16* Bm = (const LASQ bf16*)(L + ((Q & 1) ? RW_KT : RW_BT)) + row * RLD + quad * 8;
    LASQ float* Mf = (LASQ float*)(L + (Q == 0 ? RW_M1 : RW_M2)) + (quad * 4) * 64 + row;
    LASQ bf16* Mb = (LASQ bf16*)(L + (Q == 2 ? RW_M3 : RW_M4)) + (quad * 4) * RLD + row;
#pragma unroll 2
    for (int tt = 0; tt < 8; ++tt) { const int t = half * 8 + tt, mt = t >> 2, nt = t & 3;
        f32x4 acc = {0.f, 0.f, 0.f, 0.f};
        if (nt <= mt) { const LASQ bf16* ap = Am + mt * 16 * RLD; const LASQ bf16* bp = Bm + nt * 16 * RLD;
            acc = __builtin_amdgcn_mfma_f32_16x16x32_bf16(lfrag8(ap), lfrag8(bp), acc, 0, 0, 0); acc = __builtin_amdgcn_mfma_f32_16x16x32_bf16(lfrag8(ap + 32), lfrag8(bp + 32), acc, 0, 0, 0); }
        const int di = mt * 16 + quad * 4 - (nt * 16 + row);
        if (Q < 2) { LASQ float* d = Mf + mt * 16 * 64 + nt * 16;
#pragma unroll
            for (int jj = 0; jj < 4; ++jj) d[jj * 64] = (di + jj > 0) ? acc[jj] : 0.f; }
        else { LASQ bf16* d = Mb + mt * 16 * RLD + nt * 16;
#pragma unroll
            for (int jj = 0; jj < 4; ++jj) d[jj * RLD] = (bf16)(pk2((di + jj >= 0) ? acc[jj] : 0.f, 0.f) & 0xffffu); }
    }
}
template <int Q> __device__ __forceinline__ void rw1_products(LASQ unsigned char* L, int half, int row, int quad, bf16* gout) {
    const LASQ bf16* M3 = (const LASQ bf16*)(L + RW_M3) + row * RLD + quad * 8;
    const LASQ bf16* TX = (const LASQ bf16*)(L + ((Q == 0 || Q == 2) ? RW_CUM : RW_TM2)) + row * RLD + quad * 8;
    const LASQ bf16* Bh = (const LASQ bf16*)(L + RW_BH) + row * RLD + quad * 8;
    const LASQ bf16* Ad = (const LASQ bf16*)(L + (Q == 0 ? RW_RT : (Q == 1 ? RW_M4 : RW_KH))) + (quad * 4) * RLD + row;
    LASQ bf16* CY = (LASQ bf16*)(L + RW_M1) + (quad * 4) * RLD + row;
#pragma unroll 2
    for (int tt = 0; tt < 8; ++tt) { const int t = half * 8 + tt, mt = t >> 2, nt = t & 3;
        f32x4 acc = {0.f, 0.f, 0.f, 0.f};
#pragma unroll
        for (int ks = 0; ks < 2; ++ks) { bf16x8v a, bb;
            if (Q < 2) { a = lfrag8(M3 + mt * 16 * RLD + ks * 32); bb = lfrag8(TX + nt * 16 * RLD + ks * 32); }
            else { a = lfrag8(TX + mt * 16 * RLD + ks * 32); bb = lfrag8(Bh + nt * 16 * RLD + ks * 32); }
            acc = __builtin_amdgcn_mfma_f32_16x16x32_bf16(a, bb, acc, 0, 0, 0); }
        float o[4];
        if (Q != 2) { const LASQ bf16* ad = Ad + mt * 16 * RLD + nt * 16;
#pragma unroll
            for (int jj = 0; jj < 4; ++jj) o[jj] = acc[jj] + bf2f(ad[jj * RLD]); }
        else {
#pragma unroll
            for (int jj = 0; jj < 4; ++jj) o[jj] = acc[jj]; }
        if (Q == 0) { bf16* g = gout + (mt * 16 + quad * 4) * 64 + nt * 16 + row;
#pragma unroll
            for (int jj = 0; jj < 4; ++jj) g[jj * 64] = (bf16)(pk2(o[jj], 0.f) & 0xffffu); }
        else if (Q == 1) { LASQ bf16* d = CY + mt * 16 * RLD + nt * 16;
#pragma unroll
            for (int jj = 0; jj < 4; ++jj) d[jj * RLD] = (bf16)(pk2(o[jj], 0.f) & 0xffffu); }
        else { u32x2 w; w.x = pk2(o[0], o[1]); w.y = pk2(o[2], o[3]); *(u32x2*)(gout + (nt * 16 + row) * 64 + mt * 16 + quad * 4) = w; }
    }
}
__device__ __forceinline__ void rwkv_chunk_prep(const Ctx& F, const RwP2& P) {
    LASQ float* CUM = (LASQ float*)(F.lds + RW_CUM); LASQ bf16* At = (LASQ bf16*)(F.lds + RW_AT); LASQ bf16* Rt = (LASQ bf16*)(F.lds + RW_RT); LASQ bf16* Bt = (LASQ bf16*)(F.lds + RW_BT); LASQ bf16* Kt = (LASQ bf16*)(F.lds + RW_KT);
    LASQ bf16* Bh = (LASQ bf16*)(F.lds + RW_BH); LASQ bf16* Kh = (LASQ bf16*)(F.lds + RW_KH); LASQ bf16* Vt = (LASQ bf16*)(F.lds + RW_VT); LASQ float* M1 = (LASQ float*)(F.lds + RW_M1); LASQ float* M2 = (LASQ float*)(F.lds + RW_M2);
    LASQ bf16* M3 = (LASQ bf16*)(F.lds + RW_M3); LASQ bf16* M4 = (LASQ bf16*)(F.lds + RW_M4); LASQ bf16* TA = (LASQ bf16*)(F.lds + RW_CUM); LASQ bf16* TM2 = (LASQ bf16*)(F.lds + RW_TM2); LASQ bf16* CY = (LASQ bf16*)(F.lds + RW_M1); LASQ float* XA = (LASQ float*)(F.lds + RW_BT);
    const int ri = F.tid >> 3, kg = F.tid & 7, k0 = kg * 8, row = F.lane & 15, quad = F.lane >> 4;
    u32x4 raw[5];
    if (F.bid < 64 * RWN) { const int seq = F.bid / RWN, ch = F.bid % RWN, b = seq >> 5, d = (seq >> 4) & 1, h = seq & 15, c0 = h * 64 + k0; const bf16* WA = d ? P.WA1 : P.WA0;
        const size_t m = (size_t)b * T + scan_t(d, ch * RWC + ri);
        raw[0] = *(const u32x4*)(P.Rr + m * 1024 + c0); raw[1] = *(const u32x4*)(P.Rk + m * 1024 + c0); raw[2] = *(const u32x4*)(P.Rv + m * 1024 + c0);
        raw[3] = *(const u32x4*)(WA + m * 2048 + c0); raw[4] = *(const u32x4*)(WA + m * 2048 + 1024 + c0); }
    for (int item = F.bid; item < 64 * RWN; item += F.G) {
        const int seq = item / RWN, ch = item % RWN, b = seq >> 5, d = (seq >> 4) & 1, h = seq & 15, c0 = h * 64 + k0;
        bf16* YD = d ? P.YD1 : P.YD0;
        float rr[8], kd[8], bv[8], av[8], vv[8], lw[8];
        { float kr[8], wl[8], al[8];
          unpack8(raw[0], rr); unpack8(raw[1], kr); unpack8(raw[2], vv); unpack8(raw[3], wl); unpack8(raw[4], al);
          { const int itn = (item + F.G < 64 * RWN) ? item + F.G : item;
            const int seqn = itn / RWN, chn = itn % RWN, bn = seqn >> 5, dn = (seqn >> 4) & 1, hn = seqn & 15, cn = hn * 64 + k0; const bf16* WAn = dn ? P.WA1 : P.WA0;
            const size_t mn = (size_t)bn * T + scan_t(dn, chn * RWC + ri);
            raw[0] = *(const u32x4*)(P.Rr + mn * 1024 + cn); raw[1] = *(const u32x4*)(P.Rk + mn * 1024 + cn); raw[2] = *(const u32x4*)(P.Rv + mn * 1024 + cn);
            raw[3] = *(const u32x4*)(WAn + mn * 2048 + cn); raw[4] = *(const u32x4*)(WAn + mn * 2048 + 1024 + cn); }
          float ckk[8], ca0[8], cka[8], cw0[8];
#pragma unroll
          for (int q = 0; q < 2; ++q) { const f32x4 t0 = *(const f32x4*)(P.kkw + c0 + 4 * q), t1 = *(const f32x4*)(P.a0 + d * 1024 + c0 + 4 * q), t2 = *(const f32x4*)(P.kaw + c0 + 4 * q), t3 = *(const f32x4*)(P.w0 + d * 1024 + c0 + 4 * q);
#pragma unroll
              for (int e = 0; e < 4; ++e) { ckk[4 * q + e] = t0[e]; ca0[4 * q + e] = t1[e]; cka[4 * q + e] = t2[e]; cw0[4 * q + e] = t3[e]; } }
          float ss = 0.f, kn[8];
#pragma unroll
          for (int e = 0; e < 8; ++e) { kn[e] = kr[e] * ckk[e]; ss += kn[e] * kn[e]; }
          ss += __shfl_xor(ss, 1); ss += __shfl_xor(ss, 2); ss += __shfl_xor(ss, 4);
          const float inv = __builtin_amdgcn_rsqf(fmaxf(ss, 1e-24f));
#pragma unroll
          for (int e = 0; e < 8; ++e) { const float kk = kn[e] * inv; const float ag = sigm(ca0[e] + al[e]);
              kd[e] = kr[e] * (1.f + (ag - 1.f) * cka[e]); bv[e] = kk * ag; av[e] = -kk;
              lw[e] = -0.6065306597126334f * sigm(cw0[e] + wl[e]); }
          *(LASQ f32x4*)(CUM + ri * CLD + k0) = (f32x4){lw[0], lw[1], lw[2], lw[3]}; *(LASQ f32x4*)(CUM + ri * CLD + k0 + 4) = (f32x4){lw[4], lw[5], lw[6], lw[7]}; }
        LDS_BARRIER();
        if (F.tid < 64) { float tv[RWC];
#pragma unroll
            for (int i = 0; i < RWC; ++i) tv[i] = CUM[i * CLD + F.tid];
            float s = 0.f;
#pragma unroll
            for (int i = 0; i < RWC; ++i) { s += tv[i]; tv[i] = s; }
#pragma unroll
            for (int i = 0; i < RWC; ++i) CUM[i * CLD + F.tid] = tv[i]; }
        LDS_BARRIER();
        { float o1[8], o2[8], o3[8], o4[8], o5[8], o6[8];
#pragma unroll
          for (int e = 0; e < 8; ++e) { const float cm = CUM[ri * CLD + k0 + e], c63 = CUM[63 * CLD + k0 + e];
              const float ecx = __expf(cm - lw[e]), ec = __expf(cm), en = __expf(-cm), eh = __expf(c63 - cm);
              o1[e] = av[e] * ecx; o2[e] = rr[e] * ec; o3[e] = bv[e] * en; o4[e] = kd[e] * en; o5[e] = bv[e] * eh; o6[e] = kd[e] * eh;
              if (ri == 63) P.GAM[(size_t)item * 64 + k0 + e] = ec; }
          *(LASQ u32x4*)(At + ri * RLD + k0) = pack8(o1); *(LASQ u32x4*)(Rt + ri * RLD + k0) = pack8(o2); *(LASQ u32x4*)(Bt + ri * RLD + k0) = pack8(o3); *(LASQ u32x4*)(Kt + ri * RLD + k0) = pack8(o4);
          *(LASQ u32x4*)(Kh + ri * RLD + k0) = pack8(o6);
#pragma unroll
          for (int e = 0; e < 8; ++e) { Bh[(k0 + e) * RLD + ri] = (bf16)f2bf(o5[e]); Vt[(k0 + e) * RLD + ri] = (bf16)f2bf(vv[e]); } }
        LDS_BARRIER();
        { LASQ unsigned char* L = (LASQ unsigned char*)F.lds; const int q = F.wave >> 1, half = F.wave & 1;
          if (q == 0) rw1_scores<0>(L, half, row, quad); else if (q == 1) rw1_scores<1>(L, half, row, quad); else if (q == 2) rw1_scores<2>(L, half, row, quad); else rw1_scores<3>(L, half, row, quad); }
        LDS_BARRIER();
        { const int e0 = F.tid * 8, xi = e0 >> 6, xc = e0 & 63; float t8[8]; unpack8(*(const LASQ u32x4*)(At + xi * RLD + xc), t8);
          *(LASQ f32x4*)(XA + xi * 64 + xc) = (f32x4){t8[0], t8[1], t8[2], t8[3]}; *(LASQ f32x4*)(XA + xi * 64 + xc + 4) = (f32x4){t8[4], t8[5], t8[6], t8[7]}; }
        LDS_BARRIER();
#pragma unroll 1
        for (int r = 0; r < 4; ++r) {
            if (r > 0) { LASQ float* Xh = (F.wave < 4) ? XA : M2; const LASQ bf16* Xb = (F.wave < 4) ? TA : TM2; const int cb = (F.wave & 3) * 16;
                f32x4 acc = {0.f, 0.f, 0.f, 0.f};
                for (int ks = 0; ks < ((r + 1) >> 1); ++ks) { bf16x8v a; const LASQ float* mr = M1 + (16 * r + row) * 64 + ks * 32 + quad * 8;
                    const f32x4 m0 = *(const LASQ f32x4*)mr, m1v = *(const LASQ f32x4*)(mr + 4);
#pragma unroll
                    for (int e = 0; e < 8; ++e) { const int j = ks * 32 + quad * 8 + e; const float mv = (e < 4) ? m0[e & 3] : m1v[e & 3]; a[e] = (short)((j < 16 * r) ? f2bf(mv) : 0u); }
                    const int jb = ks * 32 + quad * 8; bf16x8v bb = lfrag8(Xb + (cb + row) * RLD + jb);
                    if (jb >= 16 * r) bb = (bf16x8v){0, 0, 0, 0, 0, 0, 0, 0};
                    acc = __builtin_amdgcn_mfma_f32_16x16x32_bf16(a, bb, acc, 0, 0, 0); }
#pragma unroll
                for (int jj = 0; jj < 4; ++jj) Xh[(16 * r + quad * 4 + jj) * 64 + cb + row] += acc[jj]; }
            LDS_BARRIER();
            if (F.tid < 128) { const int col = F.tid & 63; LASQ float* Xh = (F.tid < 64) ? XA : M2; LASQ bf16* dst = (F.tid < 64) ? TA : TM2;
                float x[16];
#pragma unroll
                for (int ii = 0; ii < 16; ++ii) x[ii] = Xh[(16 * r + ii) * 64 + col];
#pragma unroll
                for (int jj = 0; jj < 15; ++jj) {
#pragma unroll
                    for (int ii = jj + 1; ii < 16; ++ii) x[ii] += M1[(16 * r + ii) * 64 + 16 * r + jj] * x[jj]; }
                u32x4 w0, w1;
#pragma unroll
                for (int e = 0; e < 4; ++e) { w0[e] = pk2(x[2 * e], x[2 * e + 1]); w1[e] = pk2(x[8 + 2 * e], x[8 + 2 * e + 1]); }
                *(LASQ u32x4*)(dst + col * RLD + 16 * r) = w0; *(LASQ u32x4*)(dst + col * RLD + 16 * r + 8) = w1; }
            LDS_BARRIER();
        }
        { LASQ unsigned char* L = (LASQ unsigned char*)F.lds; const int q = F.wave >> 1, half = F.wave & 1;
          if (q == 0) rw1_products<0>(L, half, row, quad, P.RA + (size_t)item * 4096); else if (q == 1) rw1_products<1>(L, half, row, quad, nullptr);
          else if (q == 2) rw1_products<2>(L, half, row, quad, P.NT + (size_t)item * 4096); else rw1_products<3>(L, half, row, quad, P.WKT + (size_t)item * 4096); }
        LDS_BARRIER();
#pragma unroll
        for (int tt = 0; tt < 2; ++tt) { const int t = 2 * F.wave + tt, mt = t >> 2, nt = t & 3;
            f32x4 acc = {0.f, 0.f, 0.f, 0.f};
#pragma unroll
            for (int ks = 0; ks < 2; ++ks) acc = __builtin_amdgcn_mfma_f32_16x16x32_bf16(lfrag8(CY + (mt * 16 + row) * RLD + ks * 32 + quad * 8), lfrag8(Vt + (nt * 16 + row) * RLD + ks * 32 + quad * 8), acc, 0, 0, 0);
#pragma unroll
            for (int jj = 0; jj < 4; ++jj) { const size_t m = (size_t)b * T + scan_t(d, ch * RWC + mt * 16 + quad * 4 + jj); YD[m * 1024 + h * 64 + nt * 16 + row] = (bf16)f2bf(acc[jj]); } }
        LDS_BARRIER();
    }
}
constexpr int R2_RA = 0, R2_NT = 9216, R2_WK = 18432, R2_V = 27648, R2_Y = 30720, R2_G = 33792, R2_BUF = 34048, R2_SL = 2 * R2_BUF, VL2 = 24;
struct RwSet { u32x4 a, n, w, x; };
__device__ __forceinline__ void rw2_fetch(const Ctx& F, const RwP2& P, RwSet& o, int seq, int c, int b, int d, int h, int vq) {
    if (c >= RWN) c = RWN - 1;
    const size_t item = (size_t)seq * RWN + c; const bf16* YD = d ? P.YD1 : P.YD0;
    o.a = *(const u32x4*)(P.RA + item * 4096 + F.tid * 8); o.n = *(const u32x4*)(P.NT + item * 4096 + F.tid * 8); o.w = *(const u32x4*)(P.WKT + item * 4096 + F.tid * 8);
    o.x = (u32x4){0u, 0u, 0u, 0u};
    if (F.tid < 256) { const int j = (F.tid & 127) >> 1, hf = F.tid & 1; const size_t m = (size_t)b * T + scan_t(d, c * RWC + j);
        o.x = *(const u32x4*)((F.tid < 128 ? P.Rv : YD) + m * 1024 + h * 64 + vq * 16 + hf * 8); }
    else if (F.tid < 272) o.x = *(const u32x4*)(P.GAM + item * 64 + (F.tid - 256) * 4);
}
__device__ __forceinline__ void rw2_put(const Ctx& F, const RwSet& o, LASQ unsigned char* buf) {
    const int e0 = F.tid * 8, r = e0 >> 6, cc = e0 & 63;
    *(LASQ u32x4*)(buf + R2_RA + (r * RLD + cc) * 2) = o.a; *(LASQ u32x4*)(buf + R2_NT + (r * RLD + cc) * 2) = o.n; *(LASQ u32x4*)(buf + R2_WK + (r * RLD + cc) * 2) = o.w;
    if (F.tid < 256) { const int j = (F.tid & 127) >> 1, hf = F.tid & 1; *(LASQ u32x4*)(buf + (F.tid < 128 ? R2_V : R2_Y) + (j * VL2 + hf * 8) * 2) = o.x; }
    else if (F.tid < 272) *(LASQ u32x4*)(buf + R2_G + (F.tid - 256) * 16) = o.x;
}
__device__ __forceinline__ void rw2_state(const Ctx& F, const LASQ unsigned char* buf, f32x4 (&S)[4], int c) {
    const int row = F.lane & 15, quad = F.lane >> 4;
    const LASQ bf16* Sc = (const LASQ bf16*)(F.lds + R2_SL + (c & 1) * 2304); LASQ bf16* Sn = (LASQ bf16*)(F.lds + R2_SL + ((c + 1) & 1) * 2304);
    const LASQ bf16* NTl = (const LASQ bf16*)(buf + R2_NT); const LASQ bf16* WKl = (const LASQ bf16*)(buf + R2_WK); const LASQ bf16* Vl = (const LASQ bf16*)(buf + R2_V); const LASQ float* Gl = (const LASQ float*)(buf + R2_G);
    bf16x8v sf[2]; sf[0] = lfrag8(Sc + row * RLD + quad * 8); sf[1] = lfrag8(Sc + row * RLD + 32 + quad * 8);
    bf16x8v vf[2]; vf[0] = lgather8(Vl + (quad * 8) * VL2 + row, VL2); vf[1] = lgather8(Vl + (32 + quad * 8) * VL2 + row, VL2);
#pragma unroll
    for (int t = 0; t < 4; ++t) { f32x4 acc = S[t] * Gl[t * 16 + row];
        acc = __builtin_amdgcn_mfma_f32_16x16x32_bf16(sf[0], lfrag8(NTl + (t * 16 + row) * RLD + quad * 8), acc, 0, 0, 0); acc = __builtin_amdgcn_mfma_f32_16x16x32_bf16(sf[1], lfrag8(NTl + (t * 16 + row) * RLD + 32 + quad * 8), acc, 0, 0, 0);
        acc = __builtin_amdgcn_mfma_f32_16x16x32_bf16(vf[0], lfrag8(WKl + (t * 16 + row) * RLD + quad * 8), acc, 0, 0, 0); acc = __builtin_amdgcn_mfma_f32_16x16x32_bf16(vf[1], lfrag8(WKl + (t * 16 + row) * RLD + 32 + quad * 8), acc, 0, 0, 0);
        S[t] = acc; }
#pragma unroll
    for (int t = 0; t < 4; ++t) { u32x2 w; w.x = pk2(S[t][0], S[t][1]); w.y = pk2(S[t][2], S[t][3]);
        Sn[(quad * 4 + 0) * RLD + t * 16 + row] = (bf16)(w.x & 0xffffu); Sn[(quad * 4 + 1) * RLD + t * 16 + row] = (bf16)(w.x >> 16);
        Sn[(quad * 4 + 2) * RLD + t * 16 + row] = (bf16)(w.y & 0xffffu); Sn[(quad * 4 + 3) * RLD + t * 16 + row] = (bf16)(w.y >> 16); }
}
__device__ __forceinline__ void rw2_y(const Ctx& F, const RwP2& P, const LASQ unsigned char* buf, int c, int b, int d, int h, int vq) {
    const int row = F.lane & 15, quad = F.lane >> 4;
    const LASQ bf16* Sc = (const LASQ bf16*)(F.lds + R2_SL + (c & 1) * 2304); bf16* YD = d ? P.YD1 : P.YD0;
    const LASQ bf16* RAl = (const LASQ bf16*)(buf + R2_RA); const LASQ bf16* Yl = (const LASQ bf16*)(buf + R2_Y);
    bf16x8v sf[2]; sf[0] = lfrag8(Sc + row * RLD + quad * 8); sf[1] = lfrag8(Sc + row * RLD + 32 + quad * 8);
#pragma unroll
    for (int t = 0; t < 4; ++t) { f32x4 y = {0.f, 0.f, 0.f, 0.f};
        y = __builtin_amdgcn_mfma_f32_16x16x32_bf16(lfrag8(RAl + (t * 16 + row) * RLD + quad * 8), sf[0], y, 0, 0, 0); y = __builtin_amdgcn_mfma_f32_16x16x32_bf16(lfrag8(RAl + (t * 16 + row) * RLD + 32 + quad * 8), sf[1], y, 0, 0, 0);
#pragma unroll
        for (int jj = 0; jj < 4; ++jj) { const int i = t * 16 + quad * 4 + jj; const size_t m = (size_t)b * T + scan_t(d, c * RWC + i); YD[m * 1024 + h * 64 + vq * 16 + row] = (bf16)f2bf(y[jj] + bf2f(Yl[i * VL2 + row])); } }
}
__device__ __forceinline__ void rwkv_chunk_scan(const Ctx& F, const RwP2& P) {
    for (int it = F.bid; it < 256; it += F.G) {
        const int seq = it >> 2, vq = it & 3, b = seq >> 5, d = (seq >> 4) & 1, h = seq & 15;
        f32x4 S[4];
#pragma unroll
        for (int t = 0; t < 4; ++t) S[t] = (f32x4){0.f, 0.f, 0.f, 0.f};
        RwSet s0, s1, s2;
        rw2_fetch(F, P, s0, seq, 0, b, d, h, vq); rw2_fetch(F, P, s1, seq, 1, b, d, h, vq); rw2_fetch(F, P, s2, seq, 2, b, d, h, vq);
        LDS_BARRIER();
        rw2_put(F, s0, (LASQ unsigned char*)F.lds);
        for (int i = F.tid; i < 16 * RLD; i += 512) ((LASQ bf16*)(F.lds + R2_SL))[i] = 0;
        LDS_BARRIER();
        for (int c3 = 0; c3 < RWN; c3 += 6) {
#define RW2_BODY(cc, SN, SC) do { rw2_put(F, SN, (LASQ unsigned char*)F.lds + (((cc) + 1) & 1) * R2_BUF); rw2_fetch(F, P, SC, seq, (cc) + 3, b, d, h, vq); \
            if (F.wave == 0) rw2_state(F, (const LASQ unsigned char*)F.lds + ((cc) & 1) * R2_BUF, S, (cc)); else if (F.wave == 1) rw2_y(F, P, (const LASQ unsigned char*)F.lds + ((cc) & 1) * R2_BUF, (cc), b, d, h, vq); LDS_BARRIER(); } while (0)
            RW2_BODY(c3 + 0, s1, s0); RW2_BODY(c3 + 1, s2, s1); RW2_BODY(c3 + 2, s0, s2);
            RW2_BODY(c3 + 3, s1, s0); RW2_BODY(c3 + 4, s2, s1); RW2_BODY(c3 + 5, s0, s2);
#undef RW2_BODY
        }
    }
}
__device__ __forceinline__ void rwkv_post(const Ctx& F, const RwP2& P, const bf16* Gg, const float* rk, const float* lnw, const float* lnb, bf16* O) {
    for (int m = F.gw; m < M; m += F.NGW) {
#pragma unroll 1
        for (int hp = 0; hp < 2; ++hp) {
            const int c0 = hp * 512 + 8 * F.lane; const size_t i1 = (size_t)m * 1024 + c0;
            const u32x4 wy0 = *(const u32x4*)(P.YD0 + i1), wy1 = *(const u32x4*)(P.YD1 + i1), wr = *(const u32x4*)(P.Rr + i1), wk = *(const u32x4*)(P.Rk + i1), wv = *(const u32x4*)(P.Rv + i1);
            const u32x4 wa0 = *(const u32x4*)(P.WA0 + (size_t)m * 2048 + 1024 + c0), wa1 = *(const u32x4*)(P.WA1 + (size_t)m * 2048 + 1024 + c0), wg = *(const u32x4*)(Gg + i1);
            float cl[8], cb[8], ca0[8], ca1[8], cka[8], crk[8];
#pragma unroll
            for (int q = 0; q < 2; ++q) { const f32x4 t0 = *(const f32x4*)(lnw + c0 + 4 * q), t1 = *(const f32x4*)(lnb + c0 + 4 * q), t2 = *(const f32x4*)(P.a0 + c0 + 4 * q), t3 = *(const f32x4*)(P.a0 + 1024 + c0 + 4 * q),
                    t4 = *(const f32x4*)(P.kaw + c0 + 4 * q), t5 = *(const f32x4*)(rk + c0 + 4 * q);
#pragma unroll
                for (int e = 0; e < 4; ++e) { cl[4 * q + e] = t0[e]; cb[4 * q + e] = t1[e]; ca0[4 * q + e] = t2[e]; ca1[4 * q + e] = t3[e]; cka[4 * q + e] = t4[e]; crk[4 * q + e] = t5[e]; } }
            float y0[8], y1[8], r[8], k[8], v[8], a0v[8], a1v[8], g[8];
            unpack8(wy0, y0); unpack8(wy1, y1); unpack8(wr, r); unpack8(wk, k); unpack8(wv, v); unpack8(wa0, a0v); unpack8(wa1, a1v); unpack8(wg, g);
            float y[8], s1 = 0.f, dot = 0.f;
#pragma unroll
            for (int e = 0; e < 8; ++e) { y[e] = y0[e] + y1[e]; s1 += y[e];
                const float ag0 = sigm(ca0[e] + a0v[e]), ag1 = sigm(ca1[e] + a1v[e]);
                dot += r[e] * k[e] * (2.f + (ag0 + ag1 - 2.f) * cka[e]) * crk[e]; }
            s1 += __shfl_xor(s1, 1); s1 += __shfl_xor(s1, 2); s1 += __shfl_xor(s1, 4);
            dot += __shfl_xor(dot, 1); dot += __shfl_xor(dot, 2); dot += __shfl_xor(dot, 4);
            const float mean = s1 * (1.f / 64.f); float s2 = 0.f;
#pragma unroll
            for (int e = 0; e < 8; ++e) { y[e] -= mean; s2 += y[e] * y[e]; }
            s2 += __shfl_xor(s2, 1); s2 += __shfl_xor(s2, 2); s2 += __shfl_xor(s2, 4);
            const float rs = rsqrtf(s2 * (1.f / 64.f) + 64e-5f);
            float o[8];
#pragma unroll
            for (int e = 0; e < 8; ++e) o[e] = (y[e] * rs * cl[e] + cb[e] + dot * v[e]) * g[e];
            *(u32x4*)(O + (size_t)m * 2048 + c0) = pack8(o);
        }
    }
}

struct LruP { const bf16 *XBR, *GATE, *XS, *Z; const float *convw, *convb, *ba, *bx, *lam; float* CAR; bf16* Y; };
__device__ __forceinline__ int lru_row(int b, int s) { if (s < CTX) return b * T + s; const int p = s - CTX; return b * T + CTX + (p & 127) * 64 + (p >> 7); }
__device__ __forceinline__ void lru_conv(const Ctx& F, const LruP& P, bf16* XS) {
    for (int m = F.gw; m < M; m += F.NGW) {
        const int b = m / T, s = m % T; const int lo = (s < CTX) ? 0 : CTX, hi = (s < CTX) ? CTX : T;
#pragma unroll
        for (int q = 0; q < 4; ++q) {
            const int c0 = 8 * (F.lane + 64 * q);
            float y[8];
            { const f32x4 b0 = *(const f32x4*)(P.convb + c0), b1 = *(const f32x4*)(P.convb + c0 + 4); y[0] = b0[0]; y[1] = b0[1]; y[2] = b0[2]; y[3] = b0[3]; y[4] = b1[0]; y[5] = b1[1]; y[6] = b1[2]; y[7] = b1[3]; }
#pragma unroll
            for (int j = 0; j < 4; ++j) { const int sj = s + j - 2;
                if (sj >= lo && sj < hi) { const u32x4 x = *(const u32x4*)(P.XBR + (size_t)lru_row(b, sj) * 2048 + c0);
                    const f32x4 w0 = *(const f32x4*)(P.convw + j * 2048 + c0), w1 = *(const f32x4*)(P.convw + j * 2048 + c0 + 4);
                    y[0] += lo16(x[0]) * w0[0]; y[1] += hi16(x[0]) * w0[1]; y[2] += lo16(x[1]) * w0[2]; y[3] += hi16(x[1]) * w0[3];
                    y[4] += lo16(x[2]) * w1[0]; y[5] += hi16(x[2]) * w1[1]; y[6] += lo16(x[3]) * w1[2]; y[7] += hi16(x[3]) * w1[3]; } }
            u32x4 o; o.x = pk2(y[0], y[1]); o.y = pk2(y[2], y[3]); o.z = pk2(y[4], y[5]); o.w = pk2(y[6], y[7]);
            *(u32x4*)(XS + (size_t)m * 2048 + c0) = o;
        }
    }
}
struct LruRaw { unsigned lw, iw, xw; };
__device__ __forceinline__ LruRaw lru_ld(const bf16* zb, const bf16* xb, int i, int d) {
    LruRaw r; r.lw = *(const unsigned*)(zb + i * 128 + d * 8192); r.iw = *(const unsigned*)(zb + i * 128 + (2 + d) * 8192); r.xw = *(const unsigned*)(xb + i * 2048);
    return r;
}
__device__ __forceinline__ const bf16* lru_zbase(const LruP& P, int b, int cf, int c) { const int n = c >> 8, j = c & 255; return P.Z + (((size_t)(b * LNCH + cf) * 64 + n * 8 + (j >> 7)) * 32) * 128 + (j & 127); }
__device__ __forceinline__ void lru_cmp(const LruRaw& r, float (&a)[2], float (&u)[2]) {
    const float la[2] = {lo16(r.lw), hi16(r.lw)}, ig[2] = {lo16(r.iw), hi16(r.iw)}, xs[2] = {lo16(r.xw), hi16(r.xw)};
#pragma unroll
    for (int e = 0; e < 2; ++e) { a[e] = __expf(la[e]); const float x2 = 2.f * la[e];
        const float om = -x2 * (1.f + x2 * (0.5f + x2 * (0.16666667f + x2 * (0.041666668f + x2 * (0.0083333338f + x2 * 0.0013888889f)))));
        const float om2 = (x2 < -0.5f) ? (1.f - a[e] * a[e]) : om;
        u[e] = __builtin_amdgcn_sqrtf(fmaxf(om2, 0.f)) * ig[e] * xs[e]; }
}
__device__ __forceinline__ void lru_passA(const Ctx& F, const LruP& P) {
    for (int it = F.bid; it < NB * LNCH * 2; it += F.G) {
        const int hq = it & 1, bc = it >> 1, b = bc / LNCH, cf = bc % LNCH, c = hq * 1024 + 2 * F.tid;
        const bf16* zb = lru_zbase(P, b, cf, c); const bf16* xb = P.XS + ((size_t)b * T + cf * LCH) * 2048 + c;
#pragma unroll
        for (int d = 0; d < 2; ++d) {
            float A[2] = {1.f, 1.f}, U[2] = {0.f, 0.f};
#pragma unroll 1
            for (int i0 = 0; i0 < LCH; i0 += 16) {
                LruRaw rw[16];
#pragma unroll
                for (int i = 0; i < 16; ++i) rw[i] = lru_ld(zb, xb, d ? (LCH - 1 - i0 - i) : (i0 + i), d);
#pragma unroll
                for (int i = 0; i < 16; ++i) { float a[2], u[2]; lru_cmp(rw[i], a, u); U[0] = a[0] * U[0] + u[0]; A[0] *= a[0]; U[1] = a[1] * U[1] + u[1]; A[1] *= a[1]; }
            }
            *(f32x4*)(P.CAR + ((size_t)((b * 2 + d) * LNCH + cf) * 2048 + c) * 2) = (f32x4){A[0], U[0], A[1], U[1]};
        }
    }
}
__device__ __forceinline__ void lru_passB(const Ctx& F, const LruP& P) {
    const int nth = F.G * 512;
    for (int i = F.bid * 512 + F.tid; i < NB * 2 * 2048; i += nth) {
        const int c = i & 2047, d = (i >> 11) & 1, b = i >> 12;
        float h = 0.f;
        for (int k0 = 0; k0 < LNCH; k0 += 24) {
            float A[24], U[24]; float* cp[24];
#pragma unroll
            for (int j = 0; j < 24; ++j) { const int k = k0 + j, cf = d ? (k < 8 ? 7 - k : LNCH + 7 - k) : k;
                cp[j] = P.CAR + ((size_t)((b * 2 + d) * LNCH + cf) * 2048 + c) * 2; const float2 t = *(const float2*)cp[j]; A[j] = t.x; U[j] = t.y; }
#pragma unroll
            for (int j = 0; j < 24; ++j) { cp[j][1] = h; h = A[j] * h + U[j]; }
        }
    }
}
__device__ __forceinline__ void lru_passC(const Ctx& F, const LruP& P) {
    for (int it = F.bid; it < NB * LNCH * 2; it += F.G) {
        const int hq = it & 1, bc = it >> 1, b = bc / LNCH, cf = bc % LNCH, c = hq * 1024 + 2 * F.tid;
        const bf16* zb = lru_zbase(P, b, cf, c); const bf16* xb = P.XS + ((size_t)b * T + cf * LCH) * 2048 + c;
        LASQ f32x2v* hfl = (LASQ f32x2v*)F.lds + F.tid;
        { const f32x4 cr = *(const f32x4*)(P.CAR + ((size_t)((b * 2 + 0) * LNCH + cf) * 2048 + c) * 2);
          float h0 = cr[1], h1 = cr[3];
#pragma unroll
          for (int i0 = 0; i0 < LCH; i0 += 8) {
              LruRaw rw[8];
#pragma unroll
              for (int i = 0; i < 8; ++i) rw[i] = lru_ld(zb, xb, i0 + i, 0);
#pragma unroll
              for (int i = 0; i < 8; ++i) { float a[2], u[2]; lru_cmp(rw[i], a, u); h0 = a[0] * h0 + u[0]; h1 = a[1] * h1 + u[1]; hfl[(i0 + i) * 512] = (f32x2v){h0, h1}; }
              asm volatile("" ::: "memory"); } }
        { const f32x4 cr = *(const f32x4*)(P.CAR + ((size_t)((b * 2 + 1) * LNCH + cf) * 2048 + c) * 2);
          float h0 = cr[1], h1 = cr[3];
          const int s0 = cf * LCH;
#pragma unroll
          for (int i0 = 0; i0 < LCH; i0 += 8) {
              LruRaw rw[8]; unsigned gw[8];
#pragma unroll
              for (int i = 0; i < 8; ++i) { const int li = LCH - 1 - i0 - i; rw[i] = lru_ld(zb, xb, li, 1); gw[i] = *(const unsigned*)(P.GATE + (size_t)lru_row(b, s0 + li) * 2048 + c); }
#pragma unroll
              for (int i = 0; i < 8; ++i) { const int li = LCH - 1 - i0 - i; float a[2], u[2]; lru_cmp(rw[i], a, u); h0 = a[0] * h0 + u[0]; h1 = a[1] * h1 + u[1];
                  const f32x2v hv = hfl[li * 512];
                  *(unsigned*)(P.Y + (size_t)lru_row(b, s0 + li) * 2048 + c) = pk2((hv.x + h0) * gelu_tanh(lo16(gw[i])), (hv.y + h1) * gelu_tanh(hi16(gw[i]))); }
              asm volatile("" ::: "memory"); } }
    }
}

__device__ __forceinline__ void fill_wlora(const Ctx& F, const float* g2, const float* w2, const float* a2, bf16* WL) {
    const int nth = F.G * 512;
    for (int i = F.bid * 512 + F.tid; i < 5120 * 256; i += nth) {
        const int k = i & 255, n = i >> 8; float v = 0.f;
        if (n < 1024) v = g2[(size_t)k * 1024 + n];
        else { const int q = n - 1024, d = q >> 11, r2 = q & 2047;
            if (r2 < 1024) { if (k < 96) v = w2[((size_t)d * 96 + k) * 1024 + r2]; }
            else { if (k >= 96 && k < 192) v = a2[((size_t)d * 96 + (k - 96)) * 1024 + (r2 - 1024)]; } }
        WL[i] = (bf16)f2bf(v);
    }
}
__device__ __forceinline__ void zero_rows(const Ctx& F, bf16* p, size_t n16) {
    const size_t nth = (size_t)F.G * 512; const u32x4 z = {0u, 0u, 0u, 0u};
    for (size_t i = (size_t)F.bid * 512 + F.tid; i < n16; i += nth) ((u32x4*)p)[i] = z;
}

__global__ void __launch_bounds__(512, 2) mega_fwd(Args args) {
    extern __shared__ __attribute__((aligned(16))) unsigned char lds[];
    cg::grid_group grid = cg::this_grid();
    Ctx F; F.lds = lds; F.tid = threadIdx.x; F.lane = F.tid & 63; F.wave = __builtin_amdgcn_readfirstlane(F.tid >> 6);
    F.G = gridDim.x; F.bid = blockIdx.x; F.gw = F.bid * 8 + F.wave; F.NGW = F.G * 8;
    unsigned char* ws = args.ws; unsigned char* ob = (unsigned char*)args.out;
    const float* x = args.in[0]; const float* cvec = args.in[1]; const float* ctx = args.in[2]; const float* c_ctx = args.in[3];
    const float* mod_w = args.in[4]; const float* mod_b = args.in[5]; const float* norm1 = args.in[6]; const float* norm2 = args.in[7];
    const float* mlp_w1 = args.in[8]; const float* mlp_w2 = args.in[9]; const float* ab_w_in = args.in[10]; const float* ab_w_out = args.in[11];
    float* modv = (float*)(ws + WS_MODV); float* X = (float*)(ws + WS_X); bf16* H = (bf16*)(ws + WS_HR);
    bf16* Wab = (bf16*)(ws + WS_WAB); bf16* Wout = (bf16*)(ws + WS_WOUT); bf16* Wlora = (bf16*)(ws + WS_WLORA);
    bf16* PA = (bf16*)(ws + MN_PA); bf16* PB = (bf16*)(ws + MN_PB); bf16* O = (bf16*)(ws + MN_O);
    bf16* Gg = (bf16*)(ob + OT_GG); bf16* WA0 = (bf16*)(ob + OT_WA0); bf16* WA1 = (bf16*)(ws + WS_HR); bf16* LA = (bf16*)(ob + OT_LA);
    RwP2 RP; RP.Rr = (bf16*)(ws + MN_R); RP.Rk = (bf16*)(ws + MN_K); RP.Rv = (bf16*)(ws + MN_V); RP.WA0 = WA0; RP.WA1 = WA1;
    RP.w0 = args.in[13]; RP.a0 = args.in[15]; RP.kkw = args.in[18]; RP.kaw = args.in[19]; RP.RA = (bf16*)(ws + MN_RA); RP.NT = (bf16*)(ws + MN_NT); RP.WKT = (bf16*)(ws + MN_WKT);
    RP.GAM = (float*)(ws + WS_GAM); RP.YD0 = (bf16*)(ws + MN_YD0); RP.YD1 = (bf16*)(ws + MN_YD1);
    GlaP GP; GP.PB = PB; GP.gw2 = args.in[23]; GP.gb = args.in[24]; GP.KV = (bf16*)(ws + MN_KV); GP.GDP = (float*)(ws + WS_GDP);
    LruP LP; LP.XBR = (bf16*)(ob + OT_XBR); LP.GATE = (bf16*)(ws + MN_GATE); LP.XS = (bf16*)(ws + WS_HR); LP.Z = (bf16*)(ws + MN_Z);
    LP.convw = args.in[28]; LP.convb = args.in[29]; LP.ba = args.in[31]; LP.bx = args.in[33]; LP.lam = args.in[34]; LP.CAR = (float*)(ob + OT_CAR); LP.Y = (bf16*)(ob + OT_Y);
    PG8_LAS unsigned char* glds = (PG8_LAS unsigned char*)lds;
    const int lo = args.ph_lo, hi = args.ph_hi;
    volatile unsigned* xst = (volatile unsigned*)(lds + 147456 - 64);
    if (F.tid == 0) { xst[0] = 0u; xst[1] = 0u; }
    __syncthreads();
    XcdBarrier xbar = xcd_barrier_post((unsigned*)ws, xst);
#define IN(k) (lo <= (k) && (k) < hi)
#define SEAM(k) do { if (IN(k) && IN((k) + 1)) { if ((k) == 0) grid.sync(); else xcd_barrier(xbar); } } while (0)
#define GEMM(EPI, Aptr, lda_, Btptr, ldb_, nM_, nN_, K_, skip_, amode_, ...) do { pg8::Gemm g{(const bf16*)(Aptr), (const bf16*)(Btptr), 0, 0, (K_), (lda_), (ldb_)}; pg8::Sched S; S.init((nM_), (nN_), F.G, F.bid, (skip_), (amode_)); \
        pg8::EPI E{__VA_ARGS__}; pg8::gemm_phase<pg8::EPI, pg8::Sched, true, true>(glds, g, S, E); } while (0)

    if (IN(0)) {
        mod_gemv(F, cvec, c_ctx, mod_w, mod_b, modv);
        xpose(F, ab_w_in, 6816, D, ACOLS, Wab, D);
        xpose(F, ab_w_in + ACOLS, 6816, D, BCOLS, Wab + (size_t)PA_LD * D, D);
        xpose(F, ab_w_out, D, D, D, Wout, D);
        zero_rows(F, Wab + (size_t)ACOLS * D, (size_t)(PA_LD - ACOLS) * D / 8);
        zero_rows(F, Wab + (size_t)(PA_LD + BCOLS) * D, (size_t)(NAB - PA_LD - BCOLS) * D / 8);
        fill_wlora(F, args.in[17], args.in[14], args.in[16], Wlora);
        for (int i = F.bid * 512 + F.tid; i < 2 * D; i += F.G * 512) { const float l = args.in[34][i]; ((float*)(ws + WS_SPL))[i] = -8.f * ((-l) > 20.f ? (-l) : log1pf(__expf(-l))); }
    }
    SEAM(0);
    if (IN(1)) norm_mod(F, X, x, ctx, norm1, modv, 0, 1, H, 0);
    SEAM(1);
    if (IN(2)) GEMM(EpiBf16S, H, D, Wab, D, 66, 28, D, 0, 0, PA, PB, PB, PA_LD, PB_LD, PB_LD, 15, 1000, 0);
    SEAM(2);
    if (IN(3)) { gla_kv(F, GP); rwkv_mix(F, PA, args.in[12], (bf16*)RP.Rr, (bf16*)RP.Rk, (bf16*)RP.Rv, LA); }
    SEAM(3);
    if (IN(4)) { gla_carry(F, GP); GEMM(EpiBf16S, LA, 768, Wlora, 256, 66, 20, 256, 0, 1, Gg, WA0, WA1, 1024, 2048, 2048, 4, 12, 0); }
    SEAM(4);
    if (IN(5)) gla_out(F, GP, args.in[25], O);
    SEAM(5);
    if (IN(7)) rwkv_chunk_prep(F, RP);
    SEAM(7);
    if (IN(8)) rwkv_chunk_scan(F, RP);
    SEAM(8);
    if (IN(10)) rwkv_post(F, RP, Gg, args.in[20], args.in[21], args.in[22], O);
    SEAM(10);
    Ctx FI = F; FI.gw = (F.bid - 16) * 8 + F.wave; FI.NGW = (F.G - 16) * 8;
    if (IN(11)) { GEMM(EpiResid, O, D, Wout, D, 66, 8, D, 0, 0, X, x, ctx, modv, 2);
        if (F.bid >= 16) { xpose(FI, mlp_w1, FF, D, FF, (bf16*)(ws + MN_W1_0), D); xpose(FI, mlp_w2, D, FF, D, (bf16*)(ws + MN_W2_0), FF); } }
    SEAM(11);
    if (IN(12)) norm_mod(F, X, nullptr, nullptr, norm2, modv, 3, 4, H, 0);
    SEAM(12);
    if (IN(13)) GEMM(EpiBf16S, H, D, ws + MN_W1_0, D, 66, 32, D, 0, 0, (bf16*)(ws + MN_U0), nullptr, nullptr, FF, 0, 0, 1000, 1000, 1);
    SEAM(13);
    if (IN(14)) { GEMM(EpiResid, ws + MN_U0, FF, ws + MN_W2_0, FF, 66, 8, FF, 0, 0, X, nullptr, nullptr, modv, 5);
        if (F.bid >= 16) { xpose(FI, args.in[26], 2 * D, D, 2 * D, (bf16*)(ws + MN_WLIN), D); xpose(FI, args.in[27], D, D, D, (bf16*)(ws + MN_WLOUT), D);
            for (int q = 0; q < 32; ++q) { const int gq = q >> 3, n = q & 7, d = gq & 1; const float* src = (gq < 2 ? args.in[30] : args.in[32]) + (size_t)(d * 8 + n) * 65536;
                xpose(FI, src, 256, 256, 256, (bf16*)(ws + MN_WG) + (size_t)(n * 1024 + gq * 256) * 256, 256); }
            xpose(FI, mlp_w1 + (size_t)D * FF, FF, D, FF, (bf16*)(ws + MN_W1_1), D); xpose(FI, mlp_w2 + (size_t)D * FF, D, FF, D, (bf16*)(ws + MN_W2_1), FF); } }
    SEAM(14);
    const float* modv1 = modv + 3 * 12288;
    if (IN(15)) norm_mod(F, X, nullptr, nullptr, norm1 + D, modv1, 0, 1, H, 0);
    SEAM(15);
    if (IN(16)) GEMM(EpiBf16S, H, D, ws + MN_WLIN, D, 66, 16, D, 0, 0, (bf16*)LP.GATE, (bf16*)LP.XBR, (bf16*)LP.XBR, D, D, D, 8, 1000, 0);
    SEAM(16);
    if (IN(17)) lru_conv(F, LP, (bf16*)LP.XS);
    SEAM(17);
    if (IN(18)) GEMM(EpiLruGate, LP.XS, D, ws + MN_WG, 256, 66, 32, 256, 0, 2, (bf16*)LP.Z, LP.ba, LP.bx, (const float*)(ws + WS_SPL));
    SEAM(18);
    if (IN(19)) lru_passA(F, LP);
    SEAM(19);
    if (IN(20)) lru_passB(F, LP);
    SEAM(20);
    if (IN(21)) lru_passC(F, LP);
    SEAM(21);
    if (IN(22)) GEMM(EpiResid, LP.Y, D, ws + MN_WLOUT, D, 64, 8, D, 1, 0, X, nullptr, nullptr, modv1, 2);
    SEAM(22);
    if (IN(23)) norm_mod(F, X, nullptr, nullptr, norm2 + D, modv1, 3, 4, H, 1);
    SEAM(23);
    if (IN(24)) GEMM(EpiBf16S, H, D, ws + MN_W1_1, D, 64, 32, D, 1, 0, (bf16*)(ws + MN_U1), nullptr, nullptr, FF, 0, 0, 1000, 1000, 1);
    SEAM(24);
    if (IN(25)) GEMM(EpiResid, ws + MN_U1, FF, ws + MN_W2_1, FF, 64, 8, FF, 1, 0, X, nullptr, nullptr, modv1, 5);
    SEAM(25);
    if (IN(26)) final_norm(F, X, args.in[35], args.out);
}

#ifndef N_LAUNCH_PER_PHASE
#define N_LAUNCH_PER_PHASE 0
#endif
extern "C" void kernel_launch(void* const* d_in, const int* in_sizes, int n_in, void* d_out, int out_size, void* d_ws, size_t ws_size, hipStream_t stream) {
    static int grid = 0;
    if (grid == 0) {
        if (n_in != 36 || ws_size < WS_END) { fprintf(stderr, "kernel_launch: unexpected n_in %d / ws_size %zu\n", n_in, ws_size); grid = -1; return; }
        int dev = 0, cus = 0, per_cu = 0;
        hipGetDevice(&dev); hipDeviceGetAttribute(&cus, hipDeviceAttributeMultiprocessorCount, dev);
        hipFuncSetAttribute((const void*)mega_fwd, hipFuncAttributeMaxDynamicSharedMemorySize, LDS_BYTES);
        hipOccupancyMaxActiveBlocksPerMultiprocessor(&per_cu, (const void*)mega_fwd, 512, LDS_BYTES);
        if (per_cu < 1) per_cu = 1;
        (void)hipGetLastError();
        grid = cus * per_cu;
    }
    if (grid < 0) return;
    if (hipMemsetAsync(d_ws, 0, 16384, stream) != hipSuccess) { fprintf(stderr, "memset failed\n"); return; }
    Args a{};
    for (int i = 0; i < 36; ++i) a.in[i] = (const float*)d_in[i];
    a.out = (float*)d_out; a.ws = (unsigned char*)d_ws;
#if N_LAUNCH_PER_PHASE
    for (int p = 0; p < NPH; ++p) { a.ph_lo = p; a.ph_hi = p + 1; hipLaunchKernelGGL(mega_fwd, dim3(grid), dim3(512), LDS_BYTES, stream, a); }
#else
    a.ph_lo = 0; a.ph_hi = NPH;
    void* kargs[] = {&a};
    hipError_t e = hipLaunchCooperativeKernel((const void*)mega_fwd, dim3(grid), dim3(512), kargs, LDS_BYTES, stream);
    if (e != hipSuccess) fprintf(stderr, "cooperative launch failed: %s (grid %d)\n", hipGetErrorString(e), grid);
#endif
}
```

```cpp
#include <hip/hip_runtime.h>
#include <hip/hip_cooperative_groups.h>
#include <cstdio>
namespace cg = cooperative_groups;

namespace pg8 {
#define PG8_LAS __attribute__((address_space(3)))
typedef unsigned short bf16_t;
typedef short bf16x8 __attribute__((ext_vector_type(8)));
typedef float f32x4 __attribute__((ext_vector_type(4)));
typedef unsigned u32x4 __attribute__((ext_vector_type(4)));
constexpr int BM = 256, BK = 64, HALF = 128, HTB = HALF * BK * 2, STAGE_BYTES = 8 * HTB, NXCD = 8, WGM = 8;
__host__ __device__ __forceinline__ int lds_byte(int r, int c) { const int st = (r >> 4) * 2 + (c >> 5), rr = r & 15, cc = c & 31, ob = rr * 64 + cc * 2; return st * 1024 + (ob ^ (((ob >> 9) & 1) << 5)); }
__host__ __device__ __forceinline__ void stage_rc(int b, int& R, int& C) { const int st = b / 1024, sb = b % 1024, swz = sb ^ (((sb >> 9) & 1) << 5); R = (st >> 1) * 16 + swz / 64; C = (st & 1) * 32 + (swz % 64) / 2; }
__host__ __device__ __forceinline__ int perm32(int rho) { const int n = rho >> 4, i = rho & 15; return 8 * (i >> 2) + 4 * n + (i & 3); }
struct Unit { int pm, pn; };
struct Gemm { const bf16_t* A; const bf16_t* Bt; int M, N, K, lda, ldb; };
struct Sched {
    int nM, nN, nwg, G, c, skip, amode;
    __device__ void init(int nM_, int nN_, int G_, int c_, int skip_, int amode_) { nM = nM_; nN = nN_; nwg = nM * nN; G = G_; c = c_; skip = skip_; amode = amode_; }
    __device__ bool next(int i, Unit& u) const {
        const long L = (long)i * G + c; if (L >= nwg) return false;
        int wgid = (int)L; { const int q = nwg / NXCD, r = nwg % NXCD, xcd = wgid % NXCD, off = wgid / NXCD; wgid = (xcd < r ? xcd * (q + 1) : r * (q + 1) + (xcd - r) * q) + off; }
        const int nig = WGM * nN, gid = wgid / nig, fm = gid * WGM, gsz = (nM - fm) < WGM ? (nM - fm) : WGM;
        int pm = fm + ((wgid % nig) % gsz); u.pn = (wgid % nig) / gsz;
        if (skip) pm = pm + pm / 32 + 1;
        u.pm = pm; return true;
    }
    __device__ __forceinline__ size_t a_off(const Unit& u) const {
        if (amode == 1) return (size_t)(u.pn < 4 ? 0 : (u.pn < 12 ? 256 : 512)) * 2;
        if (amode == 2) return (size_t)((u.pn >> 2) * 256) * 2;
        return 0;
    }
    __device__ __forceinline__ void a_ready(const Unit&) const {}
    __device__ __forceinline__ void done(const Unit&) const {}
};
__device__ __forceinline__ unsigned cvt_pk_bf16(float lo, float hi) { unsigned r; asm volatile("v_cvt_pk_bf16_f32 %0, %1, %2" : "=v"(r) : "v"(lo), "v"(hi)); return r; }

struct EpiBf16S {
    static constexpr bool PERM = true, AFTER_DRAIN = false;
    bf16_t* O0; bf16_t* O1; bf16_t* O2; int ld0, ld1, ld2, t1, t2, act;
    __device__ __forceinline__ void operator()(const f32x4 (&acc)[2][2][4][2], const Unit& u, int wr, int wc, int fr, int fq) const {
        const int row0 = u.pm * BM + wr * 64 + fr;
        bf16_t* base; int ldc, colt;
        if (u.pn < t1) { base = O0; ldc = ld0; colt = u.pn * BM; } else if (u.pn < t2) { base = O1; ldc = ld1; colt = (u.pn - t1) * BM; } else { base = O2; ldc = ld2; colt = (u.pn - t2) * BM; }
        const int col0 = colt + wc * 32 + 8 * fq;
#pragma unroll
        for (int ai = 0; ai < 2; ++ai)
#pragma unroll
            for (int m = 0; m < 4; ++m) { bf16_t* rowp = base + (size_t)(row0 + ai * HALF + m * 16) * ldc + col0;
#pragma unroll
                for (int bj = 0; bj < 2; ++bj) { f32x4 v0 = acc[ai][bj][m][0], v1 = acc[ai][bj][m][1];
                    if (act == 1) {
#pragma unroll
                        for (int e = 0; e < 4; ++e) { float a = v0[e] > 0.f ? v0[e] : 0.f; v0[e] = a * a; float b = v1[e] > 0.f ? v1[e] : 0.f; v1[e] = b * b; } }
                    u32x4 w; w.x = cvt_pk_bf16(v0[0], v0[1]); w.y = cvt_pk_bf16(v0[2], v0[3]); w.z = cvt_pk_bf16(v1[0], v1[1]); w.w = cvt_pk_bf16(v1[2], v1[3]);
                    *(u32x4*)(rowp + bj * HALF) = w; } }
    }
};
struct EpiResid {
    static constexpr bool PERM = false, AFTER_DRAIN = false;
    float* X; const float* xin; const float* cin; const float* modv; int gidx;
    __device__ __forceinline__ void operator()(const f32x4 (&acc)[2][2][4][2], const Unit& u, int wr, int wc, int fr, int fq) const {
        const int b = u.pm / 33, tt = u.pm % 33, mi = (tt == 0) ? 2 : b;
        const int rl0 = wr * 64 + fr, col0 = u.pn * BM + wc * 32 + 4 * fq;
        const float* gp = modv + (size_t)(mi * 6 + gidx) * 2048 + col0;
        f32x4 gv[2][2];
#pragma unroll
        for (int bj = 0; bj < 2; ++bj)
#pragma unroll
            for (int n = 0; n < 2; ++n) gv[bj][n] = *(const f32x4*)(gp + bj * HALF + n * 16);
#pragma unroll
        for (int ai = 0; ai < 2; ++ai)
#pragma unroll
            for (int m = 0; m < 4; ++m) { const int rl = rl0 + ai * HALF + m * 16;
                float* xp = X + (size_t)(u.pm * BM + rl) * 2048 + col0;
                const float* bp = xp;
                if (xin) bp = (tt == 0) ? (cin + (size_t)(b * 256 + rl) * 2048 + col0) : (xin + (size_t)(b * 8192 + (tt - 1) * 256 + rl) * 2048 + col0);
#pragma unroll
                for (int bj = 0; bj < 2; ++bj)
#pragma unroll
                    for (int n = 0; n < 2; ++n) { const f32x4 bv = *(const f32x4*)(bp + bj * HALF + n * 16); *(f32x4*)(xp + bj * HALF + n * 16) = bv + gv[bj][n] * acc[ai][bj][m][n]; } }
    }
};
struct EpiLruGate {
    static constexpr bool PERM = true, AFTER_DRAIN = false;
    bf16_t* Z; const float* ba; const float* bx; const float* lam;
    __device__ __forceinline__ void operator()(const f32x4 (&acc)[2][2][4][2], const Unit& u, int wr, int wc, int fr, int fq) const {
        const int n = u.pn >> 2, gq = u.pn & 3, d = gq & 1; const bool isx = gq >= 2;
        const int row0 = u.pm * BM + wr * 64 + fr, ct0 = wc * 32 + 8 * fq;
        float bias[2][8], spl[2][8];
#pragma unroll
        for (int bj = 0; bj < 2; ++bj)
#pragma unroll
            for (int e = 0; e < 8; ++e) { const int c = d * 2048 + n * 256 + ct0 + bj * HALF + e; bias[bj][e] = isx ? bx[c] : ba[c];
                spl[bj][e] = isx ? 0.f : lam[c]; }
#pragma unroll
        for (int ai = 0; ai < 2; ++ai)
#pragma unroll
            for (int m = 0; m < 4; ++m) { const int rr = row0 + ai * HALF + m * 16;
                bf16_t* rowp = Z + ((size_t)((rr >> 5) * 64 + u.pn * 2) * 32 + (rr & 31)) * 128 + ct0;
#pragma unroll
                for (int bj = 0; bj < 2; ++bj) { float v[8];
#pragma unroll
                    for (int e = 0; e < 4; ++e) { v[e] = acc[ai][bj][m][0][e]; v[4 + e] = acc[ai][bj][m][1][e]; }
#pragma unroll
                    for (int e = 0; e < 8; ++e) { const float r = __builtin_amdgcn_rcpf(1.f + __expf(-(v[e] + bias[bj][e]))); v[e] = isx ? r : r * spl[bj][e]; }
                    u32x4 w; w.x = cvt_pk_bf16(v[0], v[1]); w.y = cvt_pk_bf16(v[2], v[3]); w.z = cvt_pk_bf16(v[4], v[5]); w.w = cvt_pk_bf16(v[6], v[7]);
                    *(u32x4*)(rowp + bj * 32 * 128) = w; } }
    }
};
template <class Epi, class Sched, bool ALIGN_EPI = false, bool SP2 = false>
__device__ __forceinline__ void gemm_phase(PG8_LAS unsigned char* lds, const Gemm g, const Sched& S, const Epi& E) {
    const int tid = threadIdx.x, wid = __builtin_amdgcn_readfirstlane(tid >> 6), lane = tid & 63, wr = wid >> 2, wc = wid & 3, fr = lane & 15, fq = lane >> 4;
    const int K = g.K, nt = K / BK;
    unsigned voffA[2], voffB[2];
#pragma unroll
    for (int i = 0; i < 2; ++i) { int R, C; stage_rc(tid * 16 + i * 8192, R, C); const int Rb = Epi::PERM ? ((R & ~31) + perm32(R & 31)) : R;
        voffA[i] = (unsigned)(R * g.lda + C) * 2u; voffB[i] = (unsigned)(Rb * g.ldb + C) * 2u; }
    const size_t kstep = (size_t)(BK * 2);
    const size_t hstepA = (size_t)HALF * g.lda * 2, hstepB = (size_t)HALF * g.ldb * 2;
    const size_t tstepA = 2 * hstepA, tstepB = 2 * hstepB;
    const unsigned ldsw = (unsigned)wid * 1024u;
    const int aoff = lds_byte(wr * 64 + fr, fq * 8), boff = lds_byte(wc * 32 + fr, fq * 8);
#define PG8_SA(b, h) (((b) * 2 + (h)) * HTB)
#define PG8_SB(b, h) ((4 + (b) * 2 + (h)) * HTB)
#define PG8_STAGE(bufoff, gbase, voff) do { _Pragma("unroll") for (int _i = 0; _i < 2; ++_i) \
        __builtin_amdgcn_global_load_lds((const unsigned*)((const char*)(gbase) + (voff)[_i]), (PG8_LAS unsigned*)(lds + (bufoff) + ldsw + _i * 8192), 16, 0, 0); } while (0)
#define PG8_LDA(dst, b, h) do { _Pragma("unroll") for (int m = 0; m < 4; ++m) _Pragma("unroll") for (int k = 0; k < 2; ++k) dst[m][k] = *(const PG8_LAS bf16x8*)(lds + PG8_SA(b, h) + aoff + m * 2048 + k * 1024); } while (0)
#define PG8_LDB(dst, b, h) do { _Pragma("unroll") for (int n = 0; n < 2; ++n) _Pragma("unroll") for (int k = 0; k < 2; ++k) dst[n][k] = *(const PG8_LAS bf16x8*)(lds + PG8_SB(b, h) + boff + n * 2048 + k * 1024); } while (0)
#define PG8_MMA(ai, bj, At, Bt) do { __builtin_amdgcn_s_setprio(1); _Pragma("unroll") for (int m = 0; m < 4; ++m) _Pragma("unroll") for (int n = 0; n < 2; ++n) _Pragma("unroll") for (int k = 0; k < 2; ++k) \
        acc[ai][bj][m][n] = __builtin_amdgcn_mfma_f32_16x16x32_bf16(Bt[n][k], At[m][k], acc[ai][bj][m][n], 0, 0, 0); __builtin_amdgcn_s_setprio(0); } while (0)
#define PG8_WAIT_V(n) asm volatile("s_waitcnt vmcnt(" #n ")" ::: "memory")
#define PG8_WAIT_L(n) asm volatile("s_waitcnt lgkmcnt(" #n ")" ::: "memory")
#define PG8_BAR __builtin_amdgcn_s_barrier()
#define PG8_SCHED __builtin_amdgcn_sched_barrier(0)
    Unit cur, nxt; int ui = 0;
    if (!S.next(0, cur)) return;
    f32x4 acc[2][2][4][2];
#pragma unroll
    for (int a = 0; a < 2; ++a)
#pragma unroll
        for (int b = 0; b < 2; ++b)
#pragma unroll
            for (int m = 0; m < 4; ++m)
#pragma unroll
                for (int n = 0; n < 2; ++n) acc[a][b][m][n] = (f32x4){0.f, 0.f, 0.f, 0.f};
    bf16x8 At[4][2], B0[2][2], B1[2][2];
    const char* cA = (const char*)g.A + (size_t)cur.pm * tstepA + S.a_off(cur); const char* cB = (const char*)g.Bt + (size_t)cur.pn * tstepB;
    S.a_ready(cur);
    if constexpr (SP2) {
        PG8_STAGE(PG8_SB(0, 0), cB, voffB); PG8_STAGE(PG8_SB(0, 1), cB + hstepB, voffB); PG8_STAGE(PG8_SA(0, 0), cA, voffA); PG8_STAGE(PG8_SA(0, 1), cA + hstepA, voffA);
        if (wr == 1) PG8_BAR;
        PG8_WAIT_V(2); PG8_BAR;
        PG8_STAGE(PG8_SB(1, 0), cB + kstep, voffB); PG8_STAGE(PG8_SA(1, 0), cA + kstep, voffA); PG8_STAGE(PG8_SB(1, 1), cB + hstepB + kstep, voffB);
        PG8_WAIT_V(6); PG8_BAR;
    } else {
        PG8_STAGE(PG8_SB(0, 0), cB, voffB); PG8_STAGE(PG8_SA(0, 0), cA, voffA); PG8_STAGE(PG8_SB(0, 1), cB + hstepB, voffB); PG8_STAGE(PG8_SA(0, 1), cA + hstepA, voffA);
        if (wr == 1) PG8_BAR;
        PG8_WAIT_V(4); PG8_BAR;
        PG8_STAGE(PG8_SB(1, 0), cB + kstep, voffB); PG8_STAGE(PG8_SA(1, 0), cA + kstep, voffA); PG8_STAGE(PG8_SB(1, 1), cB + hstepB + kstep, voffB);
        PG8_WAIT_V(6); PG8_BAR;
    }
    for (;;) {
        const bool has_next = S.next(ui + 1, nxt);
        const char* nA = has_next ? (const char*)g.A + (size_t)nxt.pm * tstepA + S.a_off(nxt) : cA; const char* nB = has_next ? (const char*)g.Bt + (size_t)nxt.pn * tstepB : cB;
        _Pragma("unroll 1") for (int t = 0; t < nt; t += 2) {
            const bool last = (t == nt - 2);
            const char* a1 = cA + (size_t)(t + 1) * kstep;
            const char* a2 = last ? nA : cA + (size_t)(t + 2) * kstep; const char* b2 = last ? nB : cB + (size_t)(t + 2) * kstep;
            const char* a3 = a2 + kstep; const char* b3 = b2 + kstep;
            if (last && has_next) S.a_ready(nxt);
            if constexpr (SP2) {
            PG8_LDB(B0, 0, 0); PG8_LDB(B1, 0, 1); PG8_SCHED; PG8_LDA(At, 0, 0); PG8_STAGE(PG8_SA(1, 1), a1 + hstepA, voffA);
            PG8_WAIT_V(8); PG8_WAIT_L(0); PG8_BAR; PG8_MMA(0, 0, At, B0); PG8_MMA(0, 1, At, B1); PG8_BAR; PG8_SCHED;
            PG8_LDA(At, 0, 1); PG8_STAGE(PG8_SB(0, 0), b2, voffB); PG8_STAGE(PG8_SB(0, 1), b2 + hstepB, voffB); PG8_STAGE(PG8_SA(0, 0), a2, voffA);
            PG8_WAIT_V(8); PG8_WAIT_L(0); PG8_BAR; PG8_MMA(1, 0, At, B0); PG8_MMA(1, 1, At, B1); PG8_BAR; PG8_SCHED;
            PG8_LDB(B0, 1, 0); PG8_LDB(B1, 1, 1); PG8_SCHED; PG8_LDA(At, 1, 0); PG8_STAGE(PG8_SA(0, 1), a2 + hstepA, voffA);
            PG8_WAIT_V(8); PG8_WAIT_L(0); PG8_BAR; PG8_MMA(0, 0, At, B0); PG8_MMA(0, 1, At, B1); PG8_BAR; PG8_SCHED;
            PG8_LDA(At, 1, 1); PG8_STAGE(PG8_SB(1, 0), b3, voffB); PG8_STAGE(PG8_SB(1, 1), b3 + hstepB, voffB); PG8_STAGE(PG8_SA(1, 0), a3, voffA);
            PG8_WAIT_V(8); PG8_WAIT_L(0); PG8_BAR; PG8_MMA(1, 0, At, B0); PG8_MMA(1, 1, At, B1); PG8_BAR; PG8_SCHED;
            } else {
            PG8_LDB(B0, 0, 0); PG8_SCHED; PG8_LDA(At, 0, 0); PG8_STAGE(PG8_SA(1, 1), a1 + hstepA, voffA);
            PG8_WAIT_L(8); PG8_BAR; PG8_WAIT_L(0); PG8_MMA(0, 0, At, B0); PG8_BAR; PG8_SCHED;
            PG8_LDB(B1, 0, 1); PG8_STAGE(PG8_SB(0, 0), b2, voffB);
            PG8_BAR; PG8_WAIT_L(0); PG8_MMA(0, 1, At, B1); PG8_BAR;
            PG8_LDA(At, 0, 1); PG8_STAGE(PG8_SA(0, 0), a2, voffA);
            PG8_BAR; PG8_WAIT_L(0); PG8_MMA(1, 0, At, B0); PG8_BAR; PG8_SCHED;
            PG8_STAGE(PG8_SB(0, 1), b2 + hstepB, voffB);
            PG8_WAIT_V(6); PG8_BAR; PG8_MMA(1, 1, At, B1); PG8_BAR;
            PG8_LDB(B0, 1, 0); PG8_SCHED; PG8_LDA(At, 1, 0); PG8_STAGE(PG8_SA(0, 1), a2 + hstepA, voffA);
            PG8_WAIT_L(8); PG8_BAR; PG8_WAIT_L(0); PG8_MMA(0, 0, At, B0); PG8_BAR; PG8_SCHED;
            PG8_LDB(B1, 1, 1); PG8_STAGE(PG8_SB(1, 0), b3, voffB);
            PG8_BAR; PG8_WAIT_L(0); PG8_MMA(0, 1, At, B1); PG8_BAR;
            PG8_LDA(At, 1, 1); PG8_STAGE(PG8_SA(1, 0), a3, voffA);
            PG8_BAR; PG8_WAIT_L(0); PG8_MMA(1, 0, At, B0); PG8_BAR; PG8_SCHED;
            PG8_STAGE(PG8_SB(1, 1), b3 + hstepB, voffB);
            PG8_WAIT_V(6); PG8_BAR; PG8_MMA(1, 1, At, B1); PG8_BAR;
            }
        }
        if constexpr (ALIGN_EPI) { if (wr == 0) PG8_BAR; }
        if constexpr (!Epi::AFTER_DRAIN) { E(acc, cur, wr, wc, fr, fq); S.done(cur); }
        if (!has_next) break;
#pragma unroll
        for (int a = 0; a < 2; ++a)
#pragma unroll
            for (int b = 0; b < 2; ++b)
#pragma unroll
                for (int m = 0; m < 4; ++m)
#pragma unroll
                    for (int n = 0; n < 2; ++n) acc[a][b][m][n] = (f32x4){0.f, 0.f, 0.f, 0.f};
        cur = nxt; cA = nA; cB = nB; ++ui;
        if constexpr (ALIGN_EPI) { if (wr == 1) PG8_BAR; }
    }
    PG8_WAIT_V(0);
    if constexpr (!ALIGN_EPI) { if (wr == 0) PG8_BAR; }
    PG8_BAR;
    if constexpr (Epi::AFTER_DRAIN) { E.fused(acc, cur, wr, wc, fr, fq, lds, wid, lane); S.done(cur); }
#undef PG8_SA
#undef PG8_SB
#undef PG8_STAGE
#undef PG8_LDA
#undef PG8_LDB
#undef PG8_MMA
#undef PG8_WAIT_V
#undef PG8_WAIT_L
#undef PG8_BAR
#undef PG8_SCHED
}
}

typedef unsigned short bf16;
#define LASQ __attribute__((address_space(3)))
typedef float f32x4 __attribute__((ext_vector_type(4)));
typedef unsigned u32x4 __attribute__((ext_vector_type(4)));
typedef unsigned u32x2 __attribute__((ext_vector_type(2)));
constexpr int D = 2048, NB = 2, SEQ = 8192, CTX = 256, T = SEQ + CTX, M = NB * T, FF = 8192;
constexpr int ACOLS = 3712, BCOLS = 3104, PA_LD = 3840, PB_LD = 3328, NAB = 7168;
constexpr size_t MiB = 1u << 20;
constexpr size_t WS_MODV = 1 * MiB, WS_GDP = 2 * MiB;
constexpr size_t WS_WAB = 8 * MiB, WS_WOUT = 36 * MiB, WS_WLORA = 44 * MiB;
constexpr size_t WS_X = 48 * MiB, WS_HR = 180 * MiB, WS_MAIN = 246 * MiB, WS_END = 768 * MiB;
constexpr size_t MN_PA = WS_MAIN + 0 * MiB, MN_PB = WS_MAIN + 124 * MiB, MN_KV = WS_MAIN + 232 * MiB;
constexpr size_t MN_R = WS_MAIN + 364 * MiB, MN_V = WS_MAIN + 397 * MiB, MN_K = WS_MAIN + 430 * MiB;
constexpr size_t MN_O = WS_MAIN + 0 * MiB, MN_YD0 = WS_MAIN + 66 * MiB, MN_YD1 = WS_MAIN + 463 * MiB, MN_RA = WS_MAIN + 124 * MiB, MN_NT = WS_MAIN + 190 * MiB, MN_WKT = WS_MAIN + 256 * MiB;
constexpr size_t WS_GAM = 4 * MiB, WS_SPL = 7 * MiB;
constexpr size_t MN_W1_0 = WS_MAIN + 124 * MiB, MN_W2_0 = WS_MAIN + 156 * MiB, MN_U0 = WS_MAIN + 188 * MiB;
constexpr size_t MN_WLIN = WS_MAIN + 0 * MiB, MN_WLOUT = WS_MAIN + 16 * MiB, MN_WG = WS_MAIN + 24 * MiB, MN_W1_1 = WS_MAIN + 28 * MiB, MN_W2_1 = WS_MAIN + 60 * MiB;
constexpr size_t MN_GATE = WS_MAIN + 92 * MiB, MN_Z = WS_MAIN + 158 * MiB, MN_U1 = WS_MAIN + 158 * MiB;
constexpr size_t OT_GG = 0 * MiB, OT_WA0 = 33 * MiB, OT_LA = 99 * MiB, OT_XBR = 0 * MiB, OT_CAR = 66 * MiB, OT_Y = 0 * MiB;
constexpr int LDS_BYTES = 147456;
constexpr int NPH = 27;
constexpr int RCH = 132, RNCH = 64;
constexpr int LCH = 32, LNCH = T / LCH;

struct Args { const float* in[36]; float* out; unsigned char* ws; int ph_lo, ph_hi; };

__device__ __forceinline__ float bf2f(bf16 u) { return __builtin_bit_cast(float, (unsigned)u << 16); }

typedef float f32x2v __attribute__((ext_vector_type(2)));
typedef __bf16 bf16x2v __attribute__((ext_vector_type(2)));
__device__ __forceinline__ unsigned pk2(float lo, float hi) { const f32x2v v = {lo, hi}; const bf16x2v b = __builtin_convertvector(v, bf16x2v); return __builtin_bit_cast(unsigned, b); }
__device__ __forceinline__ unsigned f2bf(float f) { return pk2(f, 0.f) & 0xffffu; }
__device__ __forceinline__ float lo16(unsigned w) { return __builtin_bit_cast(float, w << 16); }
__device__ __forceinline__ float hi16(unsigned w) { return __builtin_bit_cast(float, w & 0xffff0000u); }
__device__ __forceinline__ float sigm(float x) { return __builtin_amdgcn_rcpf(1.f + __expf(-x)); }
__device__ __forceinline__ float softplus_(float x) { return x > 20.f ? x : log1pf(__expf(x)); }
__device__ __forceinline__ float silu_(float x) { return x * sigm(x); }
__device__ __forceinline__ float gelu_tanh(float x) { const float u = 0.7978845608028654f * (x + 0.044715f * x * x * x); return x * sigm(2.f * u); }
__device__ __forceinline__ float tanh_(float x) { return 2.f * sigm(2.f * x) - 1.f; }
__device__ __forceinline__ float wave_sum(float v) {
#pragma unroll
    for (int o = 1; o < 64; o <<= 1) v += __shfl_xor(v, o);
    return v;
}
#define LDS_BARRIER() do { asm volatile("s_waitcnt lgkmcnt(0)" ::: "memory"); __builtin_amdgcn_s_barrier(); asm volatile("" ::: "memory"); } while (0)
#define WAVE_LDS_SYNC() do { asm volatile("s_waitcnt lgkmcnt(0)" ::: "memory"); __builtin_amdgcn_wave_barrier(); } while (0)

#define XB_TMO      128
#define XB_XCNT(j)  (256  + 64 * (j))
#define XB_XSUB(j)  (1280 + 64 * (j))
#define XB_XGEN(j)  (2304 + 64 * (j))
#define XB_TOP      3328
#define XB_TOPGEN   3392
#define XCD_BAR_WORDS 3456
#define XB_SPIN_CAP (1u << 18)

__device__ __forceinline__ unsigned xb_ld(unsigned* p)              { return __hip_atomic_load(p, __ATOMIC_RELAXED, __HIP_MEMORY_SCOPE_AGENT); }
__device__ __forceinline__ unsigned xb_add(unsigned* p, unsigned v) { return __hip_atomic_fetch_add(p, v, __ATOMIC_RELAXED, __HIP_MEMORY_SCOPE_AGENT); }
__device__ __forceinline__ unsigned xb_xcc_id() { return (unsigned)__builtin_amdgcn_s_getreg((3 << 11) | 20) & 0xFu; }
#define XB_SPIN(cond, bar) do { unsigned _sp = 0; while (cond) { __builtin_amdgcn_s_sleep(1); \
    if ((++_sp & 255u) == 0u) { if (xb_ld(&(bar)[XB_TMO])) break; if (_sp > XB_SPIN_CAP) { atomicAdd(&(bar)[XB_TMO], 1u); break; } } } } while (0)

struct XcdBarrier {
    unsigned* bar; unsigned x;
    volatile unsigned* st;
};

__device__ __forceinline__ XcdBarrier xcd_barrier_post(unsigned* bar, volatile unsigned* st) {
    XcdBarrier b; b.bar = bar; b.x = xb_xcc_id(); b.st = st;
    if (threadIdx.x == 0) (void)xb_add(&bar[XB_XCNT(b.x)], 1u);
    return b;
}
__device__ __forceinline__ void xcd_barrier_complete(unsigned* bar, unsigned x, unsigned& nloc, unsigned& nx) {
    const unsigned G = gridDim.x * gridDim.y * gridDim.z;
    unsigned sum, cnt, mine, sp = 0u;
    for (;;) {
        sum = 0u; cnt = 0u; mine = 0u;
#pragma unroll
        for (unsigned j = 0; j < 16; ++j) { const unsigned c = xb_ld(&bar[XB_XCNT(j)]); sum += c; cnt += (c > 0u) ? 1u : 0u; mine = (j == x) ? c : mine; }
        if (sum == G) break;
        __builtin_amdgcn_s_sleep(1);
        if ((++sp & 255u) == 0u) { if (xb_ld(&bar[XB_TMO])) break; if (sp > XB_SPIN_CAP) { atomicAdd(&bar[XB_TMO], 1u); break; } }
    }
    nloc = mine > 0u ? mine : 1u; nx = cnt > 0u ? cnt : 1u;
}

__device__ __forceinline__ void xcd_barrier(const XcdBarrier& b) {
    asm volatile("s_waitcnt vmcnt(0)" ::: "memory");
    __syncthreads();
    if (threadIdx.x == 0) {
        unsigned* bar = b.bar;
        __builtin_amdgcn_s_waitcnt(0);
        unsigned nloc = b.st[0], nx = b.st[1];
        if (nloc == 0u) { xcd_barrier_complete(bar, b.x, nloc, nx); b.st[0] = nloc; b.st[1] = nx; }
        const unsigned old = xb_add(&bar[XB_XSUB(b.x)], 1u);
        const unsigned gen = old / nloc;
        if (old + 1u == (gen + 1u) * nloc) {
            __builtin_amdgcn_fence(__ATOMIC_RELEASE, "agent");
            asm volatile("s_waitcnt vmcnt(0)" ::: "memory");
            const unsigned og = xb_add(&bar[XB_TOP], 1u);
            const unsigned tg = og / nx;
            if (og + 1u == (tg + 1u) * nx) xb_add(&bar[XB_TOPGEN], 1u);
            else XB_SPIN(xb_ld(&bar[XB_TOPGEN]) == tg, bar);
            __builtin_amdgcn_fence(__ATOMIC_ACQUIRE, "agent");
            xb_add(&bar[XB_XGEN(b.x)], 1u);
            asm volatile("s_waitcnt vmcnt(0)" ::: "memory");
        } else {
            XB_SPIN(xb_ld(&bar[XB_XGEN(b.x)]) == gen, bar);
            __builtin_amdgcn_fence(__ATOMIC_ACQUIRE, "agent");
            asm volatile("s_waitcnt vmcnt(0)" ::: "memory");
        }
    }
    __syncthreads();
}


struct Ctx { unsigned char* lds; int tid, lane, wave, G, bid, gw, NGW; };

__device__ __forceinline__ int scan_t(int d, int sp) { return d ? (sp < CTX ? (CTX - 1 - sp) : (T + CTX - 1 - sp)) : sp; }

__device__ __forceinline__ void xpose_item(const float* W, int ldw, bf16* WT, int ldt, int nblk, float* scr, int item, int lane) {
    const int kb = item / nblk, nb = item % nblk, k0 = 64 * kb, n0 = 32 * nb;
    f32x4 t[8];
#pragma unroll
    for (int i = 0; i < 8; ++i) t[i] = *(const f32x4*)(W + (size_t)(k0 + 8 * i + (lane >> 3)) * ldw + n0 + 4 * (lane & 7));
#pragma unroll
    for (int i = 0; i < 8; ++i) { float* s = scr + (8 * i + (lane >> 3)) * 33 + 4 * (lane & 7); s[0] = t[i][0]; s[1] = t[i][1]; s[2] = t[i][2]; s[3] = t[i][3]; }
    WAVE_LDS_SYNC();
    const int c = lane & 7;
#pragma unroll
    for (int j = 0; j < 4; ++j) { const int n = (lane >> 3) + 8 * j; const float* s = scr + (8 * c) * 33 + n;
        u32x4 o; o.x = pk2(s[0 * 33], s[1 * 33]); o.y = pk2(s[2 * 33], s[3 * 33]); o.z = pk2(s[4 * 33], s[5 * 33]); o.w = pk2(s[6 * 33], s[7 * 33]);
        *(u32x4*)(WT + (size_t)(n0 + n) * ldt + k0 + 8 * c) = o; }
    WAVE_LDS_SYNC();
}
__device__ __forceinline__ void xpose(const Ctx& F, const float* W, int ldw, int K, int N, bf16* WT, int ldt) {
    float* scr = (float*)(F.lds + F.wave * 16384);
    const int nblk = N / 32, nit = (K / 64) * nblk;
    for (int it = F.gw; it < nit; it += F.NGW) xpose_item(W, ldw, WT, ldt, nblk, scr, it, F.lane);
}

__device__ __forceinline__ void mod_gemv(const Ctx& F, const float* c, const float* c_ctx, const float* mod_w, const float* mod_b, float* modv) {
    float* sv = (float*)F.lds;
    float* red = (float*)(F.lds + 32768);
    for (int i = F.tid; i < 3 * D; i += 512) { const int r = i / D, k = i % D; const float x = (r < 2) ? c[r * D + k] : c_ctx[k]; sv[i] = silu_(x); }
    __syncthreads();
    const int l4 = F.tid & 15, kg = F.tid >> 4;
    for (int it = F.bid; it < 2 * 192; it += F.G) {
        const int layer = it / 192, n0 = (it % 192) * 64;
        const float* Wp = mod_w + (size_t)layer * D * 12288 + n0 + 4 * l4;
        f32x4 a0 = {0.f, 0.f, 0.f, 0.f}, a1 = a0, a2 = a0;
#pragma unroll 8
        for (int kk = 0; kk < 64; ++kk) { const int k = kg * 64 + kk; const f32x4 w = *(const f32x4*)(Wp + (size_t)k * 12288);
            a0 += w * sv[k]; a1 += w * sv[D + k]; a2 += w * sv[2 * D + k]; }
        *(f32x4*)(red + (kg * 3 + 0) * 64 + 4 * l4) = a0; *(f32x4*)(red + (kg * 3 + 1) * 64 + 4 * l4) = a1; *(f32x4*)(red + (kg * 3 + 2) * 64 + 4 * l4) = a2;
        __syncthreads();
        if (F.tid < 192) { const int r = F.tid / 64, n = F.tid % 64; float s = mod_b[layer * 12288 + n0 + n];
            for (int g = 0; g < 32; ++g) s += red[(g * 3 + r) * 64 + n];
            modv[(size_t)(layer * 3 + r) * 12288 + n0 + n] = s; }
        __syncthreads();
    }
}

__device__ __forceinline__ void norm_mod(const Ctx& F, const float* X, const float* xin, const float* cin, const float* g, const float* modv, int ishift, int iscale, bf16* H, int latent_only) {
    for (int m = F.gw; m < M; m += F.NGW) {
        const int b = m / T, t = m % T;
        if (latent_only && t < CTX) continue;
        const float* xr = xin ? (t < CTX ? cin + (size_t)(b * CTX + t) * D : xin + (size_t)(b * SEQ + t - CTX) * D) : X + (size_t)m * D;
        const int mi = (t < CTX) ? 2 : b;
        const float* sh = modv + (size_t)(mi * 6 + ishift) * D; const float* sc = modv + (size_t)(mi * 6 + iscale) * D;
        f32x4 v[8]; float s = 0.f;
#pragma unroll
        for (int j = 0; j < 8; ++j) { v[j] = *(const f32x4*)(xr + 4 * F.lane + 256 * j); s += (v[j].x * v[j].x + v[j].y * v[j].y) + (v[j].z * v[j].z + v[j].w * v[j].w); }
        const float rstd = rsqrtf(wave_sum(s) * (1.f / D) + 1e-6f);
#pragma unroll
        for (int j = 0; j < 8; ++j) { const int col = 4 * F.lane + 256 * j;
            const f32x4 gg = *(const f32x4*)(g + col), s1 = *(const f32x4*)(sc + col), s0 = *(const f32x4*)(sh + col);
            const f32x4 y = v[j] * rstd * gg * (s1 + 1.f) + s0;
            u32x2 o; o.x = pk2(y.x, y.y); o.y = pk2(y.z, y.w);
            *(u32x2*)(H + (size_t)m * D + col) = o; }
    }
}
__device__ __forceinline__ void final_norm(const Ctx& F, const float* X, const float* g, float* out) {
    for (int r = F.gw; r < NB * SEQ; r += F.NGW) {
        const int b = r / SEQ, tl = r % SEQ; const float* xr = X + (size_t)(b * T + CTX + tl) * D;
        f32x4 v[8]; float s = 0.f;
#pragma unroll
        for (int j = 0; j < 8; ++j) { v[j] = *(const f32x4*)(xr + 4 * F.lane + 256 * j); s += (v[j].x * v[j].x + v[j].y * v[j].y) + (v[j].z * v[j].z + v[j].w * v[j].w); }
        const float rstd = rsqrtf(wave_sum(s) * (1.f / D) + 1e-6f);
#pragma unroll
        for (int j = 0; j < 8; ++j) { const int col = 4 * F.lane + 256 * j; *(f32x4*)(out + (size_t)r * D + col) = v[j] * rstd * *(const f32x4*)(g + col); }
    }
}

__device__ __forceinline__ void rwkv_mix(const Ctx& F, const bf16* PA, const float* mu, bf16* Rr, bf16* Rk, bf16* Rv, bf16* LA) {
    for (int m = F.gw; m < M; m += F.NGW) {
        const int t = m % T;
        const bool hp = (t != 0) && (t != CTX), hn = (t != CTX - 1) && (t != T - 1);
        const bf16* p0 = PA + (size_t)m * PA_LD;
        u32x4 cur[8], pv[8], nv[8];
#pragma unroll
        for (int q = 0; q < 8; ++q) { const int g8 = F.lane + 64 * q; const int c0 = (g8 < ACOLS / 8 ? g8 : 0) * 8;
            cur[q] = *(const u32x4*)(p0 + c0); pv[q] = (u32x4){0u, 0u, 0u, 0u}; nv[q] = (u32x4){0u, 0u, 0u, 0u};
            if (hp) pv[q] = *(const u32x4*)(p0 - PA_LD + c0);
            if (hn) nv[q] = *(const u32x4*)(p0 + PA_LD + c0); }
#pragma unroll
        for (int q = 0; q < 8; ++q) { const int g8 = F.lane + 64 * q; if (g8 >= ACOLS / 8) continue;
            const int c0 = g8 * 8;
            float y[8];
#pragma unroll
            for (int e = 0; e < 4; ++e) {
                const float pl = lo16(cur[q][e]), ph = hi16(cur[q][e]);
                y[2 * e] = pl + mu[c0 + 2 * e] * (lo16(pv[q][e]) - pl) + mu[ACOLS + c0 + 2 * e] * (lo16(nv[q][e]) - pl);
                y[2 * e + 1] = ph + mu[c0 + 2 * e + 1] * (hi16(pv[q][e]) - ph) + mu[ACOLS + c0 + 2 * e + 1] * (hi16(nv[q][e]) - ph);
            }
            bf16* dst;
            if (c0 < 1024) dst = Rr + (size_t)m * 1024 + c0;
            else if (c0 < 2048) dst = Rk + (size_t)m * 1024 + (c0 - 1024);
            else if (c0 < 3072) dst = Rv + (size_t)m * 1024 + (c0 - 2048);
            else if (c0 < 3328) { dst = LA + (size_t)m * 768 + (c0 - 3072);
#pragma unroll
                for (int e = 0; e < 8; ++e) y[e] = sigm(y[e]); }
            else if (c0 < 3520) { const int qq = c0 - 3328, d = qq / 96; dst = LA + (size_t)m * 768 + 256 + d * 256 + (qq - d * 96);
#pragma unroll
                for (int e = 0; e < 8; ++e) y[e] = tanh_(y[e]); }
            else { const int qq = c0 - 3520, d = qq / 96; dst = LA + (size_t)m * 768 + 256 + d * 256 + 96 + (qq - d * 96); }
            u32x4 o; o.x = pk2(y[0], y[1]); o.y = pk2(y[2], y[3]); o.z = pk2(y[4], y[5]); o.w = pk2(y[6], y[7]);
            *(u32x4*)dst = o;
        }
        if (F.lane < 16) { const int d = F.lane >> 3, j = F.lane & 7; const u32x4 z = {0u, 0u, 0u, 0u}; *(u32x4*)(LA + (size_t)m * 768 + 256 + d * 256 + 192 + 8 * j) = z; }
    }
}

typedef short bf16x8v __attribute__((ext_vector_type(8)));
constexpr int GC = 64, GNC = T / GC;
constexpr int GL_CUM = 0, GL_QI = 33792, GL_KI = 51200, GL_VV = 68608, GL_PP = 102400, GL_RSQ = 111616, GL_GW = 113664, GL_GD = 121856;
constexpr int GCLD = 132;
constexpr int QLD = 136, VLD = 264, PLD = 72;
struct GlaP { const bf16* PB; const float *gw2, *gb; bf16* KV; float* GDP; };
__device__ __forceinline__ int gla_chunk_of(int d, int pc) { return d ? (pc < 4 ? 3 - pc : 135 - pc) : pc; }
__device__ __forceinline__ void gla_gates(const Ctx& F, const GlaP& P, int b, int h, int d, int pos0) {
    LASQ float* cum = (LASQ float*)(F.lds + GL_CUM); LASQ float* gwl = (LASQ float*)(F.lds + GL_GW); LASQ float* gdl = (LASQ float*)(F.lds + GL_GD);
    const int p = F.tid >> 3, kg = F.tid & 7;
    { const int e = F.tid >> 5, q = F.tid & 31; *(LASQ f32x4*)(gwl + e * 128 + 4 * q) = *(const f32x4*)(P.gw2 + (size_t)(d * 16 + e) * 512 + h * 128 + 4 * q); }
    if (kg < 4) { const bf16* row = P.PB + (size_t)(b * T + pos0 + p) * PB_LD + 3072 + d * 16 + 4 * kg; const u32x2 g = *(const u32x2*)row;
        *(LASQ f32x4*)(gdl + p * 16 + 4 * kg) = (f32x4){lo16(g.x), hi16(g.x), lo16(g.y), hi16(g.y)}; }
    LDS_BARRIER();
    f32x4 z[4];
    const float* gbp = P.gb + d * 512 + h * 128 + kg * 16;
#pragma unroll
    for (int q = 0; q < 4; ++q) z[q] = *(const f32x4*)(gbp + 4 * q);
#pragma unroll 2
    for (int e = 0; e < 16; ++e) { const float g = gdl[p * 16 + e]; const LASQ float* gwp = gwl + e * 128 + kg * 16;
#pragma unroll
        for (int q = 0; q < 4; ++q) z[q] += *(const f32x4*)(gwp + 4 * q) * g; }
#pragma unroll
    for (int q = 0; q < 4; ++q) { f32x4 t;
#pragma unroll
        for (int e = 0; e < 4; ++e) { const float nz = -z[q][e]; t[e] = -((nz > 20.f) ? nz : __logf(1.f + __expf(nz))) * (1.f / 16.f); }
        *(LASQ f32x4*)(cum + p * GCLD + kg * 16 + 4 * q) = t; }
    LDS_BARRIER();
    if (F.tid < 128) { float tv[GC];
#pragma unroll
        for (int pp = 0; pp < GC; ++pp) tv[pp] = cum[pp * GCLD + F.tid];
        float s = 0.f;
        if (d == 0) {
#pragma unroll
            for (int pp = 0; pp < GC; ++pp) { s += tv[pp]; tv[pp] = s; } }
        else {
#pragma unroll
            for (int pp = GC - 1; pp >= 0; --pp) { s += tv[pp]; tv[pp] = s; } }
#pragma unroll
        for (int pp = 0; pp < GC; ++pp) cum[pp * GCLD + F.tid] = tv[pp]; }
    LDS_BARRIER();
}
__device__ __forceinline__ bf16x8v lfrag8(const LASQ bf16* p) { return *(const LASQ bf16x8v*)p; }
__device__ __forceinline__ bf16x8v lgather8(const LASQ bf16* p, int stride) { bf16x8v r;
#pragma unroll
    for (int e = 0; e < 8; ++e) r[e] = (short)p[e * stride];
    return r; }
__device__ __forceinline__ void gla_load_v(const Ctx& F, const GlaP& P, int b, int h, int pos0) {
    const int p = F.tid >> 3, kg = F.tid & 7; LASQ bf16* VV = (LASQ bf16*)(F.lds + GL_VV);
    const bf16* row = P.PB + (size_t)(b * T + pos0 + p) * PB_LD + 1024 + h * 256 + kg * 32;
#pragma unroll
    for (int q = 0; q < 4; ++q) *(LASQ u32x4*)(VV + p * VLD + kg * 32 + 8 * q) = *(const u32x4*)(row + 8 * q);
}
__device__ __forceinline__ void gla_kv(const Ctx& F, const GlaP& P) {
    LASQ float* cum = (LASQ float*)(F.lds + GL_CUM); LASQ bf16* KI = (LASQ bf16*)(F.lds + GL_KI); const LASQ bf16* VV = (const LASQ bf16*)(F.lds + GL_VV);
    const int p = F.tid >> 3, kg = F.tid & 7, row = F.lane & 15, quad = F.lane >> 4;
    for (int it = F.bid; it < 16 * GNC; it += F.G) {
        const int seq = it / GNC, c = it % GNC, b = seq >> 3, d = (seq >> 2) & 1, h = seq & 3;
        const int pc = gla_chunk_of(d, c), pos0 = pc * GC;
        gla_load_v(F, P, b, h, pos0);
        gla_gates(F, P, b, h, d, pos0);
        const int tp = d ? 0 : (GC - 1);
        { const bf16* rowp = P.PB + (size_t)(b * T + pos0 + p) * PB_LD + 512 + h * 128 + kg * 16;
          const u32x4 k0 = *(const u32x4*)rowp, k1 = *(const u32x4*)(rowp + 8);
          float kv[16];
#pragma unroll
          for (int e = 0; e < 4; ++e) { kv[2 * e] = lo16(k0[e]); kv[2 * e + 1] = hi16(k0[e]); kv[8 + 2 * e] = lo16(k1[e]); kv[8 + 2 * e + 1] = hi16(k1[e]); }
#pragma unroll
          for (int e = 0; e < 16; ++e) kv[e] *= __expf(cum[tp * GCLD + kg * 16 + e] - cum[p * GCLD + kg * 16 + e]);
          u32x4 o0, o1;
#pragma unroll
          for (int e = 0; e < 4; ++e) { o0[e] = pk2(kv[2 * e], kv[2 * e + 1]); o1[e] = pk2(kv[8 + 2 * e], kv[8 + 2 * e + 1]); }
          *(LASQ u32x4*)(KI + p * QLD + kg * 16) = o0; *(LASQ u32x4*)(KI + p * QLD + kg * 16 + 8) = o1; }
        if (F.tid < 128) P.GDP[(size_t)it * 128 + F.tid] = __expf(cum[tp * GCLD + F.tid]);
        LDS_BARRIER();
        const int v0 = 32 * F.wave;
        f32x4 acc[2][8];
#pragma unroll
        for (int mt = 0; mt < 2; ++mt)
#pragma unroll
            for (int nt = 0; nt < 8; ++nt) acc[mt][nt] = (f32x4){0.f, 0.f, 0.f, 0.f};
#pragma unroll
        for (int ks = 0; ks < 2; ++ks) {
            bf16x8v a[2];
#pragma unroll
            for (int mt = 0; mt < 2; ++mt) a[mt] = lgather8(VV + (ks * 32 + quad * 8) * VLD + v0 + mt * 16 + row, VLD);
#pragma unroll
            for (int nt = 0; nt < 8; ++nt) { const bf16x8v bb = lgather8(KI + (ks * 32 + quad * 8) * QLD + nt * 16 + row, QLD);
#pragma unroll
                for (int mt = 0; mt < 2; ++mt) acc[mt][nt] = __builtin_amdgcn_mfma_f32_16x16x32_bf16(a[mt], bb, acc[mt][nt], 0, 0, 0); }
        }
        bf16* kvp = P.KV + (size_t)it * 32768;
#pragma unroll
        for (int mt = 0; mt < 2; ++mt)
#pragma unroll
            for (int nt = 0; nt < 8; ++nt)
#pragma unroll
                for (int j = 0; j < 4; ++j) kvp[(size_t)(v0 + mt * 16 + quad * 4 + j) * 128 + nt * 16 + row] = (bf16)f2bf(acc[mt][nt][j]);
        LDS_BARRIER();
    }
}
__device__ __forceinline__ void gla_carry(const Ctx& F, const GlaP& P) {
    const int nth = F.G * 512;
    for (int i = F.bid * 512 + F.tid; i < 16 * 256 * 16; i += nth) {
        const int k8 = i & 15, v = (i >> 4) & 255, seq = i >> 12;
        float s[8];
#pragma unroll
        for (int e = 0; e < 8; ++e) s[e] = 0.f;
        for (int c0 = 0; c0 < GNC; c0 += 6) {
            u32x4 q[6]; f32x4 d0[6], d1[6];
#pragma unroll
            for (int j = 0; j < 6; ++j) { const size_t sc = (size_t)seq * GNC + c0 + j;
                q[j] = *(const u32x4*)(P.KV + (sc * 256 + v) * 128 + 8 * k8); d0[j] = *(const f32x4*)(P.GDP + sc * 128 + 8 * k8); d1[j] = *(const f32x4*)(P.GDP + sc * 128 + 8 * k8 + 4); }
#pragma unroll
            for (int j = 0; j < 6; ++j) { const size_t sc = (size_t)seq * GNC + c0 + j;
                u32x4 o;
#pragma unroll
                for (int e = 0; e < 4; ++e) o[e] = pk2(s[2 * e], s[2 * e + 1]);
                *(u32x4*)(P.KV + (sc * 256 + v) * 128 + 8 * k8) = o;
                const float dd[8] = {d0[j][0], d0[j][1], d0[j][2], d0[j][3], d1[j][0], d1[j][1], d1[j][2], d1[j][3]};
#pragma unroll
                for (int e = 0; e < 4; ++e) { s[2 * e] = s[2 * e] * dd[2 * e] + lo16(q[j][e]); s[2 * e + 1] = s[2 * e + 1] * dd[2 * e + 1] + hi16(q[j][e]); } }
        }
    }
}
__device__ __forceinline__ void gla_out(const Ctx& F, const GlaP& P, const float* gn, bf16* O) {
    LASQ float* cum = (LASQ float*)(F.lds + GL_CUM); LASQ bf16* QI = (LASQ bf16*)(F.lds + GL_QI); LASQ bf16* KI = (LASQ bf16*)(F.lds + GL_KI); const LASQ bf16* VV = (const LASQ bf16*)(F.lds + GL_VV);
    LASQ bf16* PP = (LASQ bf16*)(F.lds + GL_PP); LASQ float* RSQ = (LASQ float*)(F.lds + GL_RSQ);
    const int p = F.tid >> 3, kg = F.tid & 7, row = F.lane & 15, quad = F.lane >> 4, v0 = 32 * F.wave;
    for (int it = F.bid; it < NB * 4 * GNC; it += F.G) {
        const int pc = it % GNC, bh = it / GNC, b = bh >> 2, h = bh & 3, pos0 = pc * GC;
        gla_load_v(F, P, b, h, pos0);
        f32x4 acc[4][2];
#pragma unroll
        for (int mt = 0; mt < 4; ++mt) { acc[mt][0] = (f32x4){0.f, 0.f, 0.f, 0.f}; acc[mt][1] = (f32x4){0.f, 0.f, 0.f, 0.f}; }
#pragma unroll 1
        for (int d = 0; d < 2; ++d) {
            const int seq = (b * 2 + d) * 4 + h, c = gla_chunk_of(d, pc);
            const bf16* kvp = P.KV + ((size_t)seq * GNC + c) * 32768;
            gla_gates(F, P, b, h, d, pos0);
            bf16x8v kvf[4][2];
#pragma unroll
            for (int ks = 0; ks < 4; ++ks)
#pragma unroll
                for (int nt = 0; nt < 2; ++nt) kvf[ks][nt] = *(const bf16x8v*)(kvp + (size_t)(v0 + nt * 16 + row) * 128 + ks * 32 + quad * 8);
            { const bf16* rowp = P.PB + (size_t)(b * T + pos0 + p) * PB_LD + h * 128 + kg * 16;
              const u32x4 q0 = *(const u32x4*)rowp, q1 = *(const u32x4*)(rowp + 8), k0 = *(const u32x4*)(rowp + 512), k1 = *(const u32x4*)(rowp + 520);
              float qv[16], kv[16];
#pragma unroll
              for (int e = 0; e < 4; ++e) { qv[2 * e] = lo16(q0[e]); qv[2 * e + 1] = hi16(q0[e]); qv[8 + 2 * e] = lo16(q1[e]); qv[8 + 2 * e + 1] = hi16(q1[e]);
                  kv[2 * e] = lo16(k0[e]); kv[2 * e + 1] = hi16(k0[e]); kv[8 + 2 * e] = lo16(k1[e]); kv[8 + 2 * e + 1] = hi16(k1[e]); }
#pragma unroll
              for (int e = 0; e < 16; ++e) { const float cc = cum[p * GCLD + kg * 16 + e]; qv[e] *= 0.08838834764831845f * __expf(cc); kv[e] *= __expf(-cc); }
              u32x4 o0, o1, o2, o3;
#pragma unroll
              for (int e = 0; e < 4; ++e) { o0[e] = pk2(qv[2 * e], qv[2 * e + 1]); o1[e] = pk2(qv[8 + 2 * e], qv[8 + 2 * e + 1]); o2[e] = pk2(kv[2 * e], kv[2 * e + 1]); o3[e] = pk2(kv[8 + 2 * e], kv[8 + 2 * e + 1]); }
              *(LASQ u32x4*)(QI + p * QLD + kg * 16) = o0; *(LASQ u32x4*)(QI + p * QLD + kg * 16 + 8) = o1; *(LASQ u32x4*)(KI + p * QLD + kg * 16) = o2; *(LASQ u32x4*)(KI + p * QLD + kg * 16 + 8) = o3; }
            LDS_BARRIER();
#pragma unroll
            for (int tt = 0; tt < 2; ++tt) { const int t = 2 * F.wave + tt, itl = t >> 2, jt = t & 3;
                f32x4 sc = {0.f, 0.f, 0.f, 0.f};
                const bool live = d ? (jt >= itl) : (jt <= itl);
                if (live) {
#pragma unroll
                    for (int ks = 0; ks < 4; ++ks) { const bf16x8v a = lfrag8(QI + (itl * 16 + row) * QLD + ks * 32 + quad * 8), bb = lfrag8(KI + (jt * 16 + row) * QLD + ks * 32 + quad * 8);
                        sc = __builtin_amdgcn_mfma_f32_16x16x32_bf16(a, bb, sc, 0, 0, 0); } }
#pragma unroll
                for (int j = 0; j < 4; ++j) { const int ii = itl * 16 + quad * 4 + j, jj = jt * 16 + row; const bool keep = d ? (jj >= ii) : (jj <= ii);
                    PP[ii * PLD + jj] = (bf16)f2bf(keep ? sc[j] : 0.f); } }
            LDS_BARRIER();
#pragma unroll
            for (int ks = 0; ks < 2; ++ks) {
                bf16x8v bb[2];
#pragma unroll
                for (int nt = 0; nt < 2; ++nt) bb[nt] = lgather8(VV + (ks * 32 + quad * 8) * VLD + v0 + nt * 16 + row, VLD);
#pragma unroll
                for (int mt = 0; mt < 4; ++mt) { const bf16x8v a = lfrag8(PP + (mt * 16 + row) * PLD + ks * 32 + quad * 8);
                    acc[mt][0] = __builtin_amdgcn_mfma_f32_16x16x32_bf16(a, bb[0], acc[mt][0], 0, 0, 0); acc[mt][1] = __builtin_amdgcn_mfma_f32_16x16x32_bf16(a, bb[1], acc[mt][1], 0, 0, 0); }
            }
#pragma unroll
            for (int ks = 0; ks < 4; ++ks) {
#pragma unroll
                for (int mt = 0; mt < 4; ++mt) { const bf16x8v a = lfrag8(QI + (mt * 16 + row) * QLD + ks * 32 + quad * 8);
                    acc[mt][0] = __builtin_amdgcn_mfma_f32_16x16x32_bf16(a, kvf[ks][0], acc[mt][0], 0, 0, 0); acc[mt][1] = __builtin_amdgcn_mfma_f32_16x16x32_bf16(a, kvf[ks][1], acc[mt][1], 0, 0, 0); }
            }
            LDS_BARRIER();
        }
#pragma unroll
        for (int mt = 0; mt < 4; ++mt)
#pragma unroll
            for (int j = 0; j < 4; ++j) { float ss = acc[mt][0][j] * acc[mt][0][j] + acc[mt][1][j] * acc[mt][1][j];
                ss += __shfl_xor(ss, 1); ss += __shfl_xor(ss, 2); ss += __shfl_xor(ss, 4); ss += __shfl_xor(ss, 8);
                if (row == 0) RSQ[F.wave * 64 + mt * 16 + quad * 4 + j] = ss; }
        LDS_BARRIER();
        const bf16* gbase = P.PB + (size_t)(b * T + pos0 + quad * 4) * PB_LD + 2048 + h * 256 + v0 + row; bf16* obase = O + (size_t)(b * T + pos0 + quad * 4) * 2048 + 1024 + h * 256 + v0 + row;
        const float gnv[2] = {gn[v0 + row], gn[v0 + 16 + row]};
#pragma unroll
        for (int mt = 0; mt < 4; ++mt)
#pragma unroll
            for (int j = 0; j < 4; ++j) { const int pr = mt * 16 + quad * 4 + j; float ss = 0.f;
#pragma unroll
                for (int w = 0; w < 8; ++w) ss += RSQ[w * 64 + pr];
                const float rs = rsqrtf(ss * (1.f / 256.f) + 1e-6f);
#pragma unroll
                for (int nt = 0; nt < 2; ++nt) { const float g = bf2f(gbase[(mt * 16 + j) * PB_LD + nt * 16]);
                    obase[(mt * 16 + j) * 2048 + nt * 16] = (bf16)f2bf(acc[mt][nt][j] * rs * gnv[nt] * silu_(g)); } }
        LDS_BARRIER();
    }
}

constexpr int RWC = 64, RWN = T / RWC;
constexpr int RW_CUM = 0, RW_AT = 17408, RW_RT = 26624, RW_BT = 35840, RW_KT = 45056, RW_BH = 54272, RW_KH = 63488, RW_VT = 72704, RW_M1 = 81920, RW_M2 = 98304, RW_M3 = 114688, RW_M4 = 123904, RW_TM2 = 133120;
constexpr int CLD = 68;
constexpr int RLD = 72;
struct RwP2 { const bf16 *Rr, *Rk, *Rv, *WA0, *WA1; const float *w0, *a0, *kkw, *kaw; bf16 *RA, *NT, *WKT; float* GAM; bf16 *YD0, *YD1; };
__device__ __forceinline__ void unpack8(const u32x4 w, float (&o)[8]) {
#pragma unroll
    for (int e = 0; e < 4; ++e) { o[2 * e] = lo16(w[e]); o[2 * e + 1] = hi16(w[e]); } }
__device__ __forceinline__ u32x4 pack8(const float (&v)[8]) { u32x4 o;
#pragma unroll
    for (int e = 0; e < 4; ++e) o[e] = pk2(v[2 * e], v[2 * e + 1]);
    return o; }
template <int Q> __device__ __forceinline__ void rw1_scores(LASQ unsigned char* L, int half, int row, int quad) {
    const LASQ bf16* Am = (const LASQ bf16*)(L + ((Q < 2) ? RW_AT : RW_RT)) + row * RLD + quad * 8;
    const LASQ bf16* Bm = (const LASQ bf16*)(L + ((Q & 1) ? RW_KT : RW_BT)) + row * RLD + quad * 8;
    LASQ float* Mf = (LASQ float*)(L + (Q == 0 ? RW_M1 : RW_M2)) + (quad * 4) * 64 + row;
    LASQ bf16* Mb = (LASQ bf16*)(L + (Q == 2 ? RW_M3 : RW_M4)) + (quad * 4) * RLD + row;
#pragma unroll 2
    for (int tt = 0; tt < 8; ++tt) { const int t = half * 8 + tt, mt = t >> 2, nt = t & 3;
        f32x4 acc = {0.f, 0.f, 0.f, 0.f};
        if (nt <= mt) { const LASQ bf16* ap = Am + mt * 16 * RLD; const LASQ bf16* bp = Bm + nt * 16 * RLD;
            acc = __builtin_amdgcn_mfma_f32_16x16x32_bf16(lfrag8(ap), lfrag8(bp), acc, 0, 0, 0); acc = __builtin_amdgcn_mfma_f32_16x16x32_bf16(lfrag8(ap + 32), lfrag8(bp + 32), acc, 0, 0, 0); }
        const int di = mt * 16 + quad * 4 - (nt * 16 + row);
        if (Q < 2) { LASQ float* d = Mf + mt * 16 * 64 + nt * 16;
#pragma unroll
            for (int jj = 0; jj < 4; ++jj) d[jj * 64] = (di + jj > 0) ? acc[jj] : 0.f; }
        else { LASQ bf16* d = Mb + mt * 16 * RLD + nt * 16;
#pragma unroll
            for (int jj = 0; jj < 4; ++jj) d[jj * RLD] = (bf16)(pk2((di + jj >= 0) ? acc[jj] : 0.f, 0.f) & 0xffffu); }
    }
}
template <int Q> __device__ __forceinline__ void rw1_products(LASQ unsigned char* L, int half, int row, int quad, bf16* gout) {
    const LASQ bf16* M3 = (const LASQ bf16*)(L + RW_M3) + row * RLD + quad * 8;
    const LASQ bf16* TX = (const LASQ bf16*)(L + ((Q == 0 || Q == 2) ? RW_CUM : RW_TM2)) + row * RLD + quad * 8;
    const LASQ bf16* Bh = (const LASQ bf16*)(L + RW_BH) + row * RLD + quad * 8;
    const LASQ bf16* Ad = (const LASQ bf16*)(L + (Q == 0 ? RW_RT : (Q == 1 ? RW_M4 : RW_KH))) + (quad * 4) * RLD + row;
    LASQ bf16* CY = (LASQ bf16*)(L + RW_M1) + (quad * 4) * RLD + row;
#pragma unroll 2
    for (int tt = 0; tt < 8; ++tt) { const int t = half * 8 + tt, mt = t >> 2, nt = t & 3;
        f32x4 acc = {0.f, 0.f, 0.f, 0.f};
#pragma unroll
        for (int ks = 0; ks < 2; ++ks) { bf16x8v a, bb;
            if (Q < 2) { a = lfrag8(M3 + mt * 16 * RLD + ks * 32); bb = lfrag8(TX + nt * 16 * RLD + ks * 32); }
            else { a = lfrag8(TX + mt * 16 * RLD + ks * 32); bb = lfrag8(Bh + nt * 16 * RLD + ks * 32); }
            acc = __builtin_amdgcn_mfma_f32_16x16x32_bf16(a, bb, acc, 0, 0, 0); }
        float o[4];
        if (Q != 2) { const LASQ bf16* ad = Ad + mt * 16 * RLD + nt * 16;
#pragma unroll
            for (int jj = 0; jj < 4; ++jj) o[jj] = acc[jj] + bf2f(ad[jj * RLD]); }
        else {
#pragma unroll
            for (int jj = 0; jj < 4; ++jj) o[jj] = acc[jj]; }
        if (Q == 0) { bf16* g = gout + (mt * 16 + quad * 4) * 64 + nt * 16 + row;
#pragma unroll
            for (int jj = 0; jj < 4; ++jj) g[jj * 64] = (bf16)(pk2(o[jj], 0.f) & 0xffffu); }
        else if (Q == 1) { LASQ bf16* d = CY + mt * 16 * RLD + nt * 16;
#pragma unroll
            for (int jj = 0; jj < 4; ++jj) d[jj * RLD] = (bf16)(pk2(o[jj], 0.f) & 0xffffu); }
        else { u32x2 w; w.x = pk2(o[0], o[1]); w.y = pk2(o[2], o[3]); *(u32x2*)(gout + (nt * 16 + row) * 64 + mt * 16 + quad * 4) = w; }
    }
}
__device__ __forceinline__ void rwkv_chunk_prep(const Ctx& F, const RwP2& P) {
    LASQ float* CUM = (LASQ float*)(F.lds + RW_CUM); LASQ bf16* At = (LASQ bf16*)(F.lds + RW_AT); LASQ bf16* Rt = (LASQ bf16*)(F.lds + RW_RT); LASQ bf16* Bt = (LASQ bf16*)(F.lds + RW_BT); LASQ bf16* Kt = (LASQ bf16*)(F.lds + RW_KT);
    LASQ bf16* Bh = (LASQ bf16*)(F.lds + RW_BH); LASQ bf16* Kh = (LASQ bf16*)(F.lds + RW_KH); LASQ bf16* Vt = (LASQ bf16*)(F.lds + RW_VT); LASQ float* M1 = (LASQ float*)(F.lds + RW_M1); LASQ float* M2 = (LASQ float*)(F.lds + RW_M2);
    LASQ bf16* M3 = (LASQ bf16*)(F.lds + RW_M3); LASQ bf16* M4 = (LASQ bf16*)(F.lds + RW_M4); LASQ bf16* TA = (LASQ bf16*)(F.lds + RW_CUM); LASQ bf16* TM2 = (LASQ bf16*)(F.lds + RW_TM2); LASQ bf16* CY = (LASQ bf16*)(F.lds + RW_M1); LASQ float* XA = (LASQ float*)(F.lds + RW_BT);
    const int ri = F.tid >> 3, kg = F.tid & 7, k0 = kg * 8, row = F.lane & 15, quad = F.lane >> 4;
    u32x4 raw[5];
    if (F.bid < 64 * RWN) { const int seq = F.bid / RWN, ch = F.bid % RWN, b = seq >> 5, d = (seq >> 4) & 1, h = seq & 15, c0 = h * 64 + k0; const bf16* WA = d ? P.WA1 : P.WA0;
        const size_t m = (size_t)b * T + scan_t(d, ch * RWC + ri);
        raw[0] = *(const u32x4*)(P.Rr + m * 1024 + c0); raw[1] = *(const u32x4*)(P.Rk + m * 1024 + c0); raw[2] = *(const u32x4*)(P.Rv + m * 1024 + c0);
        raw[3] = *(const u32x4*)(WA + m * 2048 + c0); raw[4] = *(const u32x4*)(WA + m * 2048 + 1024 + c0); }
    for (int item = F.bid; item < 64 * RWN; item += F.G) {
        const int seq = item / RWN, ch = item % RWN, b = seq >> 5, d = (seq >> 4) & 1, h = seq & 15, c0 = h * 64 + k0;
        bf16* YD = d ? P.YD1 : P.YD0;
        float rr[8], kd[8], bv[8], av[8], vv[8], lw[8];
        { float kr[8], wl[8], al[8];
          unpack8(raw[0], rr); unpack8(raw[1], kr); unpack8(raw[2], vv); unpack8(raw[3], wl); unpack8(raw[4], al);
          { const int itn = (item + F.G < 64 * RWN) ? item + F.G : item;
            const int seqn = itn / RWN, chn = itn % RWN, bn = seqn >> 5, dn = (seqn >> 4) & 1, hn = seqn & 15, cn = hn * 64 + k0; const bf16* WAn = dn ? P.WA1 : P.WA0;
            const size_t mn = (size_t)bn * T + scan_t(dn, chn * RWC + ri);
            raw[0] = *(const u32x4*)(P.Rr + mn * 1024 + cn); raw[1] = *(const u32x4*)(P.Rk + mn * 1024 + cn); raw[2] = *(const u32x4*)(P.Rv + mn * 1024 + cn);
            raw[3] = *(const u32x4*)(WAn + mn * 2048 + cn); raw[4] = *(const u32x4*)(WAn + mn * 2048 + 1024 + cn); }
          float ckk[8], ca0[8], cka[8], cw0[8];
#pragma unroll
          for (int q = 0; q < 2; ++q) { const f32x4 t0 = *(const f32x4*)(P.kkw + c0 + 4 * q), t1 = *(const f32x4*)(P.a0 + d * 1024 + c0 + 4 * q), t2 = *(const f32x4*)(P.kaw + c0 + 4 * q), t3 = *(const f32x4*)(P.w0 + d * 1024 + c0 + 4 * q);
#pragma unroll
              for (int e = 0; e < 4; ++e) { ckk[4 * q + e] = t0[e]; ca0[4 * q + e] = t1[e]; cka[4 * q + e] = t2[e]; cw0[4 * q + e] = t3[e]; } }
          float ss = 0.f, kn[8];
#pragma unroll
          for (int e = 0; e < 8; ++e) { kn[e] = kr[e] * ckk[e]; ss += kn[e] * kn[e]; }
          ss += __shfl_xor(ss, 1); ss += __shfl_xor(ss, 2); ss += __shfl_xor(ss, 4);
          const float inv = __builtin_amdgcn_rsqf(fmaxf(ss, 1e-24f));
#pragma unroll
          for (int e = 0; e < 8; ++e) { const float kk = kn[e] * inv; const float ag = sigm(ca0[e] + al[e]);
              kd[e] = kr[e] * (1.f + (ag - 1.f) * cka[e]); bv[e] = kk * ag; av[e] = -kk;
              lw[e] = -0.6065306597126334f * sigm(cw0[e] + wl[e]); }
          *(LASQ f32x4*)(CUM + ri * CLD + k0) = (f32x4){lw[0], lw[1], lw[2], lw[3]}; *(LASQ f32x4*)(CUM + ri * CLD + k0 + 4) = (f32x4){lw[4], lw[5], lw[6], lw[7]}; }
        LDS_BARRIER();
        if (F.tid < 64) { float tv[RWC];
#pragma unroll
            for (int i = 0; i < RWC; ++i) tv[i] = CUM[i * CLD + F.tid];
            float s = 0.f;
#pragma unroll
            for (int i = 0; i < RWC; ++i) { s += tv[i]; tv[i] = s; }
#pragma unroll
            for (int i = 0; i < RWC; ++i) CUM[i * CLD + F.tid] = tv[i]; }
        LDS_BARRIER();
        { float o1[8], o2[8], o3[8], o4[8], o5[8], o6[8];
#pragma unroll
          for (int e = 0; e < 8; ++e) { const float cm = CUM[ri * CLD + k0 + e], c63 = CUM[63 * CLD + k0 + e];
              const float ecx = __expf(cm - lw[e]), ec = __expf(cm), en = __expf(-cm), eh = __expf(c63 - cm);
              o1[e] = av[e] * ecx; o2[e] = rr[e] * ec; o3[e] = bv[e] * en; o4[e] = kd[e] * en; o5[e] = bv[e] * eh; o6[e] = kd[e] * eh;
              if (ri == 63) P.GAM[(size_t)item * 64 + k0 + e] = ec; }
          *(LASQ u32x4*)(At + ri * RLD + k0) = pack8(o1); *(LASQ u32x4*)(Rt + ri * RLD + k0) = pack8(o2); *(LASQ u32x4*)(Bt + ri * RLD + k0) = pack8(o3); *(LASQ u32x4*)(Kt + ri * RLD + k0) = pack8(o4);
          *(LASQ u32x4*)(Kh + ri * RLD + k0) = pack8(o6);
#pragma unroll
          for (int e = 0; e < 8; ++e) { Bh[(k0 + e) * RLD + ri] = (bf16)f2bf(o5[e]); Vt[(k0 + e) * RLD + ri] = (bf16)f2bf(vv[e]); } }
        LDS_BARRIER();
        { LASQ unsigned char* L = (LASQ unsigned char*)F.lds; const int q = F.wave >> 1, half = F.wave & 1;
          if (q == 0) rw1_scores<0>(L, half, row, quad); else if (q == 1) rw1_scores<1>(L, half, row, quad); else if (q == 2) rw1_scores<2>(L, half, row, quad); else rw1_scores<3>(L, half, row, quad); }
        LDS_BARRIER();
        { const int e0 = F.tid * 8, xi = e0 >> 6, xc = e0 & 63; float t8[8]; unpack8(*(const LASQ u32x4*)(At + xi * RLD + xc), t8);
          *(LASQ f32x4*)(XA + xi * 64 + xc) = (f32x4){t8[0], t8[1], t8[2], t8[3]}; *(LASQ f32x4*)(XA + xi * 64 + xc + 4) = (f32x4){t8[4], t8[5], t8[6], t8[7]}; }
        LDS_BARRIER();
#pragma unroll 1
        for (int r = 0; r < 4; ++r) {
            if (r > 0) { LASQ float* Xh = (F.wave < 4) ? XA : M2; const LASQ bf16* Xb = (F.wave < 4) ? TA : TM2; const int cb = (F.wave & 3) * 16;
                f32x4 acc = {0.f, 0.f, 0.f, 0.f};
                for (int ks = 0; ks < ((r + 1) >> 1); ++ks) { bf16x8v a; const LASQ float* mr = M1 + (16 * r + row) * 64 + ks * 32 + quad * 8;
                    const f32x4 m0 = *(const LASQ f32x4*)mr, m1v = *(const LASQ f32x4*)(mr + 4);
#pragma unroll
                    for (int e = 0; e < 8; ++e) { const int j = ks * 32 + quad * 8 + e; const float mv = (e < 4) ? m0[e & 3] : m1v[e & 3]; a[e] = (short)((j < 16 * r) ? f2bf(mv) : 0u); }
                    const int jb = ks * 32 + quad * 8; bf16x8v bb = lfrag8(Xb + (cb + row) * RLD + jb);
                    if (jb >= 16 * r) bb = (bf16x8v){0, 0, 0, 0, 0, 0, 0, 0};
                    acc = __builtin_amdgcn_mfma_f32_16x16x32_bf16(a, bb, acc, 0, 0, 0); }
#pragma unroll
                for (int jj = 0; jj < 4; ++jj) Xh[(16 * r + quad * 4 + jj) * 64 + cb + row] += acc[jj]; }
            LDS_BARRIER();
            if (F.tid < 128) { const int col = F.tid & 63; LASQ float* Xh = (F.tid < 64) ? XA : M2; LASQ bf16* dst = (F.tid < 64) ? TA : TM2;
                float x[16];
#pragma unroll
                for (int ii = 0; ii < 16; ++ii) x[ii] = Xh[(16 * r + ii) * 64 + col];
#pragma unroll
                for (int jj = 0; jj < 15; ++jj) {
#pragma unroll
                    for (int ii = jj + 1; ii < 16; ++ii) x[ii] += M1[(16 * r + ii) * 64 + 16 * r + jj] * x[jj]; }
                u32x4 w0, w1;
#pragma unroll
                for (int e = 0; e < 4; ++e) { w0[e] = pk2(x[2 * e], x[2 * e + 1]); w1[e] = pk2(x[8 + 2 * e], x[8 + 2 * e + 1]); }
                *(LASQ u32x4*)(dst + col * RLD + 16 * r) = w0; *(LASQ u32x4*)(dst + col * RLD + 16 * r + 8) = w1; }
            LDS_BARRIER();
        }
        { LASQ unsigned char* L = (LASQ unsigned char*)F.lds; const int q = F.wave >> 1, half = F.wave & 1;
          if (q == 0) rw1_products<0>(L, half, row, quad, P.RA + (size_t)item * 4096); else if (q == 1) rw1_products<1>(L, half, row, quad, nullptr);
          else if (q == 2) rw1_products<2>(L, half, row, quad, P.NT + (size_t)item * 4096); else rw1_products<3>(L, half, row, quad, P.WKT + (size_t)item * 4096); }
        LDS_BARRIER();
#pragma unroll
        for (int tt = 0; tt < 2; ++tt) { const int t = 2 * F.wave + tt, mt = t >> 2, nt = t & 3;
            f32x4 acc = {0.f, 0.f, 0.f, 0.f};
#pragma unroll
            for (int ks = 0; ks < 2; ++ks) acc = __builtin_amdgcn_mfma_f32_16x16x32_bf16(lfrag8(CY + (mt * 16 + row) * RLD + ks * 32 + quad * 8), lfrag8(Vt + (nt * 16 + row) * RLD + ks * 32 + quad * 8), acc, 0, 0, 0);
#pragma unroll
            for (int jj = 0; jj < 4; ++jj) { const size_t m = (size_t)b * T + scan_t(d, ch * RWC + mt * 16 + quad * 4 + jj); YD[m * 1024 + h * 64 + nt * 16 + row] = (bf16)f2bf(acc[jj]); } }
        LDS_BARRIER();
    }
}
constexpr int R2_RA = 0, R2_NT = 9216, R2_WK = 18432, R2_V = 27648, R2_Y = 30720, R2_G = 33792, R2_BUF = 34048, R2_SL = 2 * R2_BUF, VL2 = 24;
struct RwSet { u32x4 a, n, w, x; };
__device__ __forceinline__ void rw2_fetch(const Ctx& F, const RwP2& P, RwSet& o, int seq, int c, int b, int d, int h, int vq) {
    if (c >= RWN) c = RWN - 1;
    const size_t item = (size_t)seq * RWN + c; const bf16* YD = d ? P.YD1 : P.YD0;
    o.a = *(const u32x4*)(P.RA + item * 4096 + F.tid * 8); o.n = *(const u32x4*)(P.NT + item * 4096 + F.tid * 8); o.w = *(const u32x4*)(P.WKT + item * 4096 + F.tid * 8);
    o.x = (u32x4){0u, 0u, 0u, 0u};
    if (F.tid < 256) { const int j = (F.tid & 127) >> 1, hf = F.tid & 1; const size_t m = (size_t)b * T + scan_t(d, c * RWC + j);
        o.x = *(const u32x4*)((F.tid < 128 ? P.Rv : YD) + m * 1024 + h * 64 + vq * 16 + hf * 8); }
    else if (F.tid < 272) o.x = *(const u32x4*)(P.GAM + item * 64 + (F.tid - 256) * 4);
}
__device__ __forceinline__ void rw2_put(const Ctx& F, const RwSet& o, LASQ unsigned char* buf) {
    const int e0 = F.tid * 8, r = e0 >> 6, cc = e0 & 63;
    *(LASQ u32x4*)(buf + R2_RA + (r * RLD + cc) * 2) = o.a; *(LASQ u32x4*)(buf + R2_NT + (r * RLD + cc) * 2) = o.n; *(LASQ u32x4*)(buf + R2_WK + (r * RLD + cc) * 2) = o.w;
    if (F.tid < 256) { const int j = (F.tid & 127) >> 1, hf = F.tid & 1; *(LASQ u32x4*)(buf + (F.tid < 128 ? R2_V : R2_Y) + (j * VL2 + hf * 8) * 2) = o.x; }
    else if (F.tid < 272) *(LASQ u32x4*)(buf + R2_G + (F.tid - 256) * 16) = o.x;
}
__device__ __forceinline__ void rw2_state(const Ctx& F, const LASQ unsigned char* buf, f32x4 (&S)[4], int c) {
    const int row = F.lane & 15, quad = F.lane >> 4;
    const LASQ bf16* Sc = (const LASQ bf16*)(F.lds + R2_SL + (c & 1) * 2304); LASQ bf16* Sn = (LASQ bf16*)(F.lds + R2_SL + ((c + 1) & 1) * 2304);
    const LASQ bf16* NTl = (const LASQ bf16*)(buf + R2_NT); const LASQ bf16* WKl = (const LASQ bf16*)(buf + R2_WK); const LASQ bf16* Vl = (const LASQ bf16*)(buf + R2_V); const LASQ float* Gl = (const LASQ float*)(buf + R2_G);
    bf16x8v sf[2]; sf[0] = lfrag8(Sc + row * RLD + quad * 8); sf[1] = lfrag8(Sc + row * RLD + 32 + quad * 8);
    bf16x8v vf[2]; vf[0] = lgather8(Vl + (quad * 8) * VL2 + row, VL2); vf[1] = lgather8(Vl + (32 + quad * 8) * VL2 + row, VL2);
#pragma unroll
    for (int t = 0; t < 4; ++t) { f32x4 acc = S[t] * Gl[t * 16 + row];
        acc = __builtin_amdgcn_mfma_f32_16x16x32_bf16(sf[0], lfrag8(NTl + (t * 16 + row) * RLD + quad * 8), acc, 0, 0, 0); acc = __builtin_amdgcn_mfma_f32_16x16x32_bf16(sf[1], lfrag8(NTl + (t * 16 + row) * RLD + 32 + quad * 8), acc, 0, 0, 0);
        acc = __builtin_amdgcn_mfma_f32_16x16x32_bf16(vf[0], lfrag8(WKl + (t * 16 + row) * RLD + quad * 8), acc, 0, 0, 0); acc = __builtin_amdgcn_mfma_f32_16x16x32_bf16(vf[1], lfrag8(WKl + (t * 16 + row) * RLD + 32 + quad * 8), acc, 0, 0, 0);
        S[t] = acc; }
#pragma unroll
    for (int t = 0; t < 4; ++t) { u32x2 w; w.x = pk2(S[t][0], S[t][1]); w.y = pk2(S[t][2], S[t][3]);
        Sn[(quad * 4 + 0) * RLD + t * 16 + row] = (bf16)(w.x & 0xffffu); Sn[(quad * 4 + 1) * RLD + t * 16 + row] = (bf16)(w.x >> 16);
        Sn[(quad * 4 + 2) * RLD + t * 16 + row] = (bf16)(w.y & 0xffffu); Sn[(quad * 4 + 3) * RLD + t * 16 + row] = (bf16)(w.y >> 16); }
}
__device__ __forceinline__ void rw2_y(const Ctx& F, const RwP2& P, const LASQ unsigned char* buf, int c, int b, int d, int h, int vq) {
    const int row = F.lane & 15, quad = F.lane >> 4;
    const LASQ bf16* Sc = (const LASQ bf16*)(F.lds + R2_SL + (c & 1) * 2304); bf16* YD = d ? P.YD1 : P.YD0;
    const LASQ bf16* RAl = (const LASQ bf16*)(buf + R2_RA); const LASQ bf16* Yl = (const LASQ bf16*)(buf + R2_Y);
    bf16x8v sf[2]; sf[0] = lfrag8(Sc + row * RLD + quad * 8); sf[1] = lfrag8(Sc + row * RLD + 32 + quad * 8);
#pragma unroll
    for (int t = 0; t < 4; ++t) { f32x4 y = {0.f, 0.f, 0.f, 0.f};
        y = __builtin_amdgcn_mfma_f32_16x16x32_bf16(lfrag8(RAl + (t * 16 + row) * RLD + quad * 8), sf[0], y, 0, 0, 0); y = __builtin_amdgcn_mfma_f32_16x16x32_bf16(lfrag8(RAl + (t * 16 + row) * RLD + 32 + quad * 8), sf[1], y, 0, 0, 0);
#pragma unroll
        for (int jj = 0; jj < 4; ++jj) { const int i = t * 16 + quad * 4 + jj; const size_t m = (size_t)b * T + scan_t(d, c * RWC + i); YD[m * 1024 + h * 64 + vq * 16 + row] = (bf16)f2bf(y[jj] + bf2f(Yl[i * VL2 + row])); } }
}
__device__ __forceinline__ void rwkv_chunk_scan(const Ctx& F, const RwP2& P) {
    const int vb = (F.G % 8 == 0) ? (F.bid % 8) * (F.G / 8) + F.bid / 8 : F.bid;
    for (int it = vb; it < 256; it += F.G) {
        const int seq = it >> 2, vq = it & 3, b = seq >> 5, d = (seq >> 4) & 1, h = seq & 15;
        f32x4 S[4];
#pragma unroll
        for (int t = 0; t < 4; ++t) S[t] = (f32x4){0.f, 0.f, 0.f, 0.f};
        RwSet s0, s1, s2;
        rw2_fetch(F, P, s0, seq, 0, b, d, h, vq); rw2_fetch(F, P, s1, seq, 1, b, d, h, vq); rw2_fetch(F, P, s2, seq, 2, b, d, h, vq);
        LDS_BARRIER();
        rw2_put(F, s0, (LASQ unsigned char*)F.lds);
        for (int i = F.tid; i < 16 * RLD; i += 512) ((LASQ bf16*)(F.lds + R2_SL))[i] = 0;
        LDS_BARRIER();
        for (int c3 = 0; c3 < RWN; c3 += 6) {
#define RW2_BODY(cc, SN, SC) do { rw2_put(F, SN, (LASQ unsigned char*)F.lds + (((cc) + 1) & 1) * R2_BUF); rw2_fetch(F, P, SC, seq, (cc) + 3, b, d, h, vq); \
            if (F.wave == 0) rw2_state(F, (const LASQ unsigned char*)F.lds + ((cc) & 1) * R2_BUF, S, (cc)); else if (F.wave == 1) rw2_y(F, P, (const LASQ unsigned char*)F.lds + ((cc) & 1) * R2_BUF, (cc), b, d, h, vq); LDS_BARRIER(); } while (0)
            RW2_BODY(c3 + 0, s1, s0); RW2_BODY(c3 + 1, s2, s1); RW2_BODY(c3 + 2, s0, s2);
            RW2_BODY(c3 + 3, s1, s0); RW2_BODY(c3 + 4, s2, s1); RW2_BODY(c3 + 5, s0, s2);
#undef RW2_BODY
        }
    }
}
__device__ __forceinline__ void rwkv_post(const Ctx& F, const RwP2& P, const bf16* Gg, const float* rk, const float* lnw, const float* lnb, bf16* O) {
    for (int m = F.gw; m < M; m += F.NGW) {
#pragma unroll 1
        for (int hp = 0; hp < 2; ++hp) {
            const int c0 = hp * 512 + 8 * F.lane; const size_t i1 = (size_t)m * 1024 + c0;
            const u32x4 wy0 = *(const u32x4*)(P.YD0 + i1), wy1 = *(const u32x4*)(P.YD1 + i1), wr = *(const u32x4*)(P.Rr + i1), wk = *(const u32x4*)(P.Rk + i1), wv = *(const u32x4*)(P.Rv + i1);
            const u32x4 wa0 = *(const u32x4*)(P.WA0 + (size_t)m * 2048 + 1024 + c0), wa1 = *(const u32x4*)(P.WA1 + (size_t)m * 2048 + 1024 + c0), wg = *(const u32x4*)(Gg + i1);
            float cl[8], cb[8], ca0[8], ca1[8], cka[8], crk[8];
#pragma unroll
            for (int q = 0; q < 2; ++q) { const f32x4 t0 = *(const f32x4*)(lnw + c0 + 4 * q), t1 = *(const f32x4*)(lnb + c0 + 4 * q), t2 = *(const f32x4*)(P.a0 + c0 + 4 * q), t3 = *(const f32x4*)(P.a0 + 1024 + c0 + 4 * q),
                    t4 = *(const f32x4*)(P.kaw + c0 + 4 * q), t5 = *(const f32x4*)(rk + c0 + 4 * q);
#pragma unroll
                for (int e = 0; e < 4; ++e) { cl[4 * q + e] = t0[e]; cb[4 * q + e] = t1[e]; ca0[4 * q + e] = t2[e]; ca1[4 * q + e] = t3[e]; cka[4 * q + e] = t4[e]; crk[4 * q + e] = t5[e]; } }
            float y0[8], y1[8], r[8], k[8], v[8], a0v[8], a1v[8], g[8];
            unpack8(wy0, y0); unpack8(wy1, y1); unpack8(wr, r); unpack8(wk, k); unpack8(wv, v); unpack8(wa0, a0v); unpack8(wa1, a1v); unpack8(wg, g);
            float y[8], s1 = 0.f, dot = 0.f;
#pragma unroll
            for (int e = 0; e < 8; ++e) { y[e] = y0[e] + y1[e]; s1 += y[e];
                const float ag0 = sigm(ca0[e] + a0v[e]), ag1 = sigm(ca1[e] + a1v[e]);
                dot += r[e] * k[e] * (2.f + (ag0 + ag1 - 2.f) * cka[e]) * crk[e]; }
            s1 += __shfl_xor(s1, 1); s1 += __shfl_xor(s1, 2); s1 += __shfl_xor(s1, 4);
            dot += __shfl_xor(dot, 1); dot += __shfl_xor(dot, 2); dot += __shfl_xor(dot, 4);
            const float mean = s1 * (1.f / 64.f); float s2 = 0.f;
#pragma unroll
            for (int e = 0; e < 8; ++e) { y[e] -= mean; s2 += y[e] * y[e]; }
            s2 += __shfl_xor(s2, 1); s2 += __shfl_xor(s2, 2); s2 += __shfl_xor(s2, 4);
            const float rs = rsqrtf(s2 * (1.f / 64.f) + 64e-5f);
            float o[8];
#pragma unroll
            for (int e = 0; e < 8; ++e) o[e] = (y[e] * rs * cl[e] + cb[e] + dot * v[e]) * g[e];
            *(u32x4*)(O + (size_t)m * 2048 + c0) = pack8(o);
        }
    }
}

struct LruP { const bf16 *XBR, *GATE, *XS, *Z; const float *convw, *convb, *ba, *bx, *lam; float* CAR; bf16* Y; };
__device__ __forceinline__ int lru_row(int b, int s) { if (s < CTX) return b * T + s; const int p = s - CTX; return b * T + CTX + (p & 127) * 64 + (p >> 7); }
__device__ __forceinline__ void lru_conv(const Ctx& F, const LruP& P, bf16* XS) {
    for (int m = F.gw; m < M; m += F.NGW) {
        const int b = m / T, s = m % T; const int lo = (s < CTX) ? 0 : CTX, hi = (s < CTX) ? CTX : T;
#pragma unroll
        for (int q = 0; q < 4; ++q) {
            const int c0 = 8 * (F.lane + 64 * q);
            float y[8];
            { const f32x4 b0 = *(const f32x4*)(P.convb + c0), b1 = *(const f32x4*)(P.convb + c0 + 4); y[0] = b0[0]; y[1] = b0[1]; y[2] = b0[2]; y[3] = b0[3]; y[4] = b1[0]; y[5] = b1[1]; y[6] = b1[2]; y[7] = b1[3]; }
#pragma unroll
            for (int j = 0; j < 4; ++j) { const int sj = s + j - 2;
                if (sj >= lo && sj < hi) { const u32x4 x = *(const u32x4*)(P.XBR + (size_t)lru_row(b, sj) * 2048 + c0);
                    const f32x4 w0 = *(const f32x4*)(P.convw + j * 2048 + c0), w1 = *(const f32x4*)(P.convw + j * 2048 + c0 + 4);
                    y[0] += lo16(x[0]) * w0[0]; y[1] += hi16(x[0]) * w0[1]; y[2] += lo16(x[1]) * w0[2]; y[3] += hi16(x[1]) * w0[3];
                    y[4] += lo16(x[2]) * w1[0]; y[5] += hi16(x[2]) * w1[1]; y[6] += lo16(x[3]) * w1[2]; y[7] += hi16(x[3]) * w1[3]; } }
            u32x4 o; o.x = pk2(y[0], y[1]); o.y = pk2(y[2], y[3]); o.z = pk2(y[4], y[5]); o.w = pk2(y[6], y[7]);
            *(u32x4*)(XS + (size_t)m * 2048 + c0) = o;
        }
    }
}
struct LruRaw { unsigned lw, iw, xw; };
__device__ __forceinline__ LruRaw lru_ld(const bf16* zb, const bf16* xb, int i, int d) {
    LruRaw r; r.lw = *(const unsigned*)(zb + i * 128 + d * 8192); r.iw = *(const unsigned*)(zb + i * 128 + (2 + d) * 8192); r.xw = *(const unsigned*)(xb + i * 2048);
    return r;
}
__device__ __forceinline__ const bf16* lru_zbase(const LruP& P, int b, int cf, int c) { const int n = c >> 8, j = c & 255; return P.Z + (((size_t)(b * LNCH + cf) * 64 + n * 8 + (j >> 7)) * 32) * 128 + (j & 127); }
__device__ __forceinline__ void lru_cmp(const LruRaw& r, float (&a)[2], float (&u)[2]) {
    const float la[2] = {lo16(r.lw), hi16(r.lw)}, ig[2] = {lo16(r.iw), hi16(r.iw)}, xs[2] = {lo16(r.xw), hi16(r.xw)};
#pragma unroll
    for (int e = 0; e < 2; ++e) { a[e] = __expf(la[e]); const float x2 = 2.f * la[e];
        const float om = -x2 * (1.f + x2 * (0.5f + x2 * (0.16666667f + x2 * (0.041666668f + x2 * (0.0083333338f + x2 * 0.0013888889f)))));
        const float om2 = (x2 < -0.5f) ? (1.f - a[e] * a[e]) : om;
        u[e] = __builtin_amdgcn_sqrtf(fmaxf(om2, 0.f)) * ig[e] * xs[e]; }
}
__device__ __forceinline__ void lru_passA(const Ctx& F, const LruP& P) {
    for (int it = F.bid; it < NB * LNCH * 2; it += F.G) {
        const int hq = it & 1, bc = it >> 1, b = bc / LNCH, cf = bc % LNCH, c = hq * 1024 + 2 * F.tid;
        const bf16* zb = lru_zbase(P, b, cf, c); const bf16* xb = P.XS + ((size_t)b * T + cf * LCH) * 2048 + c;
#pragma unroll
        for (int d = 0; d < 2; ++d) {
            float A[2] = {1.f, 1.f}, U[2] = {0.f, 0.f};
#pragma unroll 1
            for (int i0 = 0; i0 < LCH; i0 += 16) {
                LruRaw rw[16];
#pragma unroll
                for (int i = 0; i < 16; ++i) rw[i] = lru_ld(zb, xb, d ? (LCH - 1 - i0 - i) : (i0 + i), d);
#pragma unroll
                for (int i = 0; i < 16; ++i) { float a[2], u[2]; lru_cmp(rw[i], a, u); U[0] = a[0] * U[0] + u[0]; A[0] *= a[0]; U[1] = a[1] * U[1] + u[1]; A[1] *= a[1]; }
            }
            *(f32x4*)(P.CAR + ((size_t)((b * 2 + d) * LNCH + cf) * 2048 + c) * 2) = (f32x4){A[0], U[0], A[1], U[1]};
        }
    }
}
__device__ __forceinline__ void lru_passB(const Ctx& F, const LruP& P) {
    const int nth = F.G * 512;
    for (int i = F.bid * 512 + F.tid; i < NB * 2 * 2048; i += nth) {
        const int c = i & 2047, d = (i >> 11) & 1, b = i >> 12;
        float h = 0.f;
        for (int k0 = 0; k0 < LNCH; k0 += 24) {
            float A[24], U[24]; float* cp[24];
#pragma unroll
            for (int j = 0; j < 24; ++j) { const int k = k0 + j, cf = d ? (k < 8 ? 7 - k : LNCH + 7 - k) : k;
                cp[j] = P.CAR + ((size_t)((b * 2 + d) * LNCH + cf) * 2048 + c) * 2; const float2 t = *(const float2*)cp[j]; A[j] = t.x; U[j] = t.y; }
#pragma unroll
            for (int j = 0; j < 24; ++j) { cp[j][1] = h; h = A[j] * h + U[j]; }
        }
    }
}
__device__ __forceinline__ void lru_passC(const Ctx& F, const LruP& P) {
    for (int it = F.bid; it < NB * LNCH * 2; it += F.G) {
        const int hq = it & 1, bc = it >> 1, b = bc / LNCH, cf = bc % LNCH, c = hq * 1024 + 2 * F.tid;
        const bf16* zb = lru_zbase(P, b, cf, c); const bf16* xb = P.XS + ((size_t)b * T + cf * LCH) * 2048 + c;
        LASQ f32x2v* hfl = (LASQ f32x2v*)F.lds + F.tid;
        { const f32x4 cr = *(const f32x4*)(P.CAR + ((size_t)((b * 2 + 0) * LNCH + cf) * 2048 + c) * 2);
          float h0 = cr[1], h1 = cr[3];
#pragma unroll
          for (int i0 = 0; i0 < LCH; i0 += 8) {
              LruRaw rw[8];
#pragma unroll
              for (int i = 0; i < 8; ++i) rw[i] = lru_ld(zb, xb, i0 + i, 0);
#pragma unroll
              for (int i = 0; i < 8; ++i) { float a[2], u[2]; lru_cmp(rw[i], a, u); h0 = a[0] * h0 + u[0]; h1 = a[1] * h1 + u[1]; hfl[(i0 + i) * 512] = (f32x2v){h0, h1}; }
              asm volatile("" ::: "memory"); } }
        { const f32x4 cr = *(const f32x4*)(P.CAR + ((size_t)((b * 2 + 1) * LNCH + cf) * 2048 + c) * 2);
          float h0 = cr[1], h1 = cr[3];
          const int s0 = cf * LCH;
#pragma unroll
          for (int i0 = 0; i0 < LCH; i0 += 8) {
              LruRaw rw[8]; unsigned gw[8];
#pragma unroll
              for (int i = 0; i < 8; ++i) { const int li = LCH - 1 - i0 - i; rw[i] = lru_ld(zb, xb, li, 1); gw[i] = *(const unsigned*)(P.GATE + (size_t)lru_row(b, s0 + li) * 2048 + c); }
#pragma unroll
              for (int i = 0; i < 8; ++i) { const int li = LCH - 1 - i0 - i; float a[2], u[2]; lru_cmp(rw[i], a, u); h0 = a[0] * h0 + u[0]; h1 = a[1] * h1 + u[1];
                  const f32x2v hv = hfl[li * 512];
                  *(unsigned*)(P.Y + (size_t)lru_row(b, s0 + li) * 2048 + c) = pk2((hv.x + h0) * gelu_tanh(lo16(gw[i])), (hv.y + h1) * gelu_tanh(hi16(gw[i]))); }
              asm volatile("" ::: "memory"); } }
    }
}

__device__ __forceinline__ void fill_wlora(const Ctx& F, const float* g2, const float* w2, const float* a2, bf16* WL) {
    const int nth = F.G * 512;
    for (int i = F.bid * 512 + F.tid; i < 5120 * 256; i += nth) {
        const int k = i & 255, n = i >> 8; float v = 0.f;
        if (n < 1024) v = g2[(size_t)k * 1024 + n];
        else { const int q = n - 1024, d = q >> 11, r2 = q & 2047;
            if (r2 < 1024) { if (k < 96) v = w2[((size_t)d * 96 + k) * 1024 + r2]; }
            else { if (k >= 96 && k < 192) v = a2[((size_t)d * 96 + (k - 96)) * 1024 + (r2 - 1024)]; } }
        WL[i] = (bf16)f2bf(v);
    }
}
__device__ __forceinline__ void zero_rows(const Ctx& F, bf16* p, size_t n16) {
    const size_t nth = (size_t)F.G * 512; const u32x4 z = {0u, 0u, 0u, 0u};
    for (size_t i = (size_t)F.bid * 512 + F.tid; i < n16; i += nth) ((u32x4*)p)[i] = z;
}

__global__ void __launch_bounds__(512, 2) mega_fwd(Args args) {
    extern __shared__ __attribute__((aligned(16))) unsigned char lds[];
    cg::grid_group grid = cg::this_grid();
    Ctx F; F.lds = lds; F.tid = threadIdx.x; F.lane = F.tid & 63; F.wave = __builtin_amdgcn_readfirstlane(F.tid >> 6);
    F.G = gridDim.x; F.bid = blockIdx.x; F.gw = F.bid * 8 + F.wave; F.NGW = F.G * 8;
    unsigned char* ws = args.ws; unsigned char* ob = (unsigned char*)args.out;
    const float* x = args.in[0]; const float* cvec = args.in[1]; const float* ctx = args.in[2]; const float* c_ctx = args.in[3];
    const float* mod_w = args.in[4]; const float* mod_b = args.in[5]; const float* norm1 = args.in[6]; const float* norm2 = args.in[7];
    const float* mlp_w1 = args.in[8]; const float* mlp_w2 = args.in[9]; const float* ab_w_in = args.in[10]; const float* ab_w_out = args.in[11];
    float* modv = (float*)(ws + WS_MODV); float* X = (float*)(ws + WS_X); bf16* H = (bf16*)(ws + WS_HR);
    bf16* Wab = (bf16*)(ws + WS_WAB); bf16* Wout = (bf16*)(ws + WS_WOUT); bf16* Wlora = (bf16*)(ws + WS_WLORA);
    bf16* PA = (bf16*)(ws + MN_PA); bf16* PB = (bf16*)(ws + MN_PB); bf16* O = (bf16*)(ws + MN_O);
    bf16* Gg = (bf16*)(ob + OT_GG); bf16* WA0 = (bf16*)(ob + OT_WA0); bf16* WA1 = (bf16*)(ws + WS_HR); bf16* LA = (bf16*)(ob + OT_LA);
    RwP2 RP; RP.Rr = (bf16*)(ws + MN_R); RP.Rk = (bf16*)(ws + MN_K); RP.Rv = (bf16*)(ws + MN_V); RP.WA0 = WA0; RP.WA1 = WA1;
    RP.w0 = args.in[13]; RP.a0 = args.in[15]; RP.kkw = args.in[18]; RP.kaw = args.in[19]; RP.RA = (bf16*)(ws + MN_RA); RP.NT = (bf16*)(ws + MN_NT); RP.WKT = (bf16*)(ws + MN_WKT);
    RP.GAM = (float*)(ws + WS_GAM); RP.YD0 = (bf16*)(ws + MN_YD0); RP.YD1 = (bf16*)(ws + MN_YD1);
    GlaP GP; GP.PB = PB; GP.gw2 = args.in[23]; GP.gb = args.in[24]; GP.KV = (bf16*)(ws + MN_KV); GP.GDP = (float*)(ws + WS_GDP);
    LruP LP; LP.XBR = (bf16*)(ob + OT_XBR); LP.GATE = (bf16*)(ws + MN_GATE); LP.XS = (bf16*)(ws + WS_HR); LP.Z = (bf16*)(ws + MN_Z);
    LP.convw = args.in[28]; LP.convb = args.in[29]; LP.ba = args.in[31]; LP.bx = args.in[33]; LP.lam = args.in[34]; LP.CAR = (float*)(ob + OT_CAR); LP.Y = (bf16*)(ob + OT_Y);
    PG8_LAS unsigned char* glds = (PG8_LAS unsigned char*)lds;
    const int lo = args.ph_lo, hi = args.ph_hi;
    volatile unsigned* xst = (volatile unsigned*)(lds + 147456 - 64);
    if (F.tid == 0) { xst[0] = 0u; xst[1] = 0u; }
    __syncthreads();
    XcdBarrier xbar = xcd_barrier_post((unsigned*)ws, xst);
#define IN(k) (lo <= (k) && (k) < hi)
#define SEAM(k) do { if (IN(k) && IN((k) + 1)) { if ((k) == 0) grid.sync(); else xcd_barrier(xbar); } } while (0)
#define GEMM(EPI, Aptr, lda_, Btptr, ldb_, nM_, nN_, K_, skip_, amode_, ...) do { pg8::Gemm g{(const bf16*)(Aptr), (const bf16*)(Btptr), 0, 0, (K_), (lda_), (ldb_)}; pg8::Sched S; S.init((nM_), (nN_), F.G, F.bid, (skip_), (amode_)); \
        pg8::EPI E{__VA_ARGS__}; pg8::gemm_phase<pg8::EPI, pg8::Sched, true, true>(glds, g, S, E); } while (0)

    if (IN(0)) {
        mod_gemv(F, cvec, c_ctx, mod_w, mod_b, modv);
        xpose(F, ab_w_in, 6816, D, ACOLS, Wab, D);
        xpose(F, ab_w_in + ACOLS, 6816, D, BCOLS, Wab + (size_t)PA_LD * D, D);
        xpose(F, ab_w_out, D, D, D, Wout, D);
        zero_rows(F, Wab + (size_t)ACOLS * D, (size_t)(PA_LD - ACOLS) * D / 8);
        zero_rows(F, Wab + (size_t)(PA_LD + BCOLS) * D, (size_t)(NAB - PA_LD - BCOLS) * D / 8);
        fill_wlora(F, args.in[17], args.in[14], args.in[16], Wlora);
        for (int i = F.bid * 512 + F.tid; i < 2 * D; i += F.G * 512) { const float l = args.in[34][i]; ((float*)(ws + WS_SPL))[i] = -8.f * ((-l) > 20.f ? (-l) : log1pf(__expf(-l))); }
    }
    SEAM(0);
    if (IN(1)) norm_mod(F, X, x, ctx, norm1, modv, 0, 1, H, 0);
    SEAM(1);
    if (IN(2)) GEMM(EpiBf16S, H, D, Wab, D, 66, 28, D, 0, 0, PA, PB, PB, PA_LD, PB_LD, PB_LD, 15, 1000, 0);
    SEAM(2);
    if (IN(3)) { gla_kv(F, GP); rwkv_mix(F, PA, args.in[12], (bf16*)RP.Rr, (bf16*)RP.Rk, (bf16*)RP.Rv, LA); }
    SEAM(3);
    if (IN(4)) { gla_carry(F, GP); GEMM(EpiBf16S, LA, 768, Wlora, 256, 66, 20, 256, 0, 1, Gg, WA0, WA1, 1024, 2048, 2048, 4, 12, 0); }
    SEAM(4);
    if (IN(5)) gla_out(F, GP, args.in[25], O);
    SEAM(5);
    if (IN(7)) rwkv_chunk_prep(F, RP);
    SEAM(7);
    if (IN(8)) rwkv_chunk_scan(F, RP);
    SEAM(8);
    if (IN(10)) rwkv_post(F, RP, Gg, args.in[20], args.in[21], args.in[22], O);
    SEAM(10);
    Ctx FI = F; FI.gw = (F.bid - 16) * 8 + F.wave; FI.NGW = (F.G - 16) * 8;
    if (IN(11)) { GEMM(EpiResid, O, D, Wout, D, 66, 8, D, 0, 0, X, x, ctx, modv, 2);
        if (F.bid >= 16) { xpose(FI, mlp_w1, FF, D, FF, (bf16*)(ws + MN_W1_0), D); xpose(FI, mlp_w2, D, FF, D, (bf16*)(ws + MN_W2_0), FF); } }
    SEAM(11);
    if (IN(12)) norm_mod(F, X, nullptr, nullptr, norm2, modv, 3, 4, H, 0);
    SEAM(12);
    if (IN(13)) GEMM(EpiBf16S, H, D, ws + MN_W1_0, D, 66, 32, D, 0, 0, (bf16*)(ws + MN_U0), nullptr, nullptr, FF, 0, 0, 1000, 1000, 1);
    SEAM(13);
    if (IN(14)) { GEMM(EpiResid, ws + MN_U0, FF, ws + MN_W2_0, FF, 66, 8, FF, 0, 0, X, nullptr, nullptr, modv, 5);
        if (F.bid >= 16) { xpose(FI, args.in[26], 2 * D, D, 2 * D, (bf16*)(ws + MN_WLIN), D); xpose(FI, args.in[27], D, D, D, (bf16*)(ws + MN_WLOUT), D);
            for (int q = 0; q < 32; ++q) { const int gq = q >> 3, n = q & 7, d = gq & 1; const float* src = (gq < 2 ? args.in[30] : args.in[32]) + (size_t)(d * 8 + n) * 65536;
                xpose(FI, src, 256, 256, 256, (bf16*)(ws + MN_WG) + (size_t)(n * 1024 + gq * 256) * 256, 256); }
            xpose(FI, mlp_w1 + (size_t)D * FF, FF, D, FF, (bf16*)(ws + MN_W1_1), D); xpose(FI, mlp_w2 + (size_t)D * FF, D, FF, D, (bf16*)(ws + MN_W2_1), FF); } }
    SEAM(14);
    const float* modv1 = modv + 3 * 12288;
    if (IN(15)) norm_mod(F, X, nullptr, nullptr, norm1 + D, modv1, 0, 1, H, 0);
    SEAM(15);
    if (IN(16)) GEMM(EpiBf16S, H, D, ws + MN_WLIN, D, 66, 16, D, 0, 0, (bf16*)LP.GATE, (bf16*)LP.XBR, (bf16*)LP.XBR, D, D, D, 8, 1000, 0);
    SEAM(16);
    if (IN(17)) lru_conv(F, LP, (bf16*)LP.XS);
    SEAM(17);
    if (IN(18)) GEMM(EpiLruGate, LP.XS, D, ws + MN_WG, 256, 66, 32, 256, 0, 2, (bf16*)LP.Z, LP.ba, LP.bx, (const float*)(ws + WS_SPL));
    SEAM(18);
    if (IN(19)) lru_passA(F, LP);
    SEAM(19);
    if (IN(20)) lru_passB(F, LP);
    SEAM(20);
    if (IN(21)) lru_passC(F, LP);
    SEAM(21);
    if (IN(22)) GEMM(EpiResid, LP.Y, D, ws + MN_WLOUT, D, 64, 8, D, 1, 0, X, nullptr, nullptr, modv1, 2);
    SEAM(22);
    if (IN(23)) norm_mod(F, X, nullptr, nullptr, norm2 + D, modv1, 3, 4, H, 1);
    SEAM(23);
    if (IN(24)) GEMM(EpiBf16S, H, D, ws + MN_W1_1, D, 64, 32, D, 1, 0, (bf16*)(ws + MN_U1), nullptr, nullptr, FF, 0, 0, 1000, 1000, 1);
    SEAM(24);
    if (IN(25)) GEMM(EpiResid, ws + MN_U1, FF, ws + MN_W2_1, FF, 64, 8, FF, 1, 0, X, nullptr, nullptr, modv1, 5);
    SEAM(25);
    if (IN(26)) final_norm(F, X, args.in[35], args.out);
}

#ifndef N_LAUNCH_PER_PHASE
#define N_LAUNCH_PER_PHASE 0
#endif
extern "C" void kernel_launch(void* const* d_in, const int* in_sizes, int n_in, void* d_out, int out_size, void* d_ws, size_t ws_size, hipStream_t stream) {
    static int grid = 0;
    if (grid == 0) {
        if (n_in != 36 || ws_size < WS_END) { fprintf(stderr, "kernel_launch: unexpected n_in %d / ws_size %zu\n", n_in, ws_size); grid = -1; return; }
        int dev = 0, cus = 0, per_cu = 0;
        hipGetDevice(&dev); hipDeviceGetAttribute(&cus, hipDeviceAttributeMultiprocessorCount, dev);
        hipFuncSetAttribute((const void*)mega_fwd, hipFuncAttributeMaxDynamicSharedMemorySize, LDS_BYTES);
        hipOccupancyMaxActiveBlocksPerMultiprocessor(&per_cu, (const void*)mega_fwd, 512, LDS_BYTES);
        if (per_cu < 1) per_cu = 1;
        (void)hipGetLastError();
        grid = cus * per_cu;
    }
    if (grid < 0) return;
    if (hipMemsetAsync(d_ws, 0, 16384, stream) != hipSuccess) { fprintf(stderr, "memset failed\n"); return; }
    Args a{};
    for (int i = 0; i < 36; ++i) a.in[i] = (const float*)d_in[i];
    a.out = (float*)d_out; a.ws = (unsigned char*)d_ws;
#if N_LAUNCH_PER_PHASE
    for (int p = 0; p < NPH; ++p) { a.ph_lo = p; a.ph_hi = p + 1; hipLaunchKernelGGL(mega_fwd, dim3(grid), dim3(512), LDS_BYTES, stream, a); }
#else
    a.ph_lo = 0; a.ph_hi = NPH;
    void* kargs[] = {&a};
    hipError_t e = hipLaunchCooperativeKernel((const void*)mega_fwd, dim3(grid), dim3(512), kargs, LDS_BYTES, stream);
    if (e != hipSuccess) fprintf(stderr, "cooperative launch failed: %s (grid %d)\n", hipGetErrorString(e), grid);
#endif
}
```

```cpp
#include <hip/hip_runtime.h>
#include <hip/hip_cooperative_groups.h>
#include <cstdio>
namespace cg = cooperative_groups;

namespace pg8 {
#define PG8_LAS __attribute__((address_space(3)))
typedef unsigned short bf16_t;
typedef short bf16x8 __attribute__((ext_vector_type(8)));
typedef float f32x4 __attribute__((ext_vector_type(4)));
typedef unsigned u32x4 __attribute__((ext_vector_type(4)));
constexpr int BM = 256, BK = 64, HALF = 128, HTB = HALF * BK * 2, STAGE_BYTES = 8 * HTB, NXCD = 8, WGM = 8;
__host__ __device__ __forceinline__ int lds_byte(int r, int c) { const int st = (r >> 4) * 2 + (c >> 5), rr = r & 15, cc = c & 31, ob = rr * 64 + cc * 2; return st * 1024 + (ob ^ (((ob >> 9) & 1) << 5)); }
__host__ __device__ __forceinline__ void stage_rc(int b, int& R, int& C) { const int st = b / 1024, sb = b % 1024, swz = sb ^ (((sb >> 9) & 1) << 5); R = (st >> 1) * 16 + swz / 64; C = (st & 1) * 32 + (swz % 64) / 2; }
__host__ __device__ __forceinline__ int perm32(int rho) { const int n = rho >> 4, i = rho & 15; return 8 * (i >> 2) + 4 * n + (i & 3); }
struct Unit { int pm, pn; };
struct Gemm { const bf16_t* A; const bf16_t* Bt; int M, N, K, lda, ldb; };
struct Sched {
    int nM, nN, nwg, G, c, skip, amode;
    __device__ void init(int nM_, int nN_, int G_, int c_, int skip_, int amode_) { nM = nM_; nN = nN_; nwg = nM * nN; G = G_; c = c_; skip = skip_; amode = amode_; }
    __device__ bool next(int i, Unit& u) const {
        const long L = (long)i * G + c; if (L >= nwg) return false;
        int wgid = (int)L; { const int q = nwg / NXCD, r = nwg % NXCD, xcd = wgid % NXCD, off = wgid / NXCD; wgid = (xcd < r ? xcd * (q + 1) : r * (q + 1) + (xcd - r) * q) + off; }
        const int nig = WGM * nN, gid = wgid / nig, fm = gid * WGM, gsz = (nM - fm) < WGM ? (nM - fm) : WGM;
        int pm = fm + ((wgid % nig) % gsz); u.pn = (wgid % nig) / gsz;
        if (skip) pm = pm + pm / 32 + 1;
        u.pm = pm; return true;
    }
    __device__ __forceinline__ size_t a_off(const Unit& u) const {
        if (amode == 1) return (size_t)(u.pn < 4 ? 0 : (u.pn < 12 ? 256 : 512)) * 2;
        if (amode == 2) return (size_t)((u.pn >> 2) * 256) * 2;
        return 0;
    }
    __device__ __forceinline__ void a_ready(const Unit&) const {}
    __device__ __forceinline__ void done(const Unit&) const {}
};
__device__ __forceinline__ unsigned cvt_pk_bf16(float lo, float hi) { unsigned r; asm volatile("v_cvt_pk_bf16_f32 %0, %1, %2" : "=v"(r) : "v"(lo), "v"(hi)); return r; }

struct EpiBf16S {
    static constexpr bool PERM = true, AFTER_DRAIN = false;
    bf16_t* O0; bf16_t* O1; bf16_t* O2; int ld0, ld1, ld2, t1, t2, act;
    __device__ __forceinline__ void operator()(const f32x4 (&acc)[2][2][4][2], const Unit& u, int wr, int wc, int fr, int fq) const {
        const int row0 = u.pm * BM + wr * 64 + fr;
        bf16_t* base; int ldc, colt;
        if (u.pn < t1) { base = O0; ldc = ld0; colt = u.pn * BM; } else if (u.pn < t2) { base = O1; ldc = ld1; colt = (u.pn - t1) * BM; } else { base = O2; ldc = ld2; colt = (u.pn - t2) * BM; }
        const int col0 = colt + wc * 32 + 8 * fq;
#pragma unroll
        for (int ai = 0; ai < 2; ++ai)
#pragma unroll
            for (int m = 0; m < 4; ++m) { bf16_t* rowp = base + (size_t)(row0 + ai * HALF + m * 16) * ldc + col0;
#pragma unroll
                for (int bj = 0; bj < 2; ++bj) { f32x4 v0 = acc[ai][bj][m][0], v1 = acc[ai][bj][m][1];
                    if (act == 1) {
#pragma unroll
                        for (int e = 0; e < 4; ++e) { float a = v0[e] > 0.f ? v0[e] : 0.f; v0[e] = a * a; float b = v1[e] > 0.f ? v1[e] : 0.f; v1[e] = b * b; } }
                    u32x4 w; w.x = cvt_pk_bf16(v0[0], v0[1]); w.y = cvt_pk_bf16(v0[2], v0[3]); w.z = cvt_pk_bf16(v1[0], v1[1]); w.w = cvt_pk_bf16(v1[2], v1[3]);
                    *(u32x4*)(rowp + bj * HALF) = w; } }
    }
};
struct EpiResid {
    static constexpr bool PERM = false, AFTER_DRAIN = false;
    float* X; const float* xin; const float* cin; const float* modv; int gidx;
    __device__ __forceinline__ void operator()(const f32x4 (&acc)[2][2][4][2], const Unit& u, int wr, int wc, int fr, int fq) const {
        const int b = u.pm / 33, tt = u.pm % 33, mi = (tt == 0) ? 2 : b;
        const int rl0 = wr * 64 + fr, col0 = u.pn * BM + wc * 32 + 4 * fq;
        const float* gp = modv + (size_t)(mi * 6 + gidx) * 2048 + col0;
        f32x4 gv[2][2];
#pragma unroll
        for (int bj = 0; bj < 2; ++bj)
#pragma unroll
            for (int n = 0; n < 2; ++n) gv[bj][n] = *(const f32x4*)(gp + bj * HALF + n * 16);
#pragma unroll
        for (int ai = 0; ai < 2; ++ai)
#pragma unroll
            for (int m = 0; m < 4; ++m) { const int rl = rl0 + ai * HALF + m * 16;
                float* xp = X + (size_t)(u.pm * BM + rl) * 2048 + col0;
                const float* bp = xp;
                if (xin) bp = (tt == 0) ? (cin + (size_t)(b * 256 + rl) * 2048 + col0) : (xin + (size_t)(b * 8192 + (tt - 1) * 256 + rl) * 2048 + col0);
#pragma unroll
                for (int bj = 0; bj < 2; ++bj)
#pragma unroll
                    for (int n = 0; n < 2; ++n) { const f32x4 bv = *(const f32x4*)(bp + bj * HALF + n * 16); *(f32x4*)(xp + bj * HALF + n * 16) = bv + gv[bj][n] * acc[ai][bj][m][n]; } }
    }
};
struct EpiLruGate {
    static constexpr bool PERM = true, AFTER_DRAIN = false;
    bf16_t* Z; const float* ba; const float* bx; const float* lam;
    __device__ __forceinline__ void operator()(const f32x4 (&acc)[2][2][4][2], const Unit& u, int wr, int wc, int fr, int fq) const {
        const int n = u.pn >> 2, gq = u.pn & 3, d = gq & 1; const bool isx = gq >= 2;
        const int row0 = u.pm * BM + wr * 64 + fr, ct0 = wc * 32 + 8 * fq;
        float bias[2][8], spl[2][8];
#pragma unroll
        for (int bj = 0; bj < 2; ++bj)
#pragma unroll
            for (int e = 0; e < 8; ++e) { const int c = d * 2048 + n * 256 + ct0 + bj * HALF + e; bias[bj][e] = isx ? bx[c] : ba[c];
                spl[bj][e] = isx ? 0.f : lam[c]; }
#pragma unroll
        for (int ai = 0; ai < 2; ++ai)
#pragma unroll
            for (int m = 0; m < 4; ++m) { const int rr = row0 + ai * HALF + m * 16;
                bf16_t* rowp = Z + ((size_t)((rr >> 5) * 64 + u.pn * 2) * 32 + (rr & 31)) * 128 + ct0;
#pragma unroll
                for (int bj = 0; bj < 2; ++bj) { float v[8];
#pragma unroll
                    for (int e = 0; e < 4; ++e) { v[e] = acc[ai][bj][m][0][e]; v[4 + e] = acc[ai][bj][m][1][e]; }
#pragma unroll
                    for (int e = 0; e < 8; ++e) { const float r = __builtin_amdgcn_rcpf(1.f + __expf(-(v[e] + bias[bj][e]))); v[e] = isx ? r : r * spl[bj][e]; }
                    u32x4 w; w.x = cvt_pk_bf16(v[0], v[1]); w.y = cvt_pk_bf16(v[2], v[3]); w.z = cvt_pk_bf16(v[4], v[5]); w.w = cvt_pk_bf16(v[6], v[7]);
                    *(u32x4*)(rowp + bj * 32 * 128) = w; } }
    }
};
template <class Epi, class Sched, bool ALIGN_EPI = false, bool SP2 = false>
__device__ __forceinline__ void gemm_phase(PG8_LAS unsigned char* lds, const Gemm g, const Sched& S, const Epi& E) {
    const int tid = threadIdx.x, wid = __builtin_amdgcn_readfirstlane(tid >> 6), lane = tid & 63, wr = wid >> 2, wc = wid & 3, fr = lane & 15, fq = lane >> 4;
    const int K = g.K, nt = K / BK;
    unsigned voffA[2], voffB[2];
#pragma unroll
    for (int i = 0; i < 2; ++i) { int R, C; stage_rc(tid * 16 + i * 8192, R, C); const int Rb = Epi::PERM ? ((R & ~31) + perm32(R & 31)) : R;
        voffA[i] = (unsigned)(R * g.lda + C) * 2u; voffB[i] = (unsigned)(Rb * g.ldb + C) * 2u; }
    const size_t kstep = (size_t)(BK * 2);
    const size_t hstepA = (size_t)HALF * g.lda * 2, hstepB = (size_t)HALF * g.ldb * 2;
    const size_t tstepA = 2 * hstepA, tstepB = 2 * hstepB;
    const unsigned ldsw = (unsigned)wid * 1024u;
    const int aoff = lds_byte(wr * 64 + fr, fq * 8), boff = lds_byte(wc * 32 + fr, fq * 8);
#define PG8_SA(b, h) (((b) * 2 + (h)) * HTB)
#define PG8_SB(b, h) ((4 + (b) * 2 + (h)) * HTB)
#define PG8_STAGE(bufoff, gbase, voff) do { _Pragma("unroll") for (int _i = 0; _i < 2; ++_i) \
        __builtin_amdgcn_global_load_lds((const unsigned*)((const char*)(gbase) + (voff)[_i]), (PG8_LAS unsigned*)(lds + (bufoff) + ldsw + _i * 8192), 16, 0, 0); } while (0)
#define PG8_LDA(dst, b, h) do { _Pragma("unroll") for (int m = 0; m < 4; ++m) _Pragma("unroll") for (int k = 0; k < 2; ++k) dst[m][k] = *(const PG8_LAS bf16x8*)(lds + PG8_SA(b, h) + aoff + m * 2048 + k * 1024); } while (0)
#define PG8_LDB(dst, b, h) do { _Pragma("unroll") for (int n = 0; n < 2; ++n) _Pragma("unroll") for (int k = 0; k < 2; ++k) dst[n][k] = *(const PG8_LAS bf16x8*)(lds + PG8_SB(b, h) + boff + n * 2048 + k * 1024); } while (0)
#define PG8_MMA(ai, bj, At, Bt) do { __builtin_amdgcn_s_setprio(1); _Pragma("unroll") for (int m = 0; m < 4; ++m) _Pragma("unroll") for (int n = 0; n < 2; ++n) _Pragma("unroll") for (int k = 0; k < 2; ++k) \
        acc[ai][bj][m][n] = __builtin_amdgcn_mfma_f32_16x16x32_bf16(Bt[n][k], At[m][k], acc[ai][bj][m][n], 0, 0, 0); __builtin_amdgcn_s_setprio(0); } while (0)
#define PG8_WAIT_V(n) asm volatile("s_waitcnt vmcnt(" #n ")" ::: "memory")
#define PG8_WAIT_L(n) asm volatile("s_waitcnt lgkmcnt(" #n ")" ::: "memory")
#define PG8_BAR __builtin_amdgcn_s_barrier()
#define PG8_SCHED __builtin_amdgcn_sched_barrier(0)
    Unit cur, nxt; int ui = 0;
    if (!S.next(0, cur)) return;
    f32x4 acc[2][2][4][2];
#pragma unroll
    for (int a = 0; a < 2; ++a)
#pragma unroll
        for (int b = 0; b < 2; ++b)
#pragma unroll
            for (int m = 0; m < 4; ++m)
#pragma unroll
                for (int n = 0; n < 2; ++n) acc[a][b][m][n] = (f32x4){0.f, 0.f, 0.f, 0.f};
    bf16x8 At[4][2], B0[2][2], B1[2][2];
    const char* cA = (const char*)g.A + (size_t)cur.pm * tstepA + S.a_off(cur); const char* cB = (const char*)g.Bt + (size_t)cur.pn * tstepB;
    S.a_ready(cur);
    if constexpr (SP2) {
        PG8_STAGE(PG8_SB(0, 0), cB, voffB); PG8_STAGE(PG8_SB(0, 1), cB + hstepB, voffB); PG8_STAGE(PG8_SA(0, 0), cA, voffA); PG8_STAGE(PG8_SA(0, 1), cA + hstepA, voffA);
        if (wr == 1) PG8_BAR;
        PG8_WAIT_V(2); PG8_BAR;
        PG8_STAGE(PG8_SB(1, 0), cB + kstep, voffB); PG8_STAGE(PG8_SA(1, 0), cA + kstep, voffA); PG8_STAGE(PG8_SB(1, 1), cB + hstepB + kstep, voffB);
        PG8_WAIT_V(6); PG8_BAR;
    } else {
        PG8_STAGE(PG8_SB(0, 0), cB, voffB); PG8_STAGE(PG8_SA(0, 0), cA, voffA); PG8_STAGE(PG8_SB(0, 1), cB + hstepB, voffB); PG8_STAGE(PG8_SA(0, 1), cA + hstepA, voffA);
        if (wr == 1) PG8_BAR;
        PG8_WAIT_V(4); PG8_BAR;
        PG8_STAGE(PG8_SB(1, 0), cB + kstep, voffB); PG8_STAGE(PG8_SA(1, 0), cA + kstep, voffA); PG8_STAGE(PG8_SB(1, 1), cB + hstepB + kstep, voffB);
        PG8_WAIT_V(6); PG8_BAR;
    }
    for (;;) {
        const bool has_next = S.next(ui + 1, nxt);
        const char* nA = has_next ? (const char*)g.A + (size_t)nxt.pm * tstepA + S.a_off(nxt) : cA; const char* nB = has_next ? (const char*)g.Bt + (size_t)nxt.pn * tstepB : cB;
        _Pragma("unroll 1") for (int t = 0; t < nt; t += 2) {
            const bool last = (t == nt - 2);
            const char* a1 = cA + (size_t)(t + 1) * kstep;
            const char* a2 = last ? nA : cA + (size_t)(t + 2) * kstep; const char* b2 = last ? nB : cB + (size_t)(t + 2) * kstep;
            const char* a3 = a2 + kstep; const char* b3 = b2 + kstep;
            if (last && has_next) S.a_ready(nxt);
            if constexpr (SP2) {
            PG8_LDB(B0, 0, 0); PG8_LDB(B1, 0, 1); PG8_SCHED; PG8_LDA(At, 0, 0); PG8_STAGE(PG8_SA(1, 1), a1 + hstepA, voffA);
            PG8_WAIT_V(8); PG8_WAIT_L(0); PG8_BAR; PG8_MMA(0, 0, At, B0); PG8_MMA(0, 1, At, B1); PG8_BAR; PG8_SCHED;
            PG8_LDA(At, 0, 1); PG8_STAGE(PG8_SB(0, 0), b2, voffB); PG8_STAGE(PG8_SB(0, 1), b2 + hstepB, voffB); PG8_STAGE(PG8_SA(0, 0), a2, voffA);
            PG8_WAIT_V(8); PG8_WAIT_L(0); PG8_BAR; PG8_MMA(1, 0, At, B0); PG8_MMA(1, 1, At, B1); PG8_BAR; PG8_SCHED;
            PG8_LDB(B0, 1, 0); PG8_LDB(B1, 1, 1); PG8_SCHED; PG8_LDA(At, 1, 0); PG8_STAGE(PG8_SA(0, 1), a2 + hstepA, voffA);
            PG8_WAIT_V(8); PG8_WAIT_L(0); PG8_BAR; PG8_MMA(0, 0, At, B0); PG8_MMA(0, 1, At, B1); PG8_BAR; PG8_SCHED;
            PG8_LDA(At, 1, 1); PG8_STAGE(PG8_SB(1, 0), b3, voffB); PG8_STAGE(PG8_SB(1, 1), b3 + hstepB, voffB); PG8_STAGE(PG8_SA(1, 0), a3, voffA);
            PG8_WAIT_V(8); PG8_WAIT_L(0); PG8_BAR; PG8_MMA(1, 0, At, B0); PG8_MMA(1, 1, At, B1); PG8_BAR; PG8_SCHED;
            } else {
            PG8_LDB(B0, 0, 0); PG8_SCHED; PG8_LDA(At, 0, 0); PG8_STAGE(PG8_SA(1, 1), a1 + hstepA, voffA);
            PG8_WAIT_L(8); PG8_BAR; PG8_WAIT_L(0); PG8_MMA(0, 0, At, B0); PG8_BAR; PG8_SCHED;
            PG8_LDB(B1, 0, 1); PG8_STAGE(PG8_SB(0, 0), b2, voffB);
            PG8_BAR; PG8_WAIT_L(0); PG8_MMA(0, 1, At, B1); PG8_BAR;
            PG8_LDA(At, 0, 1); PG8_STAGE(PG8_SA(0, 0), a2, voffA);
            PG8_BAR; PG8_WAIT_L(0); PG8_MMA(1, 0, At, B0); PG8_BAR; PG8_SCHED;
            PG8_STAGE(PG8_SB(0, 1), b2 + hstepB, voffB);
            PG8_WAIT_V(6); PG8_BAR; PG8_MMA(1, 1, At, B1); PG8_BAR;
            PG8_LDB(B0, 1, 0); PG8_SCHED; PG8_LDA(At, 1, 0); PG8_STAGE(PG8_SA(0, 1), a2 + hstepA, voffA);
            PG8_WAIT_L(8); PG8_BAR; PG8_WAIT_L(0); PG8_MMA(0, 0, At, B0); PG8_BAR; PG8_SCHED;
            PG8_LDB(B1, 1, 1); PG8_STAGE(PG8_SB(1, 0), b3, voffB);
            PG8_BAR; PG8_WAIT_L(0); PG8_MMA(0, 1, At, B1); PG8_BAR;
            PG8_LDA(At, 1, 1); PG8_STAGE(PG8_SA(1, 0), a3, voffA);
            PG8_BAR; PG8_WAIT_L(0); PG8_MMA(1, 0, At, B0); PG8_BAR; PG8_SCHED;
            PG8_STAGE(PG8_SB(1, 1), b3 + hstepB, voffB);
            PG8_WAIT_V(6); PG8_BAR; PG8_MMA(1, 1, At, B1); PG8_BAR;
            }
        }
        if constexpr (ALIGN_EPI) { if (wr == 0) PG8_BAR; }
        if constexpr (!Epi::AFTER_DRAIN) { E(acc, cur, wr, wc, fr, fq); S.done(cur); }
        if (!has_next) break;
#pragma unroll
        for (int a = 0; a < 2; ++a)
#pragma unroll
            for (int b = 0; b < 2; ++b)
#pragma unroll
                for (int m = 0; m < 4; ++m)
#pragma unroll
                    for (int n = 0; n < 2; ++n) acc[a][b][m][n] = (f32x4){0.f, 0.f, 0.f, 0.f};
        cur = nxt; cA = nA; cB = nB; ++ui;
        if constexpr (ALIGN_EPI) { if (wr == 1) PG8_BAR; }
    }
    PG8_WAIT_V(0);
    if constexpr (!ALIGN_EPI) { if (wr == 0) PG8_BAR; }
    PG8_BAR;
    if constexpr (Epi::AFTER_DRAIN) { E.fused(acc, cur, wr, wc, fr, fq, lds, wid, lane); S.done(cur); }
#undef PG8_SA
#undef PG8_SB
#undef PG8_STAGE
#undef PG8_LDA
#undef PG8_LDB
#undef PG8_MMA
#undef PG8_WAIT_V
#undef PG8_WAIT_L
#undef PG8_BAR
#undef PG8_SCHED
}
}

typedef unsigned short bf16;
#define LASQ __attribute__((address_space(3)))
typedef float f32x4 __attribute__((ext_vector_type(4)));
typedef unsigned u32x4 __attribute__((ext_vector_type(4)));
typedef unsigned u32x2 __attribute__((ext_vector_type(2)));
constexpr int D = 2048, NB = 2, SEQ = 8192, CTX = 256, T = SEQ + CTX, M = NB * T, FF = 8192;
constexpr int ACOLS = 3712, BCOLS = 3104, PA_LD = 3840, PB_LD = 3328, NAB = 7168;
constexpr size_t MiB = 1u << 20;
constexpr size_t WS_MODV = 1 * MiB, WS_GDP = 2 * MiB;
constexpr size_t WS_WAB = 8 * MiB, WS_WOUT = 36 * MiB, WS_WLORA = 44 * MiB;
constexpr size_t WS_X = 48 * MiB, WS_HR = 180 * MiB, WS_MAIN = 246 * MiB, WS_END = 768 * MiB;
constexpr size_t MN_PA = WS_MAIN + 0 * MiB, MN_PB = WS_MAIN + 124 * MiB, MN_KV = WS_MAIN + 232 * MiB;
constexpr size_t MN_R = WS_MAIN + 364 * MiB, MN_V = WS_MAIN + 397 * MiB, MN_K = WS_MAIN + 430 * MiB;
constexpr size_t MN_O = WS_MAIN + 0 * MiB, MN_YD0 = WS_MAIN + 66 * MiB, MN_YD1 = WS_MAIN + 463 * MiB, MN_RA = WS_MAIN + 124 * MiB, MN_NT = WS_MAIN + 190 * MiB, MN_WKT = WS_MAIN + 256 * MiB;
constexpr size_t WS_GAM = 4 * MiB, WS_SPL = 7 * MiB;
constexpr size_t MN_W1_0 = WS_MAIN + 124 * MiB, MN_W2_0 = WS_MAIN + 156 * MiB, MN_U0 = WS_MAIN + 188 * MiB;
constexpr size_t MN_WLIN = WS_MAIN + 0 * MiB, MN_WLOUT = WS_MAIN + 16 * MiB, MN_WG = WS_MAIN + 24 * MiB, MN_W1_1 = WS_MAIN + 28 * MiB, MN_W2_1 = WS_MAIN + 60 * MiB;
constexpr size_t MN_GATE = WS_MAIN + 92 * MiB, MN_Z = WS_MAIN + 158 * MiB, MN_U1 = WS_MAIN + 158 * MiB;
constexpr size_t OT_GG = 0 * MiB, OT_WA0 = 33 * MiB, OT_LA = 99 * MiB, OT_XBR = 0 * MiB, OT_CAR = 66 * MiB, OT_Y = 0 * MiB;
constexpr int LDS_BYTES = 147456;
constexpr int NPH = 27;
constexpr int RCH = 132, RNCH = 64;
constexpr int LCH = 32, LNCH = T / LCH;

struct Args { const float* in[36]; float* out; unsigned char* ws; int ph_lo, ph_hi; };

__device__ __forceinline__ float bf2f(bf16 u) { return __builtin_bit_cast(float, (unsigned)u << 16); }

typedef float f32x2v __attribute__((ext_vector_type(2)));
typedef __bf16 bf16x2v __attribute__((ext_vector_type(2)));
__device__ __forceinline__ unsigned pk2(float lo, float hi) { const f32x2v v = {lo, hi}; const bf16x2v b = __builtin_convertvector(v, bf16x2v); return __builtin_bit_cast(unsigned, b); }
__device__ __forceinline__ unsigned f2bf(float f) { return pk2(f, 0.f) & 0xffffu; }
__device__ __forceinline__ float lo16(unsigned w) { return __builtin_bit_cast(float, w << 16); }
__device__ __forceinline__ float hi16(unsigned w) { return __builtin_bit_cast(float, w & 0xffff0000u); }
__device__ __forceinline__ float sigm(float x) { return __builtin_amdgcn_rcpf(1.f + __expf(-x)); }
__device__ __forceinline__ float softplus_(float x) { return x > 20.f ? x : log1pf(__expf(x)); }
__device__ __forceinline__ float silu_(float x) { return x * sigm(x); }
__device__ __forceinline__ float gelu_tanh(float x) { const float u = 0.7978845608028654f * (x + 0.044715f * x * x * x); return x * sigm(2.f * u); }
__device__ __forceinline__ float tanh_(float x) { return 2.f * sigm(2.f * x) - 1.f; }
__device__ __forceinline__ float wave_sum(float v) {
#pragma unroll
    for (int o = 1; o < 64; o <<= 1) v += __shfl_xor(v, o);
    return v;
}
#define LDS_BARRIER() do { asm volatile("s_waitcnt lgkmcnt(0)" ::: "memory"); __builtin_amdgcn_s_barrier(); asm volatile("" ::: "memory"); } while (0)
#define WAVE_LDS_SYNC() do { asm volatile("s_waitcnt lgkmcnt(0)" ::: "memory"); __builtin_amdgcn_wave_barrier(); } while (0)

#define XB_TMO      128
#define XB_XCNT(j)  (256  + 64 * (j))
#define XB_XSUB(j)  (1280 + 64 * (j))
#define XB_XGEN(j)  (2304 + 64 * (j))
#define XB_TOP      3328
#define XB_TOPGEN   3392
#define XCD_BAR_WORDS 3456
#define XB_SPIN_CAP (1u << 18)

__device__ __forceinline__ unsigned xb_ld(unsigned* p)              { return __hip_atomic_load(p, __ATOMIC_RELAXED, __HIP_MEMORY_SCOPE_AGENT); }
__device__ __forceinline__ unsigned xb_add(unsigned* p, unsigned v) { return __hip_atomic_fetch_add(p, v, __ATOMIC_RELAXED, __HIP_MEMORY_SCOPE_AGENT); }
__device__ __forceinline__ unsigned xb_xcc_id() { return (unsigned)__builtin_amdgcn_s_getreg((3 << 11) | 20) & 0xFu; }
#define XB_SPIN(cond, bar) do { unsigned _sp = 0; while (cond) { __builtin_amdgcn_s_sleep(1); \
    if ((++_sp & 255u) == 0u) { if (xb_ld(&(bar)[XB_TMO])) break; if (_sp > XB_SPIN_CAP) { atomicAdd(&(bar)[XB_TMO], 1u); break; } } } } while (0)

struct XcdBarrier {
    unsigned* bar; unsigned x;
    volatile unsigned* st;
};

__device__ __forceinline__ XcdBarrier xcd_barrier_post(unsigned* bar, volatile unsigned* st) {
    XcdBarrier b; b.bar = bar; b.x = xb_xcc_id(); b.st = st;
    if (threadIdx.x == 0) (void)xb_add(&bar[XB_XCNT(b.x)], 1u);
    return b;
}
__device__ __forceinline__ void xcd_barrier_complete(unsigned* bar, unsigned x, unsigned& nloc, unsigned& nx) {
    const unsigned G = gridDim.x * gridDim.y * gridDim.z;
    unsigned sum, cnt, mine, sp = 0u;
    for (;;) {
        sum = 0u; cnt = 0u; mine = 0u;
#pragma unroll
        for (unsigned j = 0; j < 16; ++j) { const unsigned c = xb_ld(&bar[XB_XCNT(j)]); sum += c; cnt += (c > 0u) ? 1u : 0u; mine = (j == x) ? c : mine; }
        if (sum == G) break;
        __builtin_amdgcn_s_sleep(1);
        if ((++sp & 255u) == 0u) { if (xb_ld(&bar[XB_TMO])) break; if (sp > XB_SPIN_CAP) { atomicAdd(&bar[XB_TMO], 1u); break; } }
    }
    nloc = mine > 0u ? mine : 1u; nx = cnt > 0u ? cnt : 1u;
}

__device__ __forceinline__ void xcd_barrier(const XcdBarrier& b) {
    asm volatile("s_waitcnt vmcnt(0)" ::: "memory");
    __syncthreads();
    if (threadIdx.x == 0) {
        unsigned* bar = b.bar;
        __builtin_amdgcn_s_waitcnt(0);
        unsigned nloc = b.st[0], nx = b.st[1];
        if (nloc == 0u) { xcd_barrier_complete(bar, b.x, nloc, nx); b.st[0] = nloc; b.st[1] = nx; }
        const unsigned old = xb_add(&bar[XB_XSUB(b.x)], 1u);
        const unsigned gen = old / nloc;
        if (old + 1u == (gen + 1u) * nloc) {
            __builtin_amdgcn_fence(__ATOMIC_RELEASE, "agent");
            asm volatile("s_waitcnt vmcnt(0)" ::: "memory");
            const unsigned og = xb_add(&bar[XB_TOP], 1u);
            const unsigned tg = og / nx;
            if (og + 1u == (tg + 1u) * nx) xb_add(&bar[XB_TOPGEN], 1u);
            else XB_SPIN(xb_ld(&bar[XB_TOPGEN]) == tg, bar);
            __builtin_amdgcn_fence(__ATOMIC_ACQUIRE, "agent");
            xb_add(&bar[XB_XGEN(b.x)], 1u);
            asm volatile("s_waitcnt vmcnt(0)" ::: "memory");
        } else {
            XB_SPIN(xb_ld(&bar[XB_XGEN(b.x)]) == gen, bar);
            __builtin_amdgcn_fence(__ATOMIC_ACQUIRE, "agent");
            asm volatile("s_waitcnt vmcnt(0)" ::: "memory");
        }
    }
    __syncthreads();
}


struct Ctx { unsigned char* lds; int tid, lane, wave, G, bid, gw, NGW; };

__device__ __forceinline__ int scan_t(int d, int sp) { return d ? (sp < CTX ? (CTX - 1 - sp) : (T + CTX - 1 - sp)) : sp; }

__device__ __forceinline__ void xpose_item(const float* W, int ldw, bf16* WT, int ldt, int nblk, float* scr, int item, int lane) {
    const int kb = item / nblk, nb = item % nblk, k0 = 64 * kb, n0 = 32 * nb;
    f32x4 t[8];
#pragma unroll
    for (int i = 0; i < 8; ++i) t[i] = *(const f32x4*)(W + (size_t)(k0 + 8 * i + (lane >> 3)) * ldw + n0 + 4 * (lane & 7));
#pragma unroll
    for (int i = 0; i < 8; ++i) { float* s = scr + (8 * i + (lane >> 3)) * 33 + 4 * (lane & 7); s[0] = t[i][0]; s[1] = t[i][1]; s[2] = t[i][2]; s[3] = t[i][3]; }
    WAVE_LDS_SYNC();
    const int c = lane & 7;
#pragma unroll
    for (int j = 0; j < 4; ++j) { const int n = (lane >> 3) + 8 * j; const float* s = scr + (8 * c) * 33 + n;
        u32x4 o; o.x = pk2(s[0 * 33], s[1 * 33]); o.y = pk2(s[2 * 33], s[3 * 33]); o.z = pk2(s[4 * 33], s[5 * 33]); o.w = pk2(s[6 * 33], s[7 * 33]);
        *(u32x4*)(WT + (size_t)(n0 + n) * ldt + k0 + 8 * c) = o; }
    WAVE_LDS_SYNC();
}
__device__ __forceinline__ void xpose(const Ctx& F, const float* W, int ldw, int K, int N, bf16* WT, int ldt) {
    float* scr = (float*)(F.lds + F.wave * 16384);
    const int nblk = N / 32, nit = (K / 64) * nblk;
    for (int it = F.gw; it < nit; it += F.NGW) xpose_item(W, ldw, WT, ldt, nblk, scr, it, F.lane);
}

__device__ __forceinline__ void mod_gemv(const Ctx& F, const float* c, const float* c_ctx, const float* mod_w, const float* mod_b, float* modv) {
    float* sv = (float*)F.lds;
    float* red = (float*)(F.lds + 32768);
    for (int i = F.tid; i < 3 * D; i += 512) { const int r = i / D, k = i % D; const float x = (r < 2) ? c[r * D + k] : c_ctx[k]; sv[i] = silu_(x); }
    __syncthreads();
    const int l4 = F.tid & 7, kg = F.tid >> 3;
    for (int it = F.bid; it < 2 * 384; it += F.G) {
        const int layer = it / 384, n0 = (it % 384) * 32;
        const float* Wp = mod_w + (size_t)layer * D * 12288 + n0 + 4 * l4;
        f32x4 a0 = {0.f, 0.f, 0.f, 0.f}, a1 = a0, a2 = a0;
#pragma unroll 8
        for (int kk = 0; kk < 32; ++kk) { const int k = kg * 32 + kk; const f32x4 w = *(const f32x4*)(Wp + (size_t)k * 12288);
            a0 += w * sv[k]; a1 += w * sv[D + k]; a2 += w * sv[2 * D + k]; }
        *(f32x4*)(red + (kg * 3 + 0) * 32 + 4 * l4) = a0; *(f32x4*)(red + (kg * 3 + 1) * 32 + 4 * l4) = a1; *(f32x4*)(red + (kg * 3 + 2) * 32 + 4 * l4) = a2;
        __syncthreads();
        if (F.tid < 96) { const int r = F.tid / 32, n = F.tid % 32; float s = mod_b[layer * 12288 + n0 + n];
            for (int g = 0; g < 64; ++g) s += red[(g * 3 + r) * 32 + n];
            modv[(size_t)(layer * 3 + r) * 12288 + n0 + n] = s; }
        __syncthreads();
    }
}

__device__ __forceinline__ void norm_mod(const Ctx& F, const float* X, const float* xin, const float* cin, const float* g, const float* modv, int ishift, int iscale, bf16* H, int latent_only) {
    for (int m = F.gw; m < M; m += F.NGW) {
        const int b = m / T, t = m % T;
        if (latent_only && t < CTX) continue;
        const float* xr = xin ? (t < CTX ? cin + (size_t)(b * CTX + t) * D : xin + (size_t)(b * SEQ + t - CTX) * D) : X + (size_t)m * D;
        const int mi = (t < CTX) ? 2 : b;
        const float* sh = modv + (size_t)(mi * 6 + ishift) * D; const float* sc = modv + (size_t)(mi * 6 + iscale) * D;
        f32x4 v[8]; float s = 0.f;
#pragma unroll
        for (int j = 0; j < 8; ++j) { v[j] = *(const f32x4*)(xr + 4 * F.lane + 256 * j); s += (v[j].x * v[j].x + v[j].y * v[j].y) + (v[j].z * v[j].z + v[j].w * v[j].w); }
        const float rstd = rsqrtf(wave_sum(s) * (1.f / D) + 1e-6f);
#pragma unroll
        for (int j = 0; j < 8; ++j) { const int col = 4 * F.lane + 256 * j;
            const f32x4 gg = *(const f32x4*)(g + col), s1 = *(const f32x4*)(sc + col), s0 = *(const f32x4*)(sh + col);
            const f32x4 y = v[j] * rstd * gg * (s1 + 1.f) + s0;
            u32x2 o; o.x = pk2(y.x, y.y); o.y = pk2(y.z, y.w);
            *(u32x2*)(H + (size_t)m * D + col) = o; }
    }
}
__device__ __forceinline__ void final_norm(const Ctx& F, const float* X, const float* g, float* out) {
    for (int r = F.gw; r < NB * SEQ; r += F.NGW) {
        const int b = r / SEQ, tl = r % SEQ; const float* xr = X + (size_t)(b * T + CTX + tl) * D;
        f32x4 v[8]; float s = 0.f;
#pragma unroll
        for (int j = 0; j < 8; ++j) { v[j] = *(const f32x4*)(xr + 4 * F.lane + 256 * j); s += (v[j].x * v[j].x + v[j].y * v[j].y) + (v[j].z * v[j].z + v[j].w * v[j].w); }
        const float rstd = rsqrtf(wave_sum(s) * (1.f / D) + 1e-6f);
#pragma unroll
        for (int j = 0; j < 8; ++j) { const int col = 4 * F.lane + 256 * j; *(f32x4*)(out + (size_t)r * D + col) = v[j] * rstd * *(const f32x4*)(g + col); }
    }
}

__device__ __forceinline__ void rwkv_mix(const Ctx& F, const bf16* PA, const float* mu, bf16* Rr, bf16* Rk, bf16* Rv, bf16* LA) {
    for (int m = F.gw; m < M; m += F.NGW) {
        const int t = m % T;
        const bool hp = (t != 0) && (t != CTX), hn = (t != CTX - 1) && (t != T - 1);
        const bf16* p0 = PA + (size_t)m * PA_LD;
        u32x4 cur[8], pv[8], nv[8];
#pragma unroll
        for (int q = 0; q < 8; ++q) { const int g8 = F.lane + 64 * q; const int c0 = (g8 < ACOLS / 8 ? g8 : 0) * 8;
            cur[q] = *(const u32x4*)(p0 + c0); pv[q] = (u32x4){0u, 0u, 0u, 0u}; nv[q] = (u32x4){0u, 0u, 0u, 0u};
            if (hp) pv[q] = *(const u32x4*)(p0 - PA_LD + c0);
            if (hn) nv[q] = *(const u32x4*)(p0 + PA_LD + c0); }
#pragma unroll
        for (int q = 0; q < 8; ++q) { const int g8 = F.lane + 64 * q; if (g8 >= ACOLS / 8) continue;
            const int c0 = g8 * 8;
            float y[8];
#pragma unroll
            for (int e = 0; e < 4; ++e) {
                const float pl = lo16(cur[q][e]), ph = hi16(cur[q][e]);
                y[2 * e] = pl + mu[c0 + 2 * e] * (lo16(pv[q][e]) - pl) + mu[ACOLS + c0 + 2 * e] * (lo16(nv[q][e]) - pl);
                y[2 * e + 1] = ph + mu[c0 + 2 * e + 1] * (hi16(pv[q][e]) - ph) + mu[ACOLS + c0 + 2 * e + 1] * (hi16(nv[q][e]) - ph);
            }
            bf16* dst;
            if (c0 < 1024) dst = Rr + (size_t)m * 1024 + c0;
            else if (c0 < 2048) dst = Rk + (size_t)m * 1024 + (c0 - 1024);
            else if (c0 < 3072) dst = Rv + (size_t)m * 1024 + (c0 - 2048);
            else if (c0 < 3328) { dst = LA + (size_t)m * 768 + (c0 - 3072);
#pragma unroll
                for (int e = 0; e < 8; ++e) y[e] = sigm(y[e]); }
            else if (c0 < 3520) { const int qq = c0 - 3328, d = qq / 96; dst = LA + (size_t)m * 768 + 256 + d * 256 + (qq - d * 96);
#pragma unroll
                for (int e = 0; e < 8; ++e) y[e] = tanh_(y[e]); }
            else { const int qq = c0 - 3520, d = qq / 96; dst = LA + (size_t)m * 768 + 256 + d * 256 + 96 + (qq - d * 96); }
            u32x4 o; o.x = pk2(y[0], y[1]); o.y = pk2(y[2], y[3]); o.z = pk2(y[4], y[5]); o.w = pk2(y[6], y[7]);
            *(u32x4*)dst = o;
        }
        if (F.lane < 16) { const int d = F.lane >> 3, j = F.lane & 7; const u32x4 z = {0u, 0u, 0u, 0u}; *(u32x4*)(LA + (size_t)m * 768 + 256 + d * 256 + 192 + 8 * j) = z; }
    }
}

typedef short bf16x8v __attribute__((ext_vector_type(8)));
constexpr int GC = 64, GNC = T / GC;
constexpr int GL_CUM = 0, GL_QI = 33792, GL_KI = 51200, GL_VV = 68608, GL_PP = 102400, GL_RSQ = 111616, GL_GW = 113664, GL_GD = 121856;
constexpr int GCLD = 132;
constexpr int QLD = 136, VLD = 264, PLD = 72;
struct GlaP { const bf16* PB; const float *gw2, *gb; bf16* KV; float* GDP; };
__device__ __forceinline__ int gla_chunk_of(int d, int pc) { return d ? (pc < 4 ? 3 - pc : 135 - pc) : pc; }
__device__ __forceinline__ void gla_gates(const Ctx& F, const GlaP& P, int b, int h, int d, int pos0) {
    LASQ float* cum = (LASQ float*)(F.lds + GL_CUM); LASQ float* gwl = (LASQ float*)(F.lds + GL_GW); LASQ float* gdl = (LASQ float*)(F.lds + GL_GD);
    const int p = F.tid >> 3, kg = F.tid & 7;
    { const int e = F.tid >> 5, q = F.tid & 31; *(LASQ f32x4*)(gwl + e * 128 + 4 * q) = *(const f32x4*)(P.gw2 + (size_t)(d * 16 + e) * 512 + h * 128 + 4 * q); }
    if (kg < 4) { const bf16* row = P.PB + (size_t)(b * T + pos0 + p) * PB_LD + 3072 + d * 16 + 4 * kg; const u32x2 g = *(const u32x2*)row;
        *(LASQ f32x4*)(gdl + p * 16 + 4 * kg) = (f32x4){lo16(g.x), hi16(g.x), lo16(g.y), hi16(g.y)}; }
    LDS_BARRIER();
    f32x4 z[4];
    const float* gbp = P.gb + d * 512 + h * 128 + kg * 16;
#pragma unroll
    for (int q = 0; q < 4; ++q) z[q] = *(const f32x4*)(gbp + 4 * q);
#pragma unroll 2
    for (int e = 0; e < 16; ++e) { const float g = gdl[p * 16 + e]; const LASQ float* gwp = gwl + e * 128 + kg * 16;
#pragma unroll
        for (int q = 0; q < 4; ++q) z[q] += *(const f32x4*)(gwp + 4 * q) * g; }
#pragma unroll
    for (int q = 0; q < 4; ++q) { f32x4 t;
#pragma unroll
        for (int e = 0; e < 4; ++e) { const float nz = -z[q][e]; t[e] = -((nz > 20.f) ? nz : __logf(1.f + __expf(nz))) * (1.f / 16.f); }
        *(LASQ f32x4*)(cum + p * GCLD + kg * 16 + 4 * q) = t; }
    LDS_BARRIER();
    if (F.tid < 128) { float tv[GC];
#pragma unroll
        for (int pp = 0; pp < GC; ++pp) tv[pp] = cum[pp * GCLD + F.tid];
        float s = 0.f;
        if (d == 0) {
#pragma unroll
            for (int pp = 0; pp < GC; ++pp) { s += tv[pp]; tv[pp] = s; } }
        else {
#pragma unroll
            for (int pp = GC - 1; pp >= 0; --pp) { s += tv[pp]; tv[pp] = s; } }
#pragma unroll
        for (int pp = 0; pp < GC; ++pp) cum[pp * GCLD + F.tid] = tv[pp]; }
    LDS_BARRIER();
}
__device__ __forceinline__ bf16x8v lfrag8(const LASQ bf16* p) { return *(const LASQ bf16x8v*)p; }
__device__ __forceinline__ bf16x8v lgather8(const LASQ bf16* p, int stride) { bf16x8v r;
#pragma unroll
    for (int e = 0; e < 8; ++e) r[e] = (short)p[e * stride];
    return r; }
__device__ __forceinline__ void gla_load_v(const Ctx& F, const GlaP& P, int b, int h, int pos0) {
    const int p = F.tid >> 3, kg = F.tid & 7; LASQ bf16* VV = (LASQ bf16*)(F.lds + GL_VV);
    const bf16* row = P.PB + (size_t)(b * T + pos0 + p) * PB_LD + 1024 + h * 256 + kg * 32;
#pragma unroll
    for (int q = 0; q < 4; ++q) *(LASQ u32x4*)(VV + p * VLD + kg * 32 + 8 * q) = *(const u32x4*)(row + 8 * q);
}
__device__ __forceinline__ void gla_kv(const Ctx& F, const GlaP& P) {
    LASQ float* cum = (LASQ float*)(F.lds + GL_CUM); LASQ bf16* KI = (LASQ bf16*)(F.lds + GL_KI); const LASQ bf16* VV = (const LASQ bf16*)(F.lds + GL_VV);
    const int p = F.tid >> 3, kg = F.tid & 7, row = F.lane & 15, quad = F.lane >> 4;
    for (int it = F.bid; it < 16 * GNC; it += F.G) {
        const int seq = it / GNC, c = it % GNC, b = seq >> 3, d = (seq >> 2) & 1, h = seq & 3;
        const int pc = gla_chunk_of(d, c), pos0 = pc * GC;
        gla_load_v(F, P, b, h, pos0);
        gla_gates(F, P, b, h, d, pos0);
        const int tp = d ? 0 : (GC - 1);
        { const bf16* rowp = P.PB + (size_t)(b * T + pos0 + p) * PB_LD + 512 + h * 128 + kg * 16;
          const u32x4 k0 = *(const u32x4*)rowp, k1 = *(const u32x4*)(rowp + 8);
          float kv[16];
#pragma unroll
          for (int e = 0; e < 4; ++e) { kv[2 * e] = lo16(k0[e]); kv[2 * e + 1] = hi16(k0[e]); kv[8 + 2 * e] = lo16(k1[e]); kv[8 + 2 * e + 1] = hi16(k1[e]); }
#pragma unroll
          for (int e = 0; e < 16; ++e) kv[e] *= __expf(cum[tp * GCLD + kg * 16 + e] - cum[p * GCLD + kg * 16 + e]);
          u32x4 o0, o1;
#pragma unroll
          for (int e = 0; e < 4; ++e) { o0[e] = pk2(kv[2 * e], kv[2 * e + 1]); o1[e] = pk2(kv[8 + 2 * e], kv[8 + 2 * e + 1]); }
          *(LASQ u32x4*)(KI + p * QLD + kg * 16) = o0; *(LASQ u32x4*)(KI + p * QLD + kg * 16 + 8) = o1; }
        if (F.tid < 128) P.GDP[(size_t)it * 128 + F.tid] = __expf(cum[tp * GCLD + F.tid]);
        LDS_BARRIER();
        const int v0 = 32 * F.wave;
        f32x4 acc[2][8];
#pragma unroll
        for (int mt = 0; mt < 2; ++mt)
#pragma unroll
            for (int nt = 0; nt < 8; ++nt) acc[mt][nt] = (f32x4){0.f, 0.f, 0.f, 0.f};
#pragma unroll
        for (int ks = 0; ks < 2; ++ks) {
            bf16x8v a[2];
#pragma unroll
            for (int mt = 0; mt < 2; ++mt) a[mt] = lgather8(VV + (ks * 32 + quad * 8) * VLD + v0 + mt * 16 + row, VLD);
#pragma unroll
            for (int nt = 0; nt < 8; ++nt) { const bf16x8v bb = lgather8(KI + (ks * 32 + quad * 8) * QLD + nt * 16 + row, QLD);
#pragma unroll
                for (int mt = 0; mt < 2; ++mt) acc[mt][nt] = __builtin_amdgcn_mfma_f32_16x16x32_bf16(a[mt], bb, acc[mt][nt], 0, 0, 0); }
        }
        bf16* kvp = P.KV + (size_t)it * 32768;
#pragma unroll
        for (int mt = 0; mt < 2; ++mt)
#pragma unroll
            for (int nt = 0; nt < 8; ++nt)
#pragma unroll
                for (int j = 0; j < 4; ++j) kvp[(size_t)(v0 + mt * 16 + quad * 4 + j) * 128 + nt * 16 + row] = (bf16)f2bf(acc[mt][nt][j]);
        LDS_BARRIER();
    }
}
__device__ __forceinline__ void gla_carry(const Ctx& F, const GlaP& P) {
    const int nth = F.G * 512;
    for (int i = F.bid * 512 + F.tid; i < 16 * 256 * 16; i += nth) {
        const int k8 = i & 15, v = (i >> 4) & 255, seq = i >> 12;
        float s[8];
#pragma unroll
        for (int e = 0; e < 8; ++e) s[e] = 0.f;
        for (int c0 = 0; c0 < GNC; c0 += 6) {
            u32x4 q[6]; f32x4 d0[6], d1[6];
#pragma unroll
            for (int j = 0; j < 6; ++j) { const size_t sc = (size_t)seq * GNC + c0 + j;
                q[j] = *(const u32x4*)(P.KV + (sc * 256 + v) * 128 + 8 * k8); d0[j] = *(const f32x4*)(P.GDP + sc * 128 + 8 * k8); d1[j] = *(const f32x4*)(P.GDP + sc * 128 + 8 * k8 + 4); }
#pragma unroll
            for (int j = 0; j < 6; ++j) { const size_t sc = (size_t)seq * GNC + c0 + j;
                u32x4 o;
#pragma unroll
                for (int e = 0; e < 4; ++e) o[e] = pk2(s[2 * e], s[2 * e + 1]);
                *(u32x4*)(P.KV + (sc * 256 + v) * 128 + 8 * k8) = o;
                const float dd[8] = {d0[j][0], d0[j][1], d0[j][2], d0[j][3], d1[j][0], d1[j][1], d1[j][2], d1[j][3]};
#pragma unroll
                for (int e = 0; e < 4; ++e) { s[2 * e] = s[2 * e] * dd[2 * e] + lo16(q[j][e]); s[2 * e + 1] = s[2 * e + 1] * dd[2 * e + 1] + hi16(q[j][e]); } }
        }
    }
}
__device__ __forceinline__ void gla_out(const Ctx& F, const GlaP& P, const float* gn, bf16* O) {
    LASQ float* cum = (LASQ float*)(F.lds + GL_CUM); LASQ bf16* QI = (LASQ bf16*)(F.lds + GL_QI); LASQ bf16* KI = (LASQ bf16*)(F.lds + GL_KI); const LASQ bf16* VV = (const LASQ bf16*)(F.lds + GL_VV);
    LASQ bf16* PP = (LASQ bf16*)(F.lds + GL_PP); LASQ float* RSQ = (LASQ float*)(F.lds + GL_RSQ);
    const int p = F.tid >> 3, kg = F.tid & 7, row = F.lane & 15, quad = F.lane >> 4, v0 = 32 * F.wave;
    for (int it = F.bid; it < NB * 4 * GNC; it += F.G) {
        const int pc = it % GNC, bh = it / GNC, b = bh >> 2, h = bh & 3, pos0 = pc * GC;
        gla_load_v(F, P, b, h, pos0);
        f32x4 acc[4][2];
#pragma unroll
        for (int mt = 0; mt < 4; ++mt) { acc[mt][0] = (f32x4){0.f, 0.f, 0.f, 0.f}; acc[mt][1] = (f32x4){0.f, 0.f, 0.f, 0.f}; }
#pragma unroll 1
        for (int d = 0; d < 2; ++d) {
            const int seq = (b * 2 + d) * 4 + h, c = gla_chunk_of(d, pc);
            const bf16* kvp = P.KV + ((size_t)seq * GNC + c) * 32768;
            gla_gates(F, P, b, h, d, pos0);
            bf16x8v kvf[4][2];
#pragma unroll
            for (int ks = 0; ks < 4; ++ks)
#pragma unroll
                for (int nt = 0; nt < 2; ++nt) kvf[ks][nt] = *(const bf16x8v*)(kvp + (size_t)(v0 + nt * 16 + row) * 128 + ks * 32 + quad * 8);
            { const bf16* rowp = P.PB + (size_t)(b * T + pos0 + p) * PB_LD + h * 128 + kg * 16;
              const u32x4 q0 = *(const u32x4*)rowp, q1 = *(const u32x4*)(rowp + 8), k0 = *(const u32x4*)(rowp + 512), k1 = *(const u32x4*)(rowp + 520);
              float qv[16], kv[16];
#pragma unroll
              for (int e = 0; e < 4; ++e) { qv[2 * e] = lo16(q0[e]); qv[2 * e + 1] = hi16(q0[e]); qv[8 + 2 * e] = lo16(q1[e]); qv[8 + 2 * e + 1] = hi16(q1[e]);
                  kv[2 * e] = lo16(k0[e]); kv[2 * e + 1] = hi16(k0[e]); kv[8 + 2 * e] = lo16(k1[e]); kv[8 + 2 * e + 1] = hi16(k1[e]); }
#pragma unroll
              for (int e = 0; e < 16; ++e) { const float cc = cum[p * GCLD + kg * 16 + e]; qv[e] *= 0.08838834764831845f * __expf(cc); kv[e] *= __expf(-cc); }
              u32x4 o0, o1, o2, o3;
#pragma unroll
              for (int e = 0; e < 4; ++e) { o0[e] = pk2(qv[2 * e], qv[2 * e + 1]); o1[e] = pk2(qv[8 + 2 * e], qv[8 + 2 * e + 1]); o2[e] = pk2(kv[2 * e], kv[2 * e + 1]); o3[e] = pk2(kv[8 + 2 * e], kv[8 + 2 * e + 1]); }
              *(LASQ u32x4*)(QI + p * QLD + kg * 16) = o0; *(LASQ u32x4*)(QI + p * QLD + kg * 16 + 8) = o1; *(LASQ u32x4*)(KI + p * QLD + kg * 16) = o2; *(LASQ u32x4*)(KI + p * QLD + kg * 16 + 8) = o3; }
            LDS_BARRIER();
#pragma unroll
            for (int tt = 0; tt < 2; ++tt) { const int t = 2 * F.wave + tt, itl = t >> 2, jt = t & 3;
                f32x4 sc = {0.f, 0.f, 0.f, 0.f};
                const bool live = d ? (jt >= itl) : (jt <= itl);
                if (live) {
#pragma unroll
                    for (int ks = 0; ks < 4; ++ks) { const bf16x8v a = lfrag8(QI + (itl * 16 + row) * QLD + ks * 32 + quad * 8), bb = lfrag8(KI + (jt * 16 + row) * QLD + ks * 32 + quad * 8);
                        sc = __builtin_amdgcn_mfma_f32_16x16x32_bf16(a, bb, sc, 0, 0, 0); } }
#pragma unroll
                for (int j = 0; j < 4; ++j) { const int ii = itl * 16 + quad * 4 + j, jj = jt * 16 + row; const bool keep = d ? (jj >= ii) : (jj <= ii);
                    PP[ii * PLD + jj] = (bf16)f2bf(keep ? sc[j] : 0.f); } }
            LDS_BARRIER();
#pragma unroll
            for (int ks = 0; ks < 2; ++ks) {
                bf16x8v bb[2];
#pragma unroll
                for (int nt = 0; nt < 2; ++nt) bb[nt] = lgather8(VV + (ks * 32 + quad * 8) * VLD + v0 + nt * 16 + row, VLD);
#pragma unroll
                for (int mt = 0; mt < 4; ++mt) { const bf16x8v a = lfrag8(PP + (mt * 16 + row) * PLD + ks * 32 + quad * 8);
                    acc[mt][0] = __builtin_amdgcn_mfma_f32_16x16x32_bf16(a, bb[0], acc[mt][0], 0, 0, 0); acc[mt][1] = __builtin_amdgcn_mfma_f32_16x16x32_bf16(a, bb[1], acc[mt][1], 0, 0, 0); }
            }
#pragma unroll
            for (int ks = 0; ks < 4; ++ks) {
#pragma unroll
                for (int mt = 0; mt < 4; ++mt) { const bf16x8v a = lfrag8(QI + (mt * 16 + row) * QLD + ks * 32 + quad * 8);
                    acc[mt][0] = __builtin_amdgcn_mfma_f32_16x16x32_bf16(a, kvf[ks][0], acc[mt][0], 0, 0, 0); acc[mt][1] = __builtin_amdgcn_mfma_f32_16x16x32_bf16(a, kvf[ks][1], acc[mt][1], 0, 0, 0); }
            }
            LDS_BARRIER();
        }
#pragma unroll
        for (int mt = 0; mt < 4; ++mt)
#pragma unroll
            for (int j = 0; j < 4; ++j) { float ss = acc[mt][0][j] * acc[mt][0][j] + acc[mt][1][j] * acc[mt][1][j];
                ss += __shfl_xor(ss, 1); ss += __shfl_xor(ss, 2); ss += __shfl_xor(ss, 4); ss += __shfl_xor(ss, 8);
                if (row == 0) RSQ[F.wave * 64 + mt * 16 + quad * 4 + j] = ss; }
        LDS_BARRIER();
        const bf16* gbase = P.PB + (size_t)(b * T + pos0 + quad * 4) * PB_LD + 2048 + h * 256 + v0 + row; bf16* obase = O + (size_t)(b * T + pos0 + quad * 4) * 2048 + 1024 + h * 256 + v0 + row;
        const float gnv[2] = {gn[v0 + row], gn[v0 + 16 + row]};
#pragma unroll
        for (int mt = 0; mt < 4; ++mt)
#pragma unroll
            for (int j = 0; j < 4; ++j) { const int pr = mt * 16 + quad * 4 + j; float ss = 0.f;
#pragma unroll
                for (int w = 0; w < 8; ++w) ss += RSQ[w * 64 + pr];
                const float rs = rsqrtf(ss * (1.f / 256.f) + 1e-6f);
#pragma unroll
                for (int nt = 0; nt < 2; ++nt) { const float g = bf2f(gbase[(mt * 16 + j) * PB_LD + nt * 16]);
                    obase[(mt * 16 + j) * 2048 + nt * 16] = (bf16)f2bf(acc[mt][nt][j] * rs * gnv[nt] * silu_(g)); } }
        LDS_BARRIER();
    }
}

constexpr int RWC = 64, RWN = T / RWC;
constexpr int RW_CUM = 0, RW_AT = 17408, RW_RT = 26624, RW_BT = 35840, RW_KT = 45056, RW_BH = 54272, RW_KH = 63488, RW_VT = 72704, RW_M1 = 81920, RW_M2 = 98304, RW_M3 = 114688, RW_M4 = 123904, RW_TM2 = 133120;
constexpr int CLD = 68;
constexpr int RLD = 72;
struct RwP2 { const bf16 *Rr, *Rk, *Rv, *WA0, *WA1; const float *w0, *a0, *kkw, *kaw; bf16 *RA, *NT, *WKT; float* GAM; bf16 *YD0, *YD1; };
__device__ __forceinline__ void unpack8(const u32x4 w, float (&o)[8]) {
#pragma unroll
    for (int e = 0; e < 4; ++e) { o[2 * e] = lo16(w[e]); o[2 * e + 1] = hi16(w[e]); } }
__device__ __forceinline__ u32x4 pack8(const float (&v)[8]) { u32x4 o;
#pragma unroll
    for (int e = 0; e < 4; ++e) o[e] = pk2(v[2 * e], v[2 * e + 1]);
    return o; }
template <int Q> __device__ __forceinline__ void rw1_scores(LASQ unsigned char* L, int half, int row, int quad) {
    const LASQ bf16* Am = (const LASQ bf16*)(L + ((Q < 2) ? RW_AT : RW_RT)) + row * RLD + quad * 8;
    const LASQ bf16* Bm = (const LASQ bf16*)(L + ((Q & 1) ? RW_KT : RW_BT)) + row * RLD + quad * 8;
    LASQ float* Mf = (LASQ float*)(L + (Q == 0 ? RW_M1 : RW_M2)) + (quad * 4) * 64 + row;
    LASQ bf16* Mb = (LASQ bf16*)(L + (Q == 2 ? RW_M3 : RW_M4)) + (quad * 4) * RLD + row;
#pragma unroll 2
    for (int tt = 0; tt < 8; ++tt) { const int t = half * 8 + tt, mt = t >> 2, nt = t & 3;
        f32x4 acc = {0.f, 0.f, 0.f, 0.f};
        if (nt <= mt) { const LASQ bf16* ap = Am + mt * 16 * RLD; const LASQ bf16* bp = Bm + nt * 16 * RLD;
            acc = __builtin_amdgcn_mfma_f32_16x16x32_bf16(lfrag8(ap), lfrag8(bp), acc, 0, 0, 0); acc = __builtin_amdgcn_mfma_f32_16x16x32_bf16(lfrag8(ap + 32), lfrag8(bp + 32), acc, 0, 0, 0); }
        const int di = mt * 16 + quad * 4 - (nt * 16 + row);
        if (Q < 2) { LASQ float* d = Mf + mt * 16 * 64 + nt * 16;
#pragma unroll
            for (int jj = 0; jj < 4; ++jj) d[jj * 64] = (di + jj > 0) ? acc[jj] : 0.f; }
        else { LASQ bf16* d = Mb + mt * 16 * RLD + nt * 16;
#pragma unroll
            for (int jj = 0; jj < 4; ++jj) d[jj * RLD] = (bf16)(pk2((di + jj >= 0) ? acc[jj] : 0.f, 0.f) & 0xffffu); }
    }
}
template <int Q> __device__ __forceinline__ void rw1_products(LASQ unsigned char* L, int half, int row, int quad, bf16* gout) {
    const LASQ bf16* M3 = (const LASQ bf16*)(L + RW_M3) + row * RLD + quad * 8;
    const LASQ bf16* TX = (const LASQ bf16*)(L + ((Q == 0 || Q == 2) ? RW_CUM : RW_TM2)) + row * RLD + quad * 8;
    const LASQ bf16* Bh = (const LASQ bf16*)(L + RW_BH) + row * RLD + quad * 8;
    const LASQ bf16* Ad = (const LASQ bf16*)(L + (Q == 0 ? RW_RT : (Q == 1 ? RW_M4 : RW_KH))) + (quad * 4) * RLD + row;
    LASQ bf16* CY = (LASQ bf16*)(L + RW_M1) + (quad * 4) * RLD + row;
#pragma unroll 2
    for (int tt = 0; tt < 8; ++tt) { const int t = half * 8 + tt, mt = t >> 2, nt = t & 3;
        f32x4 acc = {0.f, 0.f, 0.f, 0.f};
#pragma unroll
        for (int ks = 0; ks < 2; ++ks) { bf16x8v a, bb;
            if (Q < 2) { a = lfrag8(M3 + mt * 16 * RLD + ks * 32); bb = lfrag8(TX + nt * 16 * RLD + ks * 32); }
            else { a = lfrag8(TX + mt * 16 * RLD + ks * 32); bb = lfrag8(Bh + nt * 16 * RLD + ks * 32); }
            acc = __builtin_amdgcn_mfma_f32_16x16x32_bf16(a, bb, acc, 0, 0, 0); }
        float o[4];
        if (Q != 2) { const LASQ bf16* ad = Ad + mt * 16 * RLD + nt * 16;
#pragma unroll
            for (int jj = 0; jj < 4; ++jj) o[jj] = acc[jj] + bf2f(ad[jj * RLD]); }
        else {
#pragma unroll
            for (int jj = 0; jj < 4; ++jj) o[jj] = acc[jj]; }
        if (Q == 0) { bf16* g = gout + (mt * 16 + quad * 4) * 64 + nt * 16 + row;
#pragma unroll
            for (int jj = 0; jj < 4; ++jj) g[jj * 64] = (bf16)(pk2(o[jj], 0.f) & 0xffffu); }
        else if (Q == 1) { LASQ bf16* d = CY + mt * 16 * RLD + nt * 16;
#pragma unroll
            for (int jj = 0; jj < 4; ++jj) d[jj * RLD] = (bf16)(pk2(o[jj], 0.f) & 0xffffu); }
        else { u32x2 w; w.x = pk2(o[0], o[1]); w.y = pk2(o[2], o[3]); *(u32x2*)(gout + (nt * 16 + row) * 64 + mt * 16 + quad * 4) = w; }
    }
}
__device__ __forceinline__ void rwkv_chunk_prep(const Ctx& F, const RwP2& P) {
    LASQ float* CUM = (LASQ float*)(F.lds + RW_CUM); LASQ bf16* At = (LASQ bf16*)(F.lds + RW_AT); LASQ bf16* Rt = (LASQ bf16*)(F.lds + RW_RT); LASQ bf16* Bt = (LASQ bf16*)(F.lds + RW_BT); LASQ bf16* Kt = (LASQ bf16*)(F.lds + RW_KT);
    LASQ bf16* Bh = (LASQ bf16*)(F.lds + RW_BH); LASQ bf16* Kh = (LASQ bf16*)(F.lds + RW_KH); LASQ bf16* Vt = (LASQ bf16*)(F.lds + RW_VT); LASQ float* M1 = (LASQ float*)(F.lds + RW_M1); LASQ float* M2 = (LASQ float*)(F.lds + RW_M2);
    LASQ bf16* M3 = (LASQ bf16*)(F.lds + RW_M3); LASQ bf16* M4 = (LASQ bf16*)(F.lds + RW_M4); LASQ bf16* TA = (LASQ bf16*)(F.lds + RW_CUM); LASQ bf16* TM2 = (LASQ bf16*)(F.lds + RW_TM2); LASQ bf16* CY = (LASQ bf16*)(F.lds + RW_M1); LASQ float* XA = (LASQ float*)(F.lds + RW_BT);
    const int ri = F.tid >> 3, kg = F.tid & 7, k0 = kg * 8, row = F.lane & 15, quad = F.lane >> 4;
    u32x4 raw[5];
    if (F.bid < 64 * RWN) { const int seq = F.bid / RWN, ch = F.bid % RWN, b = seq >> 5, d = (seq >> 4) & 1, h = seq & 15, c0 = h * 64 + k0; const bf16* WA = d ? P.WA1 : P.WA0;
        const size_t m = (size_t)b * T + scan_t(d, ch * RWC + ri);
        raw[0] = *(const u32x4*)(P.Rr + m * 1024 + c0); raw[1] = *(const u32x4*)(P.Rk + m * 1024 + c0); raw[2] = *(const u32x4*)(P.Rv + m * 1024 + c0);
        raw[3] = *(const u32x4*)(WA + m * 2048 + c0); raw[4] = *(const u32x4*)(WA + m * 2048 + 1024 + c0); }
    for (int item = F.bid; item < 64 * RWN; item += F.G) {
        const int seq = item / RWN, ch = item % RWN, b = seq >> 5, d = (seq >> 4) & 1, h = seq & 15, c0 = h * 64 + k0;
        bf16* YD = d ? P.YD1 : P.YD0;
        float rr[8], kd[8], bv[8], av[8], vv[8], lw[8];
        { float kr[8], wl[8], al[8];
          unpack8(raw[0], rr); unpack8(raw[1], kr); unpack8(raw[2], vv); unpack8(raw[3], wl); unpack8(raw[4], al);
          { const int itn = (item + F.G < 64 * RWN) ? item + F.G : item;
            const int seqn = itn / RWN, chn = itn % RWN, bn = seqn >> 5, dn = (seqn >> 4) & 1, hn = seqn & 15, cn = hn * 64 + k0; const bf16* WAn = dn ? P.WA1 : P.WA0;
            const size_t mn = (size_t)bn * T + scan_t(dn, chn * RWC + ri);
            raw[0] = *(const u32x4*)(P.Rr + mn * 1024 + cn); raw[1] = *(const u32x4*)(P.Rk + mn * 1024 + cn); raw[2] = *(const u32x4*)(P.Rv + mn * 1024 + cn);
            raw[3] = *(const u32x4*)(WAn + mn * 2048 + cn); raw[4] = *(const u32x4*)(WAn + mn * 2048 + 1024 + cn); }
          float ckk[8], ca0[8], cka[8], cw0[8];
#pragma unroll
          for (int q = 0; q < 2; ++q) { const f32x4 t0 = *(const f32x4*)(P.kkw + c0 + 4 * q), t1 = *(const f32x4*)(P.a0 + d * 1024 + c0 + 4 * q), t2 = *(const f32x4*)(P.kaw + c0 + 4 * q), t3 = *(const f32x4*)(P.w0 + d * 1024 + c0 + 4 * q);
#pragma unroll
              for (int e = 0; e < 4; ++e) { ckk[4 * q + e] = t0[e]; ca0[4 * q + e] = t1[e]; cka[4 * q + e] = t2[e]; cw0[4 * q + e] = t3[e]; } }
          float ss = 0.f, kn[8];
#pragma unroll
          for (int e = 0; e < 8; ++e) { kn[e] = kr[e] * ckk[e]; ss += kn[e] * kn[e]; }
          ss += __shfl_xor(ss, 1); ss += __shfl_xor(ss, 2); ss += __shfl_xor(ss, 4);
          const float inv = __builtin_amdgcn_rsqf(fmaxf(ss, 1e-24f));
#pragma unroll
          for (int e = 0; e < 8; ++e) { const float kk = kn[e] * inv; const float ag = sigm(ca0[e] + al[e]);
              kd[e] = kr[e] * (1.f + (ag - 1.f) * cka[e]); bv[e] = kk * ag; av[e] = -kk;
              lw[e] = -0.6065306597126334f * sigm(cw0[e] + wl[e]); }
          *(LASQ f32x4*)(CUM + ri * CLD + k0) = (f32x4){lw[0], lw[1], lw[2], lw[3]}; *(LASQ f32x4*)(CUM + ri * CLD + k0 + 4) = (f32x4){lw[4], lw[5], lw[6], lw[7]}; }
        LDS_BARRIER();
        if (F.tid < 64) { float tv[RWC];
#pragma unroll
            for (int i = 0; i < RWC; ++i) tv[i] = CUM[i * CLD + F.tid];
            float s = 0.f;
#pragma unroll
            for (int i = 0; i < RWC; ++i) { s += tv[i]; tv[i] = s; }
#pragma unroll
            for (int i = 0; i < RWC; ++i) CUM[i * CLD + F.tid] = tv[i]; }
        LDS_BARRIER();
        { float o1[8], o2[8], o3[8], o4[8], o5[8], o6[8];
#pragma unroll
          for (int e = 0; e < 8; ++e) { const float cm = CUM[ri * CLD + k0 + e], c63 = CUM[63 * CLD + k0 + e];
              const float ecx = __expf(cm - lw[e]), ec = __expf(cm), en = __expf(-cm), eh = __expf(c63 - cm);
              o1[e] = av[e] * ecx; o2[e] = rr[e] * ec; o3[e] = bv[e] * en; o4[e] = kd[e] * en; o5[e] = bv[e] * eh; o6[e] = kd[e] * eh;
              if (ri == 63) P.GAM[(size_t)item * 64 + k0 + e] = ec; }
          *(LASQ u32x4*)(At + ri * RLD + k0) = pack8(o1); *(LASQ u32x4*)(Rt + ri * RLD + k0) = pack8(o2); *(LASQ u32x4*)(Bt + ri * RLD + k0) = pack8(o3); *(LASQ u32x4*)(Kt + ri * RLD + k0) = pack8(o4);
          *(LASQ u32x4*)(Kh + ri * RLD + k0) = pack8(o6);
#pragma unroll
          for (int e = 0; e < 8; ++e) { Bh[(k0 + e) * RLD + ri] = (bf16)f2bf(o5[e]); Vt[(k0 + e) * RLD + ri] = (bf16)f2bf(vv[e]); } }
        LDS_BARRIER();
        { LASQ unsigned char* L = (LASQ unsigned char*)F.lds; const int q = F.wave >> 1, half = F.wave & 1;
          if (q == 0) rw1_scores<0>(L, half, row, quad); else if (q == 1) rw1_scores<1>(L, half, row, quad); else if (q == 2) rw1_scores<2>(L, half, row, quad); else rw1_scores<3>(L, half, row, quad); }
        LDS_BARRIER();
        { const int e0 = F.tid * 8, xi = e0 >> 6, xc = e0 & 63; float t8[8]; unpack8(*(const LASQ u32x4*)(At + xi * RLD + xc), t8);
          *(LASQ f32x4*)(XA + xi * 64 + xc) = (f32x4){t8[0], t8[1], t8[2], t8[3]}; *(LASQ f32x4*)(XA + xi * 64 + xc + 4) = (f32x4){t8[4], t8[5], t8[6], t8[7]}; }
        LDS_BARRIER();
#pragma unroll 1
        for (int r = 0; r < 4; ++r) {
            if (r > 0) { LASQ float* Xh = (F.wave < 4) ? XA : M2; const LASQ bf16* Xb = (F.wave < 4) ? TA : TM2; const int cb = (F.wave & 3) * 16;
                f32x4 acc = {0.f, 0.f, 0.f, 0.f};
                for (int ks = 0; ks < ((r + 1) >> 1); ++ks) { bf16x8v a; const LASQ float* mr = M1 + (16 * r + row) * 64 + ks * 32 + quad * 8;
                    const f32x4 m0 = *(const LASQ f32x4*)mr, m1v = *(const LASQ f32x4*)(mr + 4);
#pragma unroll
                    for (int e = 0; e < 8; ++e) { const int j = ks * 32 + quad * 8 + e; const float mv = (e < 4) ? m0[e & 3] : m1v[e & 3]; a[e] = (short)((j < 16 * r) ? f2bf(mv) : 0u); }
                    const int jb = ks * 32 + quad * 8; bf16x8v bb = lfrag8(Xb + (cb + row) * RLD + jb);
                    if (jb >= 16 * r) bb = (bf16x8v){0, 0, 0, 0, 0, 0, 0, 0};
                    acc = __builtin_amdgcn_mfma_f32_16x16x32_bf16(a, bb, acc, 0, 0, 0); }
#pragma unroll
                for (int jj = 0; jj < 4; ++jj) Xh[(16 * r + quad * 4 + jj) * 64 + cb + row] += acc[jj]; }
            LDS_BARRIER();
            if (F.tid < 128) { const int col = F.tid & 63; LASQ float* Xh = (F.tid < 64) ? XA : M2; LASQ bf16* dst = (F.tid < 64) ? TA : TM2;
                float x[16];
#pragma unroll
                for (int ii = 0; ii < 16; ++ii) x[ii] = Xh[(16 * r + ii) * 64 + col];
#pragma unroll
                for (int jj = 0; jj < 15; ++jj) {
#pragma unroll
                    for (int ii = jj + 1; ii < 16; ++ii) x[ii] += M1[(16 * r + ii) * 64 + 16 * r + jj] * x[jj]; }
                u32x4 w0, w1;
#pragma unroll
                for (int e = 0; e < 4; ++e) { w0[e] = pk2(x[2 * e], x[2 * e + 1]); w1[e] = pk2(x[8 + 2 * e], x[8 + 2 * e + 1]); }
                *(LASQ u32x4*)(dst + col * RLD + 16 * r) = w0; *(LASQ u32x4*)(dst + col * RLD + 16 * r + 8) = w1; }
            LDS_BARRIER();
        }
        { LASQ unsigned char* L = (LASQ unsigned char*)F.lds; const int q = F.wave >> 1, half = F.wave & 1;
          if (q == 0) rw1_products<0>(L, half, row, quad, P.RA + (size_t)item * 4096); else if (q == 1) rw1_products<1>(L, half, row, quad, nullptr);
          else if (q == 2) rw1_products<2>(L, half, row, quad, P.NT + (size_t)item * 4096); else rw1_products<3>(L, half, row, quad, P.WKT + (size_t)item * 4096); }
        LDS_BARRIER();
#pragma unroll
        for (int tt = 0; tt < 2; ++tt) { const int t = 2 * F.wave + tt, mt = t >> 2, nt = t & 3;
            f32x4 acc = {0.f, 0.f, 0.f, 0.f};
#pragma unroll
            for (int ks = 0; ks < 2; ++ks) acc = __builtin_amdgcn_mfma_f32_16x16x32_bf16(lfrag8(CY + (mt * 16 + row) * RLD + ks * 32 + quad * 8), lfrag8(Vt + (nt * 16 + row) * RLD + ks * 32 + quad * 8), acc, 0, 0, 0);
#pragma unroll
            for (int jj = 0; jj < 4; ++jj) { const size_t m = (size_t)b * T + scan_t(d, ch * RWC + mt * 16 + quad * 4 + jj); YD[m * 1024 + h * 64 + nt * 16 + row] = (bf16)f2bf(acc[jj]); } }
        LDS_BARRIER();
    }
}
constexpr int R2_RA = 0, R2_NT = 9216, R2_WK = 18432, R2_V = 27648, R2_Y = 30720, R2_G = 33792, R2_BUF = 34048, R2_SL = 2 * R2_BUF, VL2 = 24;
struct RwSet { u32x4 a, n, w, x; };
__device__ __forceinline__ void rw2_fetch(const Ctx& F, const RwP2& P, RwSet& o, int seq, int c, int b, int d, int h, int vq) {
    if (c >= RWN) c = RWN - 1;
    const size_t item = (size_t)seq * RWN + c; const bf16* YD = d ? P.YD1 : P.YD0;
    o.a = *(const u32x4*)(P.RA + item * 4096 + F.tid * 8); o.n = *(const u32x4*)(P.NT + item * 4096 + F.tid * 8); o.w = *(const u32x4*)(P.WKT + item * 4096 + F.tid * 8);
    o.x = (u32x4){0u, 0u, 0u, 0u};
    if (F.tid < 256) { const int j = (F.tid & 127) >> 1, hf = F.tid & 1; const size_t m = (size_t)b * T + scan_t(d, c * RWC + j);
        o.x = *(const u32x4*)((F.tid < 128 ? P.Rv : YD) + m * 1024 + h * 64 + vq * 16 + hf * 8); }
    else if (F.tid < 272) o.x = *(const u32x4*)(P.GAM + item * 64 + (F.tid - 256) * 4);
}
__device__ __forceinline__ void rw2_put(const Ctx& F, const RwSet& o, LASQ unsigned char* buf) {
    const int e0 = F.tid * 8, r = e0 >> 6, cc = e0 & 63;
    *(LASQ u32x4*)(buf + R2_RA + (r * RLD + cc) * 2) = o.a; *(LASQ u32x4*)(buf + R2_NT + (r * RLD + cc) * 2) = o.n; *(LASQ u32x4*)(buf + R2_WK + (r * RLD + cc) * 2) = o.w;
    if (F.tid < 256) { const int j = (F.tid & 127) >> 1, hf = F.tid & 1; *(LASQ u32x4*)(buf + (F.tid < 128 ? R2_V : R2_Y) + (j * VL2 + hf * 8) * 2) = o.x; }
    else if (F.tid < 272) *(LASQ u32x4*)(buf + R2_G + (F.tid - 256) * 16) = o.x;
}
__device__ __forceinline__ void rw2_state(const Ctx& F, const LASQ unsigned char* buf, f32x4 (&S)[4], int c) {
    const int row = F.lane & 15, quad = F.lane >> 4;
    const LASQ bf16* Sc = (const LASQ bf16*)(F.lds + R2_SL + (c & 1) * 2304); LASQ bf16* Sn = (LASQ bf16*)(F.lds + R2_SL + ((c + 1) & 1) * 2304);
    const LASQ bf16* NTl = (const LASQ bf16*)(buf + R2_NT); const LASQ bf16* WKl = (const LASQ bf16*)(buf + R2_WK); const LASQ bf16* Vl = (const LASQ bf16*)(buf + R2_V); const LASQ float* Gl = (const LASQ float*)(buf + R2_G);
    bf16x8v sf[2]; sf[0] = lfrag8(Sc + row * RLD + quad * 8); sf[1] = lfrag8(Sc + row * RLD + 32 + quad * 8);
    bf16x8v vf[2]; vf[0] = lgather8(Vl + (quad * 8) * VL2 + row, VL2); vf[1] = lgather8(Vl + (32 + quad * 8) * VL2 + row, VL2);
#pragma unroll
    for (int t = 0; t < 4; ++t) { f32x4 acc = S[t] * Gl[t * 16 + row];
        acc = __builtin_amdgcn_mfma_f32_16x16x32_bf16(sf[0], lfrag8(NTl + (t * 16 + row) * RLD + quad * 8), acc, 0, 0, 0); acc = __builtin_amdgcn_mfma_f32_16x16x32_bf16(sf[1], lfrag8(NTl + (t * 16 + row) * RLD + 32 + quad * 8), acc, 0, 0, 0);
        acc = __builtin_amdgcn_mfma_f32_16x16x32_bf16(vf[0], lfrag8(WKl + (t * 16 + row) * RLD + quad * 8), acc, 0, 0, 0); acc = __builtin_amdgcn_mfma_f32_16x16x32_bf16(vf[1], lfrag8(WKl + (t * 16 + row) * RLD + 32 + quad * 8), acc, 0, 0, 0);
        S[t] = acc; }
#pragma unroll
    for (int t = 0; t < 4; ++t) { u32x2 w; w.x = pk2(S[t][0], S[t][1]); w.y = pk2(S[t][2], S[t][3]);
        Sn[(quad * 4 + 0) * RLD + t * 16 + row] = (bf16)(w.x & 0xffffu); Sn[(quad * 4 + 1) * RLD + t * 16 + row] = (bf16)(w.x >> 16);
        Sn[(quad * 4 + 2) * RLD + t * 16 + row] = (bf16)(w.y & 0xffffu); Sn[(quad * 4 + 3) * RLD + t * 16 + row] = (bf16)(w.y >> 16); }
}
__device__ __forceinline__ void rw2_y(const Ctx& F, const RwP2& P, const LASQ unsigned char* buf, int c, int b, int d, int h, int vq) {
    const int row = F.lane & 15, quad = F.lane >> 4;
    const LASQ bf16* Sc = (const LASQ bf16*)(F.lds + R2_SL + (c & 1) * 2304); bf16* YD = d ? P.YD1 : P.YD0;
    const LASQ bf16* RAl = (const LASQ bf16*)(buf + R2_RA); const LASQ bf16* Yl = (const LASQ bf16*)(buf + R2_Y);
    bf16x8v sf[2]; sf[0] = lfrag8(Sc + row * RLD + quad * 8); sf[1] = lfrag8(Sc + row * RLD + 32 + quad * 8);
#pragma unroll
    for (int t = 0; t < 4; ++t) { f32x4 y = {0.f, 0.f, 0.f, 0.f};
        y = __builtin_amdgcn_mfma_f32_16x16x32_bf16(lfrag8(RAl + (t * 16 + row) * RLD + quad * 8), sf[0], y, 0, 0, 0); y = __builtin_amdgcn_mfma_f32_16x16x32_bf16(lfrag8(RAl + (t * 16 + row) * RLD + 32 + quad * 8), sf[1], y, 0, 0, 0);
#pragma unroll
        for (int jj = 0; jj < 4; ++jj) { const int i = t * 16 + quad * 4 + jj; const size_t m = (size_t)b * T + scan_t(d, c * RWC + i); YD[m * 1024 + h * 64 + vq * 16 + row] = (bf16)f2bf(y[jj] + bf2f(Yl[i * VL2 + row])); } }
}
__device__ __forceinline__ void rwkv_chunk_scan(const Ctx& F, const RwP2& P) {
    const int vb = (F.G % 8 == 0) ? (F.bid % 8) * (F.G / 8) + F.bid / 8 : F.bid;
    for (int it = vb; it < 256; it += F.G) {
        const int seq = it >> 2, vq = it & 3, b = seq >> 5, d = (seq >> 4) & 1, h = seq & 15;
        f32x4 S[4];
#pragma unroll
        for (int t = 0; t < 4; ++t) S[t] = (f32x4){0.f, 0.f, 0.f, 0.f};
        RwSet s0, s1, s2;
        rw2_fetch(F, P, s0, seq, 0, b, d, h, vq); rw2_fetch(F, P, s1, seq, 1, b, d, h, vq); rw2_fetch(F, P, s2, seq, 2, b, d, h, vq);
        LDS_BARRIER();
        rw2_put(F, s0, (LASQ unsigned char*)F.lds);
        for (int i = F.tid; i < 16 * RLD; i += 512) ((LASQ bf16*)(F.lds + R2_SL))[i] = 0;
        LDS_BARRIER();
        for (int c3 = 0; c3 < RWN; c3 += 6) {
#define RW2_BODY(cc, SN, SC) do { rw2_put(F, SN, (LASQ unsigned char*)F.lds + (((cc) + 1) & 1) * R2_BUF); rw2_fetch(F, P, SC, seq, (cc) + 3, b, d, h, vq); \
            if (F.wave == 0) rw2_state(F, (const LASQ unsigned char*)F.lds + ((cc) & 1) * R2_BUF, S, (cc)); else if (F.wave == 1) rw2_y(F, P, (const LASQ unsigned char*)F.lds + ((cc) & 1) * R2_BUF, (cc), b, d, h, vq); LDS_BARRIER(); } while (0)
            RW2_BODY(c3 + 0, s1, s0); RW2_BODY(c3 + 1, s2, s1); RW2_BODY(c3 + 2, s0, s2);
            RW2_BODY(c3 + 3, s1, s0); RW2_BODY(c3 + 4, s2, s1); RW2_BODY(c3 + 5, s0, s2);
#undef RW2_BODY
        }
    }
}
__device__ __forceinline__ void rwkv_post(const Ctx& F, const RwP2& P, const bf16* Gg, const float* rk, const float* lnw, const float* lnb, bf16* O) {
    for (int m = F.gw; m < M; m += F.NGW) {
#pragma unroll 1
        for (int hp = 0; hp < 2; ++hp) {
            const int c0 = hp * 512 + 8 * F.lane; const size_t i1 = (size_t)m * 1024 + c0;
            const u32x4 wy0 = *(const u32x4*)(P.YD0 + i1), wy1 = *(const u32x4*)(P.YD1 + i1), wr = *(const u32x4*)(P.Rr + i1), wk = *(const u32x4*)(P.Rk + i1), wv = *(const u32x4*)(P.Rv + i1);
            const u32x4 wa0 = *(const u32x4*)(P.WA0 + (size_t)m * 2048 + 1024 + c0), wa1 = *(const u32x4*)(P.WA1 + (size_t)m * 2048 + 1024 + c0), wg = *(const u32x4*)(Gg + i1);
            float cl[8], cb[8], ca0[8], ca1[8], cka[8], crk[8];
#pragma unroll
            for (int q = 0; q < 2; ++q) { const f32x4 t0 = *(const f32x4*)(lnw + c0 + 4 * q), t1 = *(const f32x4*)(lnb + c0 + 4 * q), t2 = *(const f32x4*)(P.a0 + c0 + 4 * q), t3 = *(const f32x4*)(P.a0 + 1024 + c0 + 4 * q),
                    t4 = *(const f32x4*)(P.kaw + c0 + 4 * q), t5 = *(const f32x4*)(rk + c0 + 4 * q);
#pragma unroll
                for (int e = 0; e < 4; ++e) { cl[4 * q + e] = t0[e]; cb[4 * q + e] = t1[e]; ca0[4 * q + e] = t2[e]; ca1[4 * q + e] = t3[e]; cka[4 * q + e] = t4[e]; crk[4 * q + e] = t5[e]; } }
            float y0[8], y1[8], r[8], k[8], v[8], a0v[8], a1v[8], g[8];
            unpack8(wy0, y0); unpack8(wy1, y1); unpack8(wr, r); unpack8(wk, k); unpack8(wv, v); unpack8(wa0, a0v); unpack8(wa1, a1v); unpack8(wg, g);
            float y[8], s1 = 0.f, dot = 0.f;
#pragma unroll
            for (int e = 0; e < 8; ++e) { y[e] = y0[e] + y1[e]; s1 += y[e];
                const float ag0 = sigm(ca0[e] + a0v[e]), ag1 = sigm(ca1[e] + a1v[e]);
                dot += r[e] * k[e] * (2.f + (ag0 + ag1 - 2.f) * cka[e]) * crk[e]; }
            s1 += __shfl_xor(s1, 1); s1 += __shfl_xor(s1, 2); s1 += __shfl_xor(s1, 4);
            dot += __shfl_xor(dot, 1); dot += __shfl_xor(dot, 2); dot += __shfl_xor(dot, 4);
            const float mean = s1 * (1.f / 64.f); float s2 = 0.f;
#pragma unroll
            for (int e = 0; e < 8; ++e) { y[e] -= mean; s2 += y[e] * y[e]; }
            s2 += __shfl_xor(s2, 1); s2 += __shfl_xor(s2, 2); s2 += __shfl_xor(s2, 4);
            const float rs = rsqrtf(s2 * (1.f / 64.f) + 64e-5f);
            float o[8];
#pragma unroll
            for (int e = 0; e < 8; ++e) o[e] = (y[e] * rs * cl[e] + cb[e] + dot * v[e]) * g[e];
            *(u32x4*)(O + (size_t)m * 2048 + c0) = pack8(o);
        }
    }
}

struct LruP { const bf16 *XBR, *GATE, *XS, *Z; const float *convw, *convb, *ba, *bx, *lam; float* CAR; bf16* Y; };
__device__ __forceinline__ int lru_row(int b, int s) { if (s < CTX) return b * T + s; const int p = s - CTX; return b * T + CTX + (p & 127) * 64 + (p >> 7); }
__device__ __forceinline__ void lru_conv(const Ctx& F, const LruP& P, bf16* XS) {
    for (int m = F.gw; m < M; m += F.NGW) {
        const int b = m / T, s = m % T; const int lo = (s < CTX) ? 0 : CTX, hi = (s < CTX) ? CTX : T;
#pragma unroll
        for (int q = 0; q < 4; ++q) {
            const int c0 = 8 * (F.lane + 64 * q);
            float y[8];
            { const f32x4 b0 = *(const f32x4*)(P.convb + c0), b1 = *(const f32x4*)(P.convb + c0 + 4); y[0] = b0[0]; y[1] = b0[1]; y[2] = b0[2]; y[3] = b0[3]; y[4] = b1[0]; y[5] = b1[1]; y[6] = b1[2]; y[7] = b1[3]; }
#pragma unroll
            for (int j = 0; j < 4; ++j) { const int sj = s + j - 2;
                if (sj >= lo && sj < hi) { const u32x4 x = *(const u32x4*)(P.XBR + (size_t)lru_row(b, sj) * 2048 + c0);
                    const f32x4 w0 = *(const f32x4*)(P.convw + j * 2048 + c0), w1 = *(const f32x4*)(P.convw + j * 2048 + c0 + 4);
                    y[0] += lo16(x[0]) * w0[0]; y[1] += hi16(x[0]) * w0[1]; y[2] += lo16(x[1]) * w0[2]; y[3] += hi16(x[1]) * w0[3];
                    y[4] += lo16(x[2]) * w1[0]; y[5] += hi16(x[2]) * w1[1]; y[6] += lo16(x[3]) * w1[2]; y[7] += hi16(x[3]) * w1[3]; } }
            u32x4 o; o.x = pk2(y[0], y[1]); o.y = pk2(y[2], y[3]); o.z = pk2(y[4], y[5]); o.w = pk2(y[6], y[7]);
            *(u32x4*)(XS + (size_t)m * 2048 + c0) = o;
        }
    }
}
struct LruRaw { unsigned lw, iw, xw; };
__device__ __forceinline__ LruRaw lru_ld(const bf16* zb, const bf16* xb, int i, int d) {
    LruRaw r; r.lw = *(const unsigned*)(zb + i * 128 + d * 8192); r.iw = *(const unsigned*)(zb + i * 128 + (2 + d) * 8192); r.xw = *(const unsigned*)(xb + i * 2048);
    return r;
}
__device__ __forceinline__ const bf16* lru_zbase(const LruP& P, int b, int cf, int c) { const int n = c >> 8, j = c & 255; return P.Z + (((size_t)(b * LNCH + cf) * 64 + n * 8 + (j >> 7)) * 32) * 128 + (j & 127); }
__device__ __forceinline__ void lru_cmp(const LruRaw& r, float (&a)[2], float (&u)[2]) {
    const float la[2] = {lo16(r.lw), hi16(r.lw)}, ig[2] = {lo16(r.iw), hi16(r.iw)}, xs[2] = {lo16(r.xw), hi16(r.xw)};
#pragma unroll
    for (int e = 0; e < 2; ++e) { a[e] = __expf(la[e]); const float x2 = 2.f * la[e];
        const float om = -x2 * (1.f + x2 * (0.5f + x2 * (0.16666667f + x2 * (0.041666668f + x2 * (0.0083333338f + x2 * 0.0013888889f)))));
        const float om2 = (x2 < -0.5f) ? (1.f - a[e] * a[e]) : om;
        u[e] = __builtin_amdgcn_sqrtf(fmaxf(om2, 0.f)) * ig[e] * xs[e]; }
}
__device__ __forceinline__ void lru_passA(const Ctx& F, const LruP& P) {
    for (int it = F.bid; it < NB * LNCH * 2; it += F.G) {
        const int hq = it & 1, bc = it >> 1, b = bc / LNCH, cf = bc % LNCH, c = hq * 1024 + 2 * F.tid;
        const bf16* zb = lru_zbase(P, b, cf, c); const bf16* xb = P.XS + ((size_t)b * T + cf * LCH) * 2048 + c;
#pragma unroll
        for (int d = 0; d < 2; ++d) {
            float A[2] = {1.f, 1.f}, U[2] = {0.f, 0.f};
#pragma unroll 1
            for (int i0 = 0; i0 < LCH; i0 += 16) {
                LruRaw rw[16];
#pragma unroll
                for (int i = 0; i < 16; ++i) rw[i] = lru_ld(zb, xb, d ? (LCH - 1 - i0 - i) : (i0 + i), d);
#pragma unroll
                for (int i = 0; i < 16; ++i) { float a[2], u[2]; lru_cmp(rw[i], a, u); U[0] = a[0] * U[0] + u[0]; A[0] *= a[0]; U[1] = a[1] * U[1] + u[1]; A[1] *= a[1]; }
            }
            *(f32x4*)(P.CAR + ((size_t)((b * 2 + d) * LNCH + cf) * 2048 + c) * 2) = (f32x4){A[0], U[0], A[1], U[1]};
        }
    }
}
__device__ __forceinline__ void lru_passB(const Ctx& F, const LruP& P) {
    const int nth = F.G * 512;
    for (int i = F.bid * 512 + F.tid; i < NB * 2 * 2048; i += nth) {
        const int c = i & 2047, d = (i >> 11) & 1, b = i >> 12;
        float h = 0.f;
        for (int k0 = 0; k0 < LNCH; k0 += 24) {
            float A[24], U[24]; float* cp[24];
#pragma unroll
            for (int j = 0; j < 24; ++j) { const int k = k0 + j, cf = d ? (k < 8 ? 7 - k : LNCH + 7 - k) : k;
                cp[j] = P.CAR + ((size_t)((b * 2 + d) * LNCH + cf) * 2048 + c) * 2; const float2 t = *(const float2*)cp[j]; A[j] = t.x; U[j] = t.y; }
#pragma unroll
            for (int j = 0; j < 24; ++j) { cp[j][1] = h; h = A[j] * h + U[j]; }
        }
    }
}
__device__ __forceinline__ void lru_passC(const Ctx& F, const LruP& P) {
    for (int it = F.bid; it < NB * LNCH * 2; it += F.G) {
        const int hq = it & 1, bc = it >> 1, b = bc / LNCH, cf = bc % LNCH, c = hq * 1024 + 2 * F.tid;
        const bf16* zb = lru_zbase(P, b, cf, c); const bf16* xb = P.XS + ((size_t)b * T + cf * LCH) * 2048 + c;
        LASQ f32x2v* hfl = (LASQ f32x2v*)F.lds + F.tid;
        { const f32x4 cr = *(const f32x4*)(P.CAR + ((size_t)((b * 2 + 0) * LNCH + cf) * 2048 + c) * 2);
          float h0 = cr[1], h1 = cr[3];
#pragma unroll
          for (int i0 = 0; i0 < LCH; i0 += 8) {
              LruRaw rw[8];
#pragma unroll
              for (int i = 0; i < 8; ++i) rw[i] = lru_ld(zb, xb, i0 + i, 0);
#pragma unroll
              for (int i = 0; i < 8; ++i) { float a[2], u[2]; lru_cmp(rw[i], a, u); h0 = a[0] * h0 + u[0]; h1 = a[1] * h1 + u[1]; hfl[(i0 + i) * 512] = (f32x2v){h0, h1}; }
              asm volatile("" ::: "memory"); } }
        { const f32x4 cr = *(const f32x4*)(P.CAR + ((size_t)((b * 2 + 1) * LNCH + cf) * 2048 + c) * 2);
          float h0 = cr[1], h1 = cr[3];
          const int s0 = cf * LCH;
#pragma unroll
          for (int i0 = 0; i0 < LCH; i0 += 8) {
              LruRaw rw[8]; unsigned gw[8];
#pragma unroll
              for (int i = 0; i < 8; ++i) { const int li = LCH - 1 - i0 - i; rw[i] = lru_ld(zb, xb, li, 1); gw[i] = *(const unsigned*)(P.GATE + (size_t)lru_row(b, s0 + li) * 2048 + c); }
#pragma unroll
              for (int i = 0; i < 8; ++i) { const int li = LCH - 1 - i0 - i; float a[2], u[2]; lru_cmp(rw[i], a, u); h0 = a[0] * h0 + u[0]; h1 = a[1] * h1 + u[1];
                  const f32x2v hv = hfl[li * 512];
                  *(unsigned*)(P.Y + (size_t)lru_row(b, s0 + li) * 2048 + c) = pk2((hv.x + h0) * gelu_tanh(lo16(gw[i])), (hv.y + h1) * gelu_tanh(hi16(gw[i]))); }
              asm volatile("" ::: "memory"); } }
    }
}

__device__ __forceinline__ void fill_wlora(const Ctx& F, const float* g2, const float* w2, const float* a2, bf16* WL) {
    const int nth = F.G * 512;
    for (int i = F.bid * 512 + F.tid; i < 5120 * 256; i += nth) {
        const int k = i & 255, n = i >> 8; float v = 0.f;
        if (n < 1024) v = g2[(size_t)k * 1024 + n];
        else { const int q = n - 1024, d = q >> 11, r2 = q & 2047;
            if (r2 < 1024) { if (k < 96) v = w2[((size_t)d * 96 + k) * 1024 + r2]; }
            else { if (k >= 96 && k < 192) v = a2[((size_t)d * 96 + (k - 96)) * 1024 + (r2 - 1024)]; } }
        WL[i] = (bf16)f2bf(v);
    }
}
__device__ __forceinline__ void zero_rows(const Ctx& F, bf16* p, size_t n16) {
    const size_t nth = (size_t)F.G * 512; const u32x4 z = {0u, 0u, 0u, 0u};
    for (size_t i = (size_t)F.bid * 512 + F.tid; i < n16; i += nth) ((u32x4*)p)[i] = z;
}

__global__ void __launch_bounds__(512, 2) mega_fwd(Args args) {
    extern __shared__ __attribute__((aligned(16))) unsigned char lds[];
    cg::grid_group grid = cg::this_grid();
    Ctx F; F.lds = lds; F.tid = threadIdx.x; F.lane = F.tid & 63; F.wave = __builtin_amdgcn_readfirstlane(F.tid >> 6);
    F.G = gridDim.x; F.bid = blockIdx.x; F.gw = F.bid * 8 + F.wave; F.NGW = F.G * 8;
    unsigned char* ws = args.ws; unsigned char* ob = (unsigned char*)args.out;
    const float* x = args.in[0]; const float* cvec = args.in[1]; const float* ctx = args.in[2]; const float* c_ctx = args.in[3];
    const float* mod_w = args.in[4]; const float* mod_b = args.in[5]; const float* norm1 = args.in[6]; const float* norm2 = args.in[7];
    const float* mlp_w1 = args.in[8]; const float* mlp_w2 = args.in[9]; const float* ab_w_in = args.in[10]; const float* ab_w_out = args.in[11];
    float* modv = (float*)(ws + WS_MODV); float* X = (float*)(ws + WS_X); bf16* H = (bf16*)(ws + WS_HR);
    bf16* Wab = (bf16*)(ws + WS_WAB); bf16* Wout = (bf16*)(ws + WS_WOUT); bf16* Wlora = (bf16*)(ws + WS_WLORA);
    bf16* PA = (bf16*)(ws + MN_PA); bf16* PB = (bf16*)(ws + MN_PB); bf16* O = (bf16*)(ws + MN_O);
    bf16* Gg = (bf16*)(ob + OT_GG); bf16* WA0 = (bf16*)(ob + OT_WA0); bf16* WA1 = (bf16*)(ws + WS_HR); bf16* LA = (bf16*)(ob + OT_LA);
    RwP2 RP; RP.Rr = (bf16*)(ws + MN_R); RP.Rk = (bf16*)(ws + MN_K); RP.Rv = (bf16*)(ws + MN_V); RP.WA0 = WA0; RP.WA1 = WA1;
    RP.w0 = args.in[13]; RP.a0 = args.in[15]; RP.kkw = args.in[18]; RP.kaw = args.in[19]; RP.RA = (bf16*)(ws + MN_RA); RP.NT = (bf16*)(ws + MN_NT); RP.WKT = (bf16*)(ws + MN_WKT);
    RP.GAM = (float*)(ws + WS_GAM); RP.YD0 = (bf16*)(ws + MN_YD0); RP.YD1 = (bf16*)(ws + MN_YD1);
    GlaP GP; GP.PB = PB; GP.gw2 = args.in[23]; GP.gb = args.in[24]; GP.KV = (bf16*)(ws + MN_KV); GP.GDP = (float*)(ws + WS_GDP);
    LruP LP; LP.XBR = (bf16*)(ob + OT_XBR); LP.GATE = (bf16*)(ws + MN_GATE); LP.XS = (bf16*)(ws + WS_HR); LP.Z = (bf16*)(ws + MN_Z);
    LP.convw = args.in[28]; LP.convb = args.in[29]; LP.ba = args.in[31]; LP.bx = args.in[33]; LP.lam = args.in[34]; LP.CAR = (float*)(ob + OT_CAR); LP.Y = (bf16*)(ob + OT_Y);
    PG8_LAS unsigned char* glds = (PG8_LAS unsigned char*)lds;
    const int lo = args.ph_lo, hi = args.ph_hi;
    volatile unsigned* xst = (volatile unsigned*)(lds + 147456 - 64);
    if (F.tid == 0) { xst[0] = 0u; xst[1] = 0u; }
    __syncthreads();
    XcdBarrier xbar = xcd_barrier_post((unsigned*)ws, xst);
#define IN(k) (lo <= (k) && (k) < hi)
#define SEAM(k) do { if (IN(k) && IN((k) + 1)) { if ((k) == 0) grid.sync(); else xcd_barrier(xbar); } } while (0)
#define GEMM(EPI, Aptr, lda_, Btptr, ldb_, nM_, nN_, K_, skip_, amode_, ...) do { pg8::Gemm g{(const bf16*)(Aptr), (const bf16*)(Btptr), 0, 0, (K_), (lda_), (ldb_)}; pg8::Sched S; S.init((nM_), (nN_), F.G, F.bid, (skip_), (amode_)); \
        pg8::EPI E{__VA_ARGS__}; pg8::gemm_phase<pg8::EPI, pg8::Sched, true, true>(glds, g, S, E); } while (0)

    if (IN(0)) {
        mod_gemv(F, cvec, c_ctx, mod_w, mod_b, modv);
        xpose(F, ab_w_in, 6816, D, ACOLS, Wab, D);
        xpose(F, ab_w_in + ACOLS, 6816, D, BCOLS, Wab + (size_t)PA_LD * D, D);
        xpose(F, ab_w_out, D, D, D, Wout, D);
        zero_rows(F, Wab + (size_t)ACOLS * D, (size_t)(PA_LD - ACOLS) * D / 8);
        zero_rows(F, Wab + (size_t)(PA_LD + BCOLS) * D, (size_t)(NAB - PA_LD - BCOLS) * D / 8);
        fill_wlora(F, args.in[17], args.in[14], args.in[16], Wlora);
        for (int i = F.bid * 512 + F.tid; i < 2 * D; i += F.G * 512) { const float l = args.in[34][i]; ((float*)(ws + WS_SPL))[i] = -8.f * ((-l) > 20.f ? (-l) : log1pf(__expf(-l))); }
    }
    SEAM(0);
    if (IN(1)) norm_mod(F, X, x, ctx, norm1, modv, 0, 1, H, 0);
    SEAM(1);
    if (IN(2)) GEMM(EpiBf16S, H, D, Wab, D, 66, 28, D, 0, 0, PA, PB, PB, PA_LD, PB_LD, PB_LD, 15, 1000, 0);
    SEAM(2);
    if (IN(3)) { gla_kv(F, GP); rwkv_mix(F, PA, args.in[12], (bf16*)RP.Rr, (bf16*)RP.Rk, (bf16*)RP.Rv, LA); }
    SEAM(3);
    if (IN(4)) { gla_carry(F, GP); GEMM(EpiBf16S, LA, 768, Wlora, 256, 66, 20, 256, 0, 1, Gg, WA0, WA1, 1024, 2048, 2048, 4, 12, 0); }
    SEAM(4);
    if (IN(5)) gla_out(F, GP, args.in[25], O);
    SEAM(5);
    if (IN(7)) rwkv_chunk_prep(F, RP);
    SEAM(7);
    if (IN(8)) rwkv_chunk_scan(F, RP);
    SEAM(8);
    if (IN(10)) rwkv_post(F, RP, Gg, args.in[20], args.in[21], args.in[22], O);
    SEAM(10);
    Ctx FI = F; FI.gw = (F.bid - 16) * 8 + F.wave; FI.NGW = (F.G - 16) * 8;
    if (IN(11)) { GEMM(EpiResid, O, D, Wout, D, 66, 8, D, 0, 0, X, x, ctx, modv, 2);
        if (F.bid >= 16) { xpose(FI, mlp_w1, FF, D, FF, (bf16*)(ws + MN_W1_0), D); xpose(FI, mlp_w2, D, FF, D, (bf16*)(ws + MN_W2_0), FF); } }
    SEAM(11);
    if (IN(12)) norm_mod(F, X, nullptr, nullptr, norm2, modv, 3, 4, H, 0);
    SEAM(12);
    if (IN(13)) GEMM(EpiBf16S, H, D, ws + MN_W1_0, D, 66, 32, D, 0, 0, (bf16*)(ws + MN_U0), nullptr, nullptr, FF, 0, 0, 1000, 1000, 1);
    SEAM(13);
    if (IN(14)) { GEMM(EpiResid, ws + MN_U0, FF, ws + MN_W2_0, FF, 66, 8, FF, 0, 0, X, nullptr, nullptr, modv, 5);
        if (F.bid >= 16) { xpose(FI, args.in[26], 2 * D, D, 2 * D, (bf16*)(ws + MN_WLIN), D); xpose(FI, args.in[27], D, D, D, (bf16*)(ws + MN_WLOUT), D);
            for (int q = 0; q < 32; ++q) { const int gq = q >> 3, n = q & 7, d = gq & 1; const float* src = (gq < 2 ? args.in[30] : args.in[32]) + (size_t)(d * 8 + n) * 65536;
                xpose(FI, src, 256, 256, 256, (bf16*)(ws + MN_WG) + (size_t)(n * 1024 + gq * 256) * 256, 256); }
            xpose(FI, mlp_w1 + (size_t)D * FF, FF, D, FF, (bf16*)(ws + MN_W1_1), D); xpose(FI, mlp_w2 + (size_t)D * FF, D, FF, D, (bf16*)(ws + MN_W2_1), FF); } }
    SEAM(14);
    const float* modv1 = modv + 3 * 12288;
    if (IN(15)) norm_mod(F, X, nullptr, nullptr, norm1 + D, modv1, 0, 1, H, 0);
    SEAM(15);
    if (IN(16)) GEMM(EpiBf16S, H, D, ws + MN_WLIN, D, 66, 16, D, 0, 0, (bf16*)LP.GATE, (bf16*)LP.XBR, (bf16*)LP.XBR, D, D, D, 8, 1000, 0);
    SEAM(16);
    if (IN(17)) lru_conv(F, LP, (bf16*)LP.XS);
    SEAM(17);
    if (IN(18)) GEMM(EpiLruGate, LP.XS, D, ws + MN_WG, 256, 66, 32, 256, 0, 2, (bf16*)LP.Z, LP.ba, LP.bx, (const float*)(ws + WS_SPL));
    SEAM(18);
    if (IN(19)) lru_passA(F, LP);
    SEAM(19);
    if (IN(20)) lru_passB(F, LP);
    SEAM(20);
    if (IN(21)) lru_passC(F, LP);
    SEAM(21);
    if (IN(22)) GEMM(EpiResid, LP.Y, D, ws + MN_WLOUT, D, 64, 8, D, 1, 0, X, nullptr, nullptr, modv1, 2);
    SEAM(22);
    if (IN(23)) norm_mod(F, X, nullptr, nullptr, norm2 + D, modv1, 3, 4, H, 1);
    SEAM(23);
    if (IN(24)) GEMM(EpiBf16S, H, D, ws + MN_W1_1, D, 64, 32, D, 1, 0, (bf16*)(ws + MN_U1), nullptr, nullptr, FF, 0, 0, 1000, 1000, 1);
    SEAM(24);
    if (IN(25)) GEMM(EpiResid, ws + MN_U1, FF, ws + MN_W2_1, FF, 64, 8, FF, 1, 0, X, nullptr, nullptr, modv1, 5);
    SEAM(25);
    if (IN(26)) final_norm(F, X, args.in[35], args.out);
}

#ifndef N_LAUNCH_PER_PHASE
#define N_LAUNCH_PER_PHASE 0
#endif
extern "C" void kernel_launch(void* const* d_in, const int* in_sizes, int n_in, void* d_out, int out_size, void* d_ws, size_t ws_size, hipStream_t stream) {
    static int grid = 0;
    if (grid == 0) {
        if (n_in != 36 || ws_size < WS_END) { fprintf(stderr, "kernel_launch: unexpected n_in %d / ws_size %zu\n", n_in, ws_size); grid = -1; return; }
        int dev = 0, cus = 0, per_cu = 0;
        hipGetDevice(&dev); hipDeviceGetAttribute(&cus, hipDeviceAttributeMultiprocessorCount, dev);
        hipFuncSetAttribute((const void*)mega_fwd, hipFuncAttributeMaxDynamicSharedMemorySize, LDS_BYTES);
        hipOccupancyMaxActiveBlocksPerMultiprocessor(&per_cu, (const void*)mega_fwd, 512, LDS_BYTES);
        if (per_cu < 1) per_cu = 1;
        (void)hipGetLastError();
        grid = cus * per_cu;
    }
    if (grid < 0) return;
    if (hipMemsetAsync(d_ws, 0, 16384, stream) != hipSuccess) { fprintf(stderr, "memset failed\n"); return; }
    Args a{};
    for (int i = 0; i < 36; ++i) a.in[i] = (const float*)d_in[i];
    a.out = (float*)d_out; a.ws = (unsigned char*)d_ws;
#if N_LAUNCH_PER_PHASE
    for (int p = 0; p < NPH; ++p) { a.ph_lo = p; a.ph_hi = p + 1; hipLaunchKernelGGL(mega_fwd, dim3(grid), dim3(512), LDS_BYTES, stream, a); }
#else
    a.ph_lo = 0; a.ph_hi = NPH;
    void* kargs[] = {&a};
    hipError_t e = hipLaunchCooperativeKernel((const void*)mega_fwd, dim3(grid), dim3(512), kargs, LDS_BYTES, stream);
    if (e != hipSuccess) fprintf(stderr, "cooperative launch failed: %s (grid %d)\n", hipGetErrorString(e), grid);
#endif
}
```
